# Optimizing an MI355X kernel written in HIP

```python
import math
import jax
import jax.numpy as jnp
from jax import lax
import numpy as np

D_MODEL = 2048
BATCH = 4
SEQ = 2048
DEPTH = 4

D_MIX = D_MODEL
POOL_WINDOWS = (2, 4, 8, 16)
POOL_GROUPS = 4
POOL_WIDTH = D_MIX // 4
POOL_GROUP_DIM = POOL_WIDTH // POOL_GROUPS
MLA_NOPE = 128
MLA_ROPE = 64
MLA_V = 128
MLA_HEADS = (3 * D_MIX // 8) // MLA_V
MLA_Q_RANK = 512
MLA_KV_RANK = 256
ROPE_THETA = 10000.0
DIFF_QK = 64
DIFF_V = 2 * DIFF_QK
DIFF_HEADS = (D_MIX - POOL_WIDTH - MLA_HEADS * MLA_V) // DIFF_V
REL_BUCKETS = 32
REL_MAX_EXACT = 16
REL_MAX_DISTANCE = 128
Q_BLOCK = 128
IN_SPLITS = (POOL_WIDTH, MLA_Q_RANK, MLA_KV_RANK, MLA_ROPE,
             DIFF_HEADS * 2 * DIFF_QK, DIFF_HEADS * 2 * DIFF_QK, DIFF_HEADS * DIFF_V)
N_IN = 3648
N_GROUPS = 4
EXPERTS_PER_GROUP = 8
N_EXPERTS = N_GROUPS * EXPERTS_PER_GROUP
TOP_K = 2
EXPERT_HIDDEN = 512
MOE_BLOCK = 128
NORM_EPS = 1e-6

kernel_name = 'hymba_pool_mla_diff_hiermoe'


def rmsnorm(x, g):
    xf = x.astype(jnp.float32)
    y = xf * lax.rsqrt(jnp.mean(xf * xf, axis=-1, keepdims=True) + NORM_EPS)
    return (y * g.astype(jnp.float32)).astype(x.dtype)


def rope_tables(positions, dtype):
    inv = 1.0 / (ROPE_THETA ** (jnp.arange(0, MLA_ROPE, 2, dtype=jnp.float32) / MLA_ROPE))
    ang = positions.astype(jnp.float32)[..., None] * inv
    return jnp.cos(ang).astype(dtype), jnp.sin(ang).astype(dtype)


def apply_rope(x, cos, sin):
    half = x.shape[-1] // 2
    x1, x2 = x[..., :half], x[..., half:]
    return jnp.concatenate([x1 * cos - x2 * sin, x1 * sin + x2 * cos], axis=-1)


def causal_mask(q0, nq, nk):
    return jnp.arange(nk)[None, :] <= (q0 + jnp.arange(nq))[:, None]


def t5_bucket(rel):
    n = jnp.maximum(rel, 0)
    nf = jnp.maximum(n, 1).astype(jnp.float32)
    large = REL_MAX_EXACT + (jnp.log(nf / REL_MAX_EXACT)
                             / math.log(REL_MAX_DISTANCE / REL_MAX_EXACT)
                             * (REL_BUCKETS - REL_MAX_EXACT)).astype(jnp.int32)
    large = jnp.minimum(large, REL_BUCKETS - 1)
    return jnp.where(n < REL_MAX_EXACT, n, large)


def pool_mixer(u, w, scale):
    B, S, _ = u.shape
    ug = u.reshape(B, S, POOL_GROUPS, POOL_GROUP_DIM)
    cs = lax.cumsum(ug.astype(jnp.float32), axis=1)
    t = jnp.arange(S)
    means = []
    for g, win in enumerate(POOL_WINDOWS):
        c = cs[:, :, g]
        lag = jnp.concatenate([jnp.zeros((B, win, POOL_GROUP_DIM), jnp.float32), c[:, :S - win]], axis=1)
        cnt = jnp.minimum(t + 1, win).astype(jnp.float32)[None, :, None]
        means.append((c - lag) / cnt)
    d = jnp.stack(means, axis=2).astype(u.dtype) - ug
    y = jnp.einsum('bsgc,gcd->bsgd', d, w).reshape(B, S, POOL_WIDTH)
    return y * scale


def mla_mixer(c_q, c_kv, k_r, q_norm, w_uq, kv_norm, w_ukv, cos, sin):
    B, S, _ = c_q.shape
    q = (rmsnorm(c_q, q_norm) @ w_uq).reshape(B, S, MLA_HEADS, MLA_NOPE + MLA_ROPE)
    q_nope = q[..., :MLA_NOPE]
    q_rope = apply_rope(q[..., MLA_NOPE:], cos[:, :, None], sin[:, :, None])
    kv = (rmsnorm(c_kv, kv_norm) @ w_ukv).reshape(B, S, MLA_HEADS, MLA_NOPE + MLA_V)
    k_nope, v = kv[..., :MLA_NOPE], kv[..., MLA_NOPE:]
    k_rope = apply_rope(k_r, cos, sin)
    scale = (MLA_NOPE + MLA_ROPE) ** -0.5
    outs = []
    for i in range(S // Q_BLOCK):
        q0, end = i * Q_BLOCK, (i + 1) * Q_BLOCK
        s = (jnp.einsum('bqhd,bkhd->bhqk', q_nope[:, q0:end], k_nope[:, :end])
             + jnp.einsum('bqhd,bkd->bhqk', q_rope[:, q0:end], k_rope[:, :end])).astype(jnp.float32) * scale
        s = jnp.where(causal_mask(q0, Q_BLOCK, end), s, -jnp.inf)
        p = jax.nn.softmax(s, axis=-1).astype(v.dtype)
        outs.append(jnp.einsum('bhqk,bkhd->bqhd', p, v[:, :end]))
    return jnp.concatenate(outs, axis=1).reshape(B, S, MLA_HEADS * MLA_V)


def diff_mixer(q, k, v, lam_vecs, subln, rel_bias, positions, lam_init):
    B, S, _ = q.shape
    q = q.reshape(B, S, DIFF_HEADS, 2, DIFF_QK)
    k = k.reshape(B, S, DIFF_HEADS, 2, DIFF_QK)
    v = v.reshape(B, S, DIFF_HEADS, DIFF_V)
    lv = lam_vecs.astype(jnp.float32)
    lam = jnp.exp(jnp.sum(lv[0] * lv[1])) - jnp.exp(jnp.sum(lv[2] * lv[3])) + lam_init
    scale = DIFF_QK ** -0.5
    outs = []
    for i in range(S // Q_BLOCK):
        q0, end = i * Q_BLOCK, (i + 1) * Q_BLOCK
        rel = positions[:, q0:end, None] - positions[:, None, :end]
        bias = jnp.transpose(rel_bias[t5_bucket(rel)], (0, 3, 1, 2)).astype(jnp.float32)
        s = jnp.einsum('bqhcd,bkhcd->cbhqk', q[:, q0:end], k[:, :end]).astype(jnp.float32) * scale + bias[None]
        s = jnp.where(causal_mask(q0, Q_BLOCK, end), s, -jnp.inf)
        p = jax.nn.softmax(s, axis=-1)
        a = (p[0] - lam * p[1]).astype(v.dtype)
        outs.append(jnp.einsum('bhqk,bkhd->bqhd', a, v[:, :end]))
    o = jnp.concatenate(outs, axis=1)
    o = rmsnorm(o, subln) * (1.0 - lam_init)
    return o.reshape(B, S, DIFF_HEADS * DIFF_V)


def hier_moe(x, wg_r, bg_r, we_r, be_r, w_gate, w_up, w_down):
    B, S, D = x.shape
    T = B * S
    xf = x.reshape(T, D)
    g_logits = (xf @ wg_r + bg_r).astype(jnp.float32)
    g_prob = jax.nn.softmax(g_logits, axis=-1)
    g_idx = jnp.argmax(g_logits, axis=-1)
    g_gate = jnp.take_along_axis(g_prob, g_idx[:, None], axis=1)[:, 0]
    e_logits = (xf @ we_r + be_r).astype(jnp.float32).reshape(T, N_GROUPS, EXPERTS_PER_GROUP)
    e_in = jnp.take_along_axis(e_logits, g_idx[:, None, None], axis=1)[:, 0]
    top_p, top_i = lax.top_k(jax.nn.softmax(e_in, axis=-1), TOP_K)
    top_p = top_p / jnp.sum(top_p, axis=-1, keepdims=True)
    expert_id = (g_idx[:, None] * EXPERTS_PER_GROUP + top_i).reshape(-1)
    gate = (g_gate[:, None] * top_p).reshape(-1)
    tok = jnp.repeat(jnp.arange(T, dtype=jnp.int32), TOP_K)
    order = jnp.argsort(expert_id)
    se = expert_id[order]
    counts = jnp.zeros((N_EXPERTS,), jnp.int32).at[expert_id].add(1)
    padded = (counts + MOE_BLOCK - 1) // MOE_BLOCK * MOE_BLOCK
    start = jnp.cumsum(counts) - counts
    ends = jnp.cumsum(padded)
    pstart = ends - padded
    dest = pstart[se] + (jnp.arange(T * TOP_K) - start[se])
    n_blocks = -(-(T * TOP_K) // MOE_BLOCK) + N_EXPERTS
    P = n_blocks * MOE_BLOCK
    buf_tok = jnp.full((P,), T, jnp.int32).at[dest].set(tok[order])
    buf_gate = jnp.zeros((P,), x.dtype).at[dest].set(gate[order].astype(x.dtype))
    block_e = jnp.minimum(jnp.searchsorted(ends, jnp.arange(n_blocks) * MOE_BLOCK, side='right'), N_EXPERTS - 1)
    x_pad = jnp.concatenate([xf, jnp.zeros((1, D), x.dtype)], axis=0)
    xb = x_pad[buf_tok].reshape(n_blocks, MOE_BLOCK, D)

    def expert_block(args):
        xblk, e = args
        h = jax.nn.silu(xblk @ w_gate[e]) * (xblk @ w_up[e])
        return h @ w_down[e]

    yb = lax.map(expert_block, (xb, block_e)).reshape(P, D) * buf_gate[:, None]
    out = jnp.zeros((T + 1, D), x.dtype).at[buf_tok].add(yb)[:T]
    return out.reshape(B, S, D)


def setup_inputs(seed: int = 0) -> dict:
    key = jax.random.key(seed)
    ks = list(jax.random.split(key, 24))
    f32 = jnp.float32

    def nrm(k, shape, scale):
        return jax.random.normal(k, shape, f32) * scale

    def gain(k, shape):
        return 1.0 + 0.02 * jax.random.normal(k, shape, f32)

    L = DEPTH
    positions = (jax.random.randint(ks[1], (BATCH, 1), 0, 1024, dtype=jnp.int32)
                 + jnp.arange(SEQ, dtype=jnp.int32)[None, :])
    return {
        'x': nrm(ks[0], (BATCH, SEQ, D_MODEL), 1.0),
        'positions': positions,
        'attn_norm': gain(ks[2], (L, D_MODEL)),
        'w_in': nrm(ks[3], (L, D_MODEL, N_IN), D_MODEL ** -0.5),
        'pool_w': nrm(ks[4], (L, POOL_GROUPS, POOL_GROUP_DIM, POOL_GROUP_DIM), POOL_GROUP_DIM ** -0.5),
        'pool_scale': gain(ks[5], (L, POOL_WIDTH)),
        'mla_q_norm': gain(ks[6], (L, MLA_Q_RANK)),
        'mla_w_uq': nrm(ks[7], (L, MLA_Q_RANK, MLA_HEADS * (MLA_NOPE + MLA_ROPE)), MLA_Q_RANK ** -0.5),
        'mla_kv_norm': gain(ks[8], (L, MLA_KV_RANK)),
        'mla_w_ukv': nrm(ks[9], (L, MLA_KV_RANK, MLA_HEADS * (MLA_NOPE + MLA_V)), MLA_KV_RANK ** -0.5),
        'diff_lambda': nrm(ks[10], (L, 4, DIFF_QK), 0.1),
        'diff_subln': gain(ks[11], (L, DIFF_V)),
        'rel_bias': nrm(ks[12], (REL_BUCKETS, DIFF_HEADS), 0.3),
        'w_out': nrm(ks[13], (L, D_MIX, D_MODEL), D_MIX ** -0.5),
        'ffn_norm': gain(ks[14], (L, D_MODEL)),
        'router_group_w': nrm(ks[15], (L, D_MODEL, N_GROUPS), D_MODEL ** -0.5),
        'router_group_b': nrm(ks[16], (L, N_GROUPS), 0.01),
        'router_expert_w': nrm(ks[17], (L, D_MODEL, N_EXPERTS), D_MODEL ** -0.5),
        'router_expert_b': nrm(ks[18], (L, N_EXPERTS), 0.01),
        'expert_w_gate': nrm(ks[19], (L, N_EXPERTS, D_MODEL, EXPERT_HIDDEN), D_MODEL ** -0.5),
        'expert_w_up': nrm(ks[20], (L, N_EXPERTS, D_MODEL, EXPERT_HIDDEN), D_MODEL ** -0.5),
        'expert_w_down': nrm(ks[21], (L, N_EXPERTS, EXPERT_HIDDEN, D_MODEL), EXPERT_HIDDEN ** -0.5),
        'final_norm': gain(ks[22], (D_MODEL,)),
    }


def reference(x, positions, attn_norm, w_in, pool_w, pool_scale, mla_q_norm, mla_w_uq,
              mla_kv_norm, mla_w_ukv, diff_lambda, diff_subln, rel_bias, w_out, ffn_norm,
              router_group_w, router_group_b, router_expert_w, router_expert_b,
              expert_w_gate, expert_w_up, expert_w_down, final_norm):
    cos, sin = rope_tables(positions, x.dtype)
    offs = [0]
    for w in IN_SPLITS:
        offs.append(offs[-1] + w)
    h = x
    for l in range(DEPTH):
        u = rmsnorm(h, attn_norm[l])
        proj = u @ w_in[l]
        p_pool, c_q, c_kv, k_r, dq, dk, dv = [proj[..., offs[j]:offs[j + 1]] for j in range(len(IN_SPLITS))]
        lam_init = 0.8 - 0.6 * math.exp(-0.3 * l)
        a_out = pool_mixer(p_pool, pool_w[l], pool_scale[l])
        b_out = mla_mixer(c_q, c_kv, k_r, mla_q_norm[l], mla_w_uq[l], mla_kv_norm[l], mla_w_ukv[l], cos, sin)
        c_out = diff_mixer(dq, dk, dv, diff_lambda[l], diff_subln[l], rel_bias, positions, lam_init)
        mix = jnp.concatenate([a_out, b_out, c_out], axis=-1)
        h = h + mix @ w_out[l]
        h = h + hier_moe(rmsnorm(h, ffn_norm[l]), router_group_w[l], router_group_b[l],
                         router_expert_w[l], router_expert_b[l],
                         expert_w_gate[l], expert_w_up[l], expert_w_down[l])
    return rmsnorm(h, final_norm)
```

```cpp
#include <hip/hip_runtime.h>
#include <cstdio>
#include <cstdint>

#ifndef MK_LAUNCHES
#define MK_LAUNCHES 1
#endif

#ifndef DUP_MASK
#define DUP_MASK 0
#endif
#define DUPN(p) (((DUP_MASK) >> (p)) & 1 ? 2 : 1)
#define LAS __attribute__((address_space(3)))
#define GAS __attribute__((address_space(1)))
typedef unsigned short bf16_t;
typedef short bf16x8 __attribute__((ext_vector_type(8)));
typedef float f32x4 __attribute__((ext_vector_type(4)));
typedef float f32x2 __attribute__((ext_vector_type(2)));
typedef float f32x16 __attribute__((ext_vector_type(16)));
typedef unsigned u32x4 __attribute__((ext_vector_type(4)));
typedef unsigned u32x2 __attribute__((ext_vector_type(2)));
typedef __bf16 bfv2 __attribute__((ext_vector_type(2)));

constexpr int T = 8192, D = 2048, S = 2048, NB = 4, NL = 4, NIN = 3648;
constexpr int NE = 32, EH = 512, LISTCAP = 8192;
constexpr float EPS = 1e-6f;
constexpr float LOG2E = 1.4426950408889634f;
constexpr int NWAVES = 8, NTHR = 512;

constexpr size_t MiB = 1u << 20;
constexpr size_t al256(size_t x) { return (x + 255) & ~(size_t)255; }
constexpr size_t WS_CTL = 0, CTL_BYTES = 1 * MiB;
constexpr size_t SZ_WIN = (size_t)3072 * 2048 * 2, SZ_WDV = (size_t)768 * 2048 * 2, SZ_WUQ = (size_t)1280 * 512 * 2, SZ_WK = (size_t)768 * 256 * 2,
                 SZ_WOUT = (size_t)2048 * 2048 * 2, SZ_WGU1 = (size_t)1024 * 2048 * 2, SZ_WD1 = (size_t)2048 * 512 * 2;
constexpr size_t WS_WIN = WS_CTL + CTL_BYTES;
constexpr size_t WS_WDV = WS_WIN + NL * SZ_WIN;
constexpr size_t WS_WUQ = WS_WDV + NL * SZ_WDV;
constexpr size_t WS_WK = WS_WUQ + NL * SZ_WUQ;
constexpr size_t WS_WV = WS_WK + NL * SZ_WK;
constexpr size_t WS_WOUT = WS_WV + NL * SZ_WK;
constexpr size_t WS_WGU = WS_WOUT + NL * SZ_WOUT;
constexpr size_t WS_WD = WS_WGU + (size_t)NL * NE * SZ_WGU1;
constexpr size_t WS_COS = WS_WD + (size_t)NL * NE * SZ_WD1;
constexpr size_t WS_SIN = WS_COS + (size_t)T * 32 * 4;
constexpr size_t WS_LUT = WS_SIN + (size_t)T * 32 * 4;
constexpr size_t WS_TMAX = WS_LUT + al256(6 * 132 * 4);
constexpr size_t WS_H = WS_TMAX + al256(NB * 32 * 4);
constexpr size_t WS_XB = WS_H + (size_t)T * D * 4;
constexpr size_t WS_ZP = WS_XB + (size_t)T * D * 2;
constexpr size_t WS_CQ = WS_ZP + (size_t)T * 512 * 2;
constexpr size_t WS_CKV = WS_CQ + (size_t)T * 512 * 2;
constexpr size_t WS_KR = WS_CKV + (size_t)T * 256 * 2;
constexpr size_t WS_DQ = WS_KR + (size_t)T * 64 * 2;
constexpr size_t WS_DK = WS_DQ + (size_t)T * 768 * 2;
constexpr size_t WS_DVT = WS_DK + (size_t)T * 768 * 2;
constexpr size_t WS_QM = WS_DVT + (size_t)T * 768 * 2;
constexpr size_t WS_KN = WS_QM + (size_t)T * 1152 * 2;
constexpr size_t WS_VMT = WS_KN + (size_t)T * 768 * 2;
constexpr size_t WS_MIX = WS_VMT + (size_t)T * 768 * 2;
constexpr size_t WS_CQSS = WS_MIX + (size_t)T * D * 2;
constexpr size_t WS_CKVSS = WS_CQSS + (size_t)T * 8 * 4;
constexpr size_t WS_GW = WS_CKVSS + (size_t)T * 4 * 4;
constexpr size_t WS_LIST = WS_GW + (size_t)T * 2 * 4;
constexpr size_t WS_ACT = WS_LIST + (size_t)NE * LISTCAP * 4;
constexpr size_t WS_Y2 = WS_ACT + (size_t)(2 * T + 256) * EH * 2;
constexpr size_t WS_Y1 = WS_Y2 + (size_t)T * D * 4;
constexpr size_t WS_H2 = WS_Y1 + (size_t)T * D * 4;
constexpr size_t WS_WRH = WS_H2 + (size_t)T * D * 4;
constexpr size_t WS_WRL = WS_WRH + (size_t)NL * 64 * D * 2;
constexpr size_t WS_END = WS_WRL + (size_t)NL * 64 * D * 2;
constexpr int CW_BAR = 4096, CW_TMO = 12288, CW_CNT = 16384, CW_RDY = 32768;

constexpr int LDS_MISC = 135168;
constexpr int LDS_BYTES = 147456;

__device__ __forceinline__ unsigned pk2(float lo, float hi) { f32x2 v = {lo, hi}; return __builtin_bit_cast(unsigned, __builtin_convertvector(v, bfv2)); }
__device__ __forceinline__ f32x4 unpk4(u32x2 a) { return (f32x4){__builtin_bit_cast(float, a.x << 16), __builtin_bit_cast(float, a.x & 0xffff0000u), __builtin_bit_cast(float, a.y << 16), __builtin_bit_cast(float, a.y & 0xffff0000u)}; }
__device__ __forceinline__ float bf2f(unsigned short b) { return __builtin_bit_cast(float, (unsigned)b << 16); }
template <int M> __device__ __forceinline__ float xor_lt32(float v) { return __builtin_bit_cast(float, __builtin_amdgcn_ds_swizzle(__builtin_bit_cast(int, v), (M << 10) | 0x1f)); }
__device__ __forceinline__ float sum32(float v) { const unsigned x = __builtin_bit_cast(unsigned, v); auto r = __builtin_amdgcn_permlane32_swap(x, x, false, false);
    unsigned a = r[0], b = r[1]; asm volatile("" : "+v"(a), "+v"(b));
    return __builtin_bit_cast(float, a) + __builtin_bit_cast(float, b); }
__device__ __forceinline__ float max32(float v) { const unsigned x = __builtin_bit_cast(unsigned, v); auto r = __builtin_amdgcn_permlane32_swap(x, x, false, false);
    unsigned a = r[0], b = r[1]; asm volatile("" : "+v"(a), "+v"(b));
    return fmaxf(__builtin_bit_cast(float, a), __builtin_bit_cast(float, b)); }
__device__ __forceinline__ float wave_sum(float v) {
    v += xor_lt32<1>(v); v += xor_lt32<2>(v); v += xor_lt32<4>(v); v += xor_lt32<8>(v); v += xor_lt32<16>(v);
    return sum32(v);
}
#define LDS_WAIT() asm volatile("s_waitcnt lgkmcnt(0)" ::: "memory")

#define XB_TMO      128
#define XB_XCNT(j)  (256  + 64 * (j))
#define XB_XSUB(j)  (1280 + 64 * (j))
#define XB_XGEN(j)  (2304 + 64 * (j))
#define XB_TOP      3328
#define XB_TOPGEN   3392
#define XCD_BAR_WORDS 3456
#define XB_SPIN_CAP (1u << 18)
__device__ __forceinline__ unsigned xb_ld(unsigned* p)              { return __hip_atomic_load(p, __ATOMIC_RELAXED, __HIP_MEMORY_SCOPE_AGENT); }
__device__ __forceinline__ unsigned xb_add(unsigned* p, unsigned v) { return __hip_atomic_fetch_add(p, v, __ATOMIC_RELAXED, __HIP_MEMORY_SCOPE_AGENT); }
__device__ __forceinline__ unsigned xb_xcc_id() { return (unsigned)__builtin_amdgcn_s_getreg((3 << 11) | 20) & 0xFu; }
#define XB_SPIN(cond, bar) do { unsigned _sp = 0; while (cond) { __builtin_amdgcn_s_sleep(1); \
    if ((++_sp & 255u) == 0u) { if (xb_ld(&(bar)[XB_TMO])) break; if (_sp > XB_SPIN_CAP) { atomicAdd(&(bar)[XB_TMO], 1u); break; } } } } while (0)
struct XcdBarrier { unsigned* bar; unsigned x; volatile LAS unsigned* st; };
__device__ __forceinline__ XcdBarrier xcd_barrier_post(unsigned* bar, volatile LAS unsigned* st) {
    XcdBarrier b; b.bar = bar; b.x = xb_xcc_id(); b.st = st;
    if (threadIdx.x == 0) (void)xb_add(&bar[XB_XCNT(b.x)], 1u);
    return b;
}
__device__ __forceinline__ void xcd_barrier_complete(unsigned* bar, unsigned x, unsigned& nloc, unsigned& nx) {
    const unsigned G = gridDim.x * gridDim.y * gridDim.z;
    unsigned sum, cnt, mine, sp = 0u;
    for (;;) {
        sum = 0u; cnt = 0u; mine = 0u;
#pragma unroll
        for (unsigned j = 0; j < 16; ++j) { const unsigned c = xb_ld(&bar[XB_XCNT(j)]); sum += c; cnt += (c > 0u) ? 1u : 0u; mine = (j == x) ? c : mine; }
        if (sum == G) break;
        __builtin_amdgcn_s_sleep(1);
        if ((++sp & 255u) == 0u) { if (xb_ld(&bar[XB_TMO])) break; if (sp > XB_SPIN_CAP) { atomicAdd(&bar[XB_TMO], 1u); break; } }
    }
    nloc = mine > 0u ? mine : 1u; nx = cnt > 0u ? cnt : 1u;
}
__device__ __forceinline__ void xcd_barrier(const XcdBarrier& b) {
    asm volatile("s_waitcnt vmcnt(0)" ::: "memory");
    __syncthreads();
    if (threadIdx.x == 0) {
        unsigned* bar = b.bar;
        __builtin_amdgcn_s_waitcnt(0);
        unsigned nloc = b.st[0], nx = b.st[1];
        if (nloc == 0u) { xcd_barrier_complete(bar, b.x, nloc, nx); b.st[0] = nloc; b.st[1] = nx; }
        const unsigned old = xb_add(&bar[XB_XSUB(b.x)], 1u);
        const unsigned gen = old / nloc;
        if (old + 1u == (gen + 1u) * nloc) {
            __builtin_amdgcn_fence(__ATOMIC_RELEASE, "agent");
            asm volatile("s_waitcnt vmcnt(0)" ::: "memory");
            const unsigned og = xb_add(&bar[XB_TOP], 1u);
            const unsigned tg = og / nx;
            if (og + 1u == (tg + 1u) * nx) xb_add(&bar[XB_TOPGEN], 1u);
            else XB_SPIN(xb_ld(&bar[XB_TOPGEN]) == tg, bar);
            __builtin_amdgcn_fence(__ATOMIC_ACQUIRE, "agent");
            xb_add(&bar[XB_XGEN(b.x)], 1u);
            asm volatile("s_waitcnt vmcnt(0)" ::: "memory");
        } else {
            XB_SPIN(xb_ld(&bar[XB_XGEN(b.x)]) == gen, bar);
            __builtin_amdgcn_fence(__ATOMIC_ACQUIRE, "agent");
            asm volatile("s_waitcnt vmcnt(0)" ::: "memory");
        }
    }
    __syncthreads();
}

namespace pg8 {
constexpr int BM = 256, BK = 64, HALF = 128, HTB = HALF * BK * 2, STAGE_BYTES = 8 * HTB, NXCD = 8, WGM = 8;
__host__ __device__ __forceinline__ int lds_byte(int r, int c) { const int st = (r >> 4) * 2 + (c >> 5), rr = r & 15, cc = c & 31, ob = rr * 64 + cc * 2; return st * 1024 + (ob ^ (((ob >> 9) & 1) << 5)); }
__host__ __device__ __forceinline__ void stage_rc(int b, int& R, int& C) { const int st = b / 1024, sb = b % 1024, swz = sb ^ (((sb >> 9) & 1) << 5); R = (st >> 1) * 16 + swz / 64; C = (st & 1) * 32 + (swz % 64) / 2; }
__host__ __device__ __forceinline__ int perm32(int rho) { const int n = rho >> 4, i = rho & 15; return 8 * (i >> 2) + 4 * n + (i & 3); }

struct Unit { const char* a; const char* b; const int* rowmap; int nrows; int p0, p1, p2, p3; };
struct Gemm { int K, lda, ldb; };

__device__ __forceinline__ void tile_of(int L, int nM, int nN, int& pm, int& pn) {
    const int nwg = nM * nN; int wgid = L;
    { const int q = nwg / NXCD, r = nwg % NXCD, xcd = wgid % NXCD, off = wgid / NXCD; wgid = (xcd < r ? xcd * (q + 1) : r * (q + 1) + (xcd - r) * q) + off; }
    const int nig = WGM * nN, gid = wgid / nig, fm = gid * WGM, gsz = (nM - fm) < WGM ? (nM - fm) : WGM;
    pm = fm + ((wgid % nig) % gsz); pn = (wgid % nig) / gsz;
}

template <class Epi, class Sched, bool GATHER, bool HOOK = false>
__device__ __forceinline__ void gemm_phase(LAS unsigned char* lds, const Gemm g, const Sched& S, const Epi& E) {
    int tid_ = threadIdx.x; asm volatile("" : "+v"(tid_));
    const int tid = tid_, wid = __builtin_amdgcn_readfirstlane(tid >> 6), lane = tid & 63, wr = wid >> 2, wc = wid & 3, fr = lane & 15, fq = lane >> 4;
    const int K = g.K, nt = K / BK;
    unsigned voffA[2], voffB[2];
#pragma unroll
    for (int i = 0; i < 2; ++i) { int R, C; stage_rc(tid * 16 + i * 8192, R, C); const int Rb = Epi::PERM ? ((R & ~31) + perm32(R & 31)) : R;
        voffA[i] = (unsigned)(R * g.lda + C) * 2u; voffB[i] = (unsigned)(Rb * g.ldb + C) * 2u; }
    const size_t kstep = (size_t)(BK * 2);
    const size_t hstepA = (size_t)HALF * g.lda * 2, hstepB = (size_t)HALF * g.ldb * 2;
    const unsigned ldsw = (unsigned)wid * 1024u;
    const int aoff = lds_byte(wr * 64 + fr, fq * 8), boff = lds_byte(wc * 32 + fr, fq * 8);
    unsigned ga[2][2], gn[2][2];
#define PG8_SA(b, h) (((b) * 2 + (h)) * HTB)
#define PG8_SB(b, h) ((4 + (b) * 2 + (h)) * HTB)
#define PG8_GLDS(src, dst) __builtin_amdgcn_global_load_lds((const unsigned*)(src), (LAS unsigned*)(dst), 16, 0, 0)
#define PG8_STAGE_B(bufoff, gbase) do { _Pragma("unroll") for (int _i = 0; _i < 2; ++_i) PG8_GLDS((const char*)(gbase) + voffB[_i], lds + (bufoff) + ldsw + _i * 8192); } while (0)
#define PG8_STAGE_A(bufoff, gbase, hh, SEL) do { _Pragma("unroll") for (int _i = 0; _i < 2; ++_i) { \
        if constexpr (GATHER) PG8_GLDS((const char*)(gbase) + ((SEL) ? gn[hh][_i] : ga[hh][_i]), lds + (bufoff) + ldsw + _i * 8192); \
        else PG8_GLDS((const char*)(gbase) + (hh) * hstepA + voffA[_i], lds + (bufoff) + ldsw + _i * 8192); } } while (0)
#define PG8_GMAP(u, O) do { if constexpr (GATHER) { _Pragma("unroll") for (int _h = 0; _h < 2; ++_h) _Pragma("unroll") for (int _i = 0; _i < 2; ++_i) { \
        int _R, _C; stage_rc(tid * 16 + _i * 8192, _R, _C); const int _r = _R + 128 * _h; const int _e = (_r < (u).nrows) ? ((u).rowmap[_r] >> 1) : 0; O[_h][_i] = (unsigned)(_e * g.lda + _C) * 2u; } } } while (0)
#define PG8_LDA(dst, b, h) do { _Pragma("unroll") for (int m = 0; m < 4; ++m) _Pragma("unroll") for (int k = 0; k < 2; ++k) dst[m][k] = *(const LAS bf16x8*)(lds + PG8_SA(b, h) + aoff + m * 2048 + k * 1024); } while (0)
#define PG8_LDB(dst, b, h) do { _Pragma("unroll") for (int n = 0; n < 2; ++n) _Pragma("unroll") for (int k = 0; k < 2; ++k) dst[n][k] = *(const LAS bf16x8*)(lds + PG8_SB(b, h) + boff + n * 2048 + k * 1024); } while (0)
#define PG8_MMA(ai, bj, At, Bt) do { __builtin_amdgcn_s_setprio(1); _Pragma("unroll") for (int m = 0; m < 4; ++m) _Pragma("unroll") for (int n = 0; n < 2; ++n) _Pragma("unroll") for (int k = 0; k < 2; ++k) \
        acc[ai][bj][m][n] = __builtin_amdgcn_mfma_f32_16x16x32_bf16(Bt[n][k], At[m][k], acc[ai][bj][m][n], 0, 0, 0); __builtin_amdgcn_s_setprio(0); } while (0)
#define PG8_WAIT_V(n) asm volatile("s_waitcnt vmcnt(" #n ")" ::: "memory")
#define PG8_WAIT_L(n) asm volatile("s_waitcnt lgkmcnt(" #n ")" ::: "memory")
#define PG8_BAR __builtin_amdgcn_s_barrier()
#define PG8_SCHED __builtin_amdgcn_sched_barrier(0)
    Unit cur, nxt; int ui = 0;
    if (!S.next(0, cur)) return;
    if constexpr (HOOK) S.a_ready(cur);
    f32x4 acc[2][2][4][2];
#pragma unroll
    for (int a = 0; a < 2; ++a)
#pragma unroll
        for (int b = 0; b < 2; ++b)
#pragma unroll
            for (int m = 0; m < 4; ++m)
#pragma unroll
                for (int n = 0; n < 2; ++n) acc[a][b][m][n] = (f32x4){0.f, 0.f, 0.f, 0.f};
    bf16x8 At[4][2], B0[2][2], B1[2][2];
    const char* cA = cur.a; const char* cB = cur.b;
    PG8_GMAP(cur, ga);
    PG8_STAGE_B(PG8_SB(0, 0), cB); PG8_STAGE_A(PG8_SA(0, 0), cA, 0, false); PG8_STAGE_B(PG8_SB(0, 1), cB + hstepB); PG8_STAGE_A(PG8_SA(0, 1), cA, 1, false);
    if (wr == 1) PG8_BAR;
    PG8_WAIT_V(4); PG8_BAR;
    PG8_STAGE_B(PG8_SB(1, 0), cB + kstep); PG8_STAGE_A(PG8_SA(1, 0), cA + kstep, 0, false); PG8_STAGE_B(PG8_SB(1, 1), cB + hstepB + kstep);
    PG8_WAIT_V(6); PG8_BAR;
    for (;;) {
        const bool has_next = S.next(ui + 1, nxt);
        const char* nA = has_next ? nxt.a : cA; const char* nB = has_next ? nxt.b : cB;
        if constexpr (GATHER) { if (has_next) { PG8_GMAP(nxt, gn); } else {
#pragma unroll
            for (int _h = 0; _h < 2; ++_h)
#pragma unroll
                for (int _i = 0; _i < 2; ++_i) gn[_h][_i] = ga[_h][_i]; } }
        for (int t = 0; t < nt; t += 2) {
            const bool last = (t == nt - 2);
            if constexpr (HOOK) { if (last && has_next) S.a_ready(nxt); }
            const char* a1 = cA + (size_t)(t + 1) * kstep;
            const char* a2 = last ? nA : cA + (size_t)(t + 2) * kstep; const char* b2 = last ? nB : cB + (size_t)(t + 2) * kstep;
            const char* a3 = a2 + kstep; const char* b3 = b2 + kstep;
            PG8_LDB(B0, 0, 0); PG8_SCHED; PG8_LDA(At, 0, 0); PG8_STAGE_A(PG8_SA(1, 1), a1, 1, false);
            PG8_WAIT_L(8); PG8_BAR; PG8_WAIT_L(0); PG8_MMA(0, 0, At, B0); PG8_BAR; PG8_SCHED;
            PG8_LDB(B1, 0, 1); PG8_STAGE_B(PG8_SB(0, 0), b2);
            PG8_BAR; PG8_WAIT_L(0); PG8_MMA(0, 1, At, B1); PG8_BAR;
            PG8_LDA(At, 0, 1); PG8_STAGE_A(PG8_SA(0, 0), a2, 0, last);
            PG8_BAR; PG8_WAIT_L(0); PG8_MMA(1, 0, At, B0); PG8_BAR; PG8_SCHED;
            PG8_STAGE_B(PG8_SB(0, 1), b2 + hstepB);
            PG8_WAIT_V(6); PG8_BAR; PG8_MMA(1, 1, At, B1); PG8_BAR;
            PG8_LDB(B0, 1, 0); PG8_SCHED; PG8_LDA(At, 1, 0); PG8_STAGE_A(PG8_SA(0, 1), a2, 1, last);
            PG8_WAIT_L(8); PG8_BAR; PG8_WAIT_L(0); PG8_MMA(0, 0, At, B0); PG8_BAR; PG8_SCHED;
            PG8_LDB(B1, 1, 1); PG8_STAGE_B(PG8_SB(1, 0), b3);
            PG8_BAR; PG8_WAIT_L(0); PG8_MMA(0, 1, At, B1); PG8_BAR;
            PG8_LDA(At, 1, 1); PG8_STAGE_A(PG8_SA(1, 0), a3, 0, last);
            PG8_BAR; PG8_WAIT_L(0); PG8_MMA(1, 0, At, B0); PG8_BAR; PG8_SCHED;
            PG8_STAGE_B(PG8_SB(1, 1), b3 + hstepB);
            PG8_WAIT_V(6); PG8_BAR; PG8_MMA(1, 1, At, B1); PG8_BAR;
        }
        { int le = threadIdx.x & 63; asm volatile("" : "+v"(le));
          E(acc, cur, wr, wc, le & 15, le >> 4); }
        if (!has_next) break;
#pragma unroll
        for (int a = 0; a < 2; ++a)
#pragma unroll
            for (int b = 0; b < 2; ++b)
#pragma unroll
                for (int m = 0; m < 4; ++m)
#pragma unroll
                    for (int n = 0; n < 2; ++n) acc[a][b][m][n] = (f32x4){0.f, 0.f, 0.f, 0.f};
        cur = nxt; cA = nA; cB = nB; ++ui;
        if constexpr (GATHER) {
#pragma unroll
            for (int _h = 0; _h < 2; ++_h)
#pragma unroll
                for (int _i = 0; _i < 2; ++_i) ga[_h][_i] = gn[_h][_i]; }
    }
    PG8_WAIT_V(0);
    if (wr == 0) PG8_BAR;
    PG8_BAR;
#undef PG8_SA
#undef PG8_SB
#undef PG8_GLDS
#undef PG8_STAGE_A
#undef PG8_STAGE_B
#undef PG8_GMAP
#undef PG8_LDA
#undef PG8_LDB
#undef PG8_MMA
#undef PG8_WAIT_V
#undef PG8_WAIT_L
#undef PG8_BAR
#undef PG8_SCHED
}

__device__ __forceinline__ void store_tile_bf16(const f32x4 (&acc)[2][2][4][2], bf16_t* dst, size_t ld, int row0, int col0, float scale, int wr, int wc, int fr, int fq) {
#pragma unroll
    for (int ai = 0; ai < 2; ++ai)
#pragma unroll
        for (int m = 0; m < 4; ++m) { bf16_t* rowp = dst + (size_t)(row0 + ai * HALF + wr * 64 + m * 16 + fr) * ld + col0 + wc * 32 + 8 * fq;
#pragma unroll
            for (int bj = 0; bj < 2; ++bj) { const f32x4 v0 = acc[ai][bj][m][0] * scale, v1 = acc[ai][bj][m][1] * scale;
                u32x4 w; w.x = pk2(v0[0], v0[1]); w.y = pk2(v0[2], v0[3]); w.z = pk2(v1[0], v1[1]); w.w = pk2(v1[2], v1[3]);
                *(u32x4*)(rowp + bj * HALF) = w; } }
}
}

struct Args { const float* in[23]; float* out; unsigned char* ws; int g_lo, g_hi, use_bar, pad; };
enum { IN_X = 0, IN_POS, IN_ATTN_NORM, IN_W_IN, IN_POOL_W, IN_POOL_SCALE, IN_Q_NORM, IN_W_UQ, IN_KV_NORM, IN_W_UKV, IN_LAMBDA, IN_SUBLN, IN_REL_BIAS, IN_W_OUT, IN_FFN_NORM,
       IN_RG_W, IN_RG_B, IN_RE_W, IN_RE_B, IN_EW_GATE, IN_EW_UP, IN_EW_DOWN, IN_FINAL_NORM };

struct Frame {
    LAS unsigned char* lds;
    volatile LAS unsigned* MISC;
    unsigned* ctl;
    unsigned char* ws;
    unsigned char* ws0;
    int tid, lane, wave, vcu, G, bx;
};
constexpr int MISC_PTAB = 192;
__device__ __forceinline__ const float* inptr(const Frame& F, int i) {
    const unsigned lo = __builtin_amdgcn_readfirstlane(F.MISC[MISC_PTAB + 2 * i]), hi = __builtin_amdgcn_readfirstlane(F.MISC[MISC_PTAB + 2 * i + 1]);
    return (const float*)(GAS const float*)(((unsigned long long)hi << 32) | lo);
}

__device__ __forceinline__ void frame_refresh(Frame& F) {
    int t = threadIdx.x; asm volatile("" : "+v"(t)); F.tid = t; F.lane = t & 63; F.wave = __builtin_amdgcn_readfirstlane(t >> 6);
    int bx = blockIdx.x, G = gridDim.x; asm volatile("" : "+s"(bx), "+s"(G)); F.bx = bx; F.G = G; F.vcu = (G % 8 == 0) ? (bx % 8) * (G / 8) + bx / 8 : bx;
    GAS unsigned char* w = (GAS unsigned char*)F.ws0; asm volatile("" : "+s"(w)); F.ws = (unsigned char*)w; F.ctl = (unsigned*)(F.ws + WS_CTL);
    LAS unsigned char* lb = F.lds; asm volatile("" : "+s"(lb)); F.MISC = (volatile LAS unsigned*)(lb + LDS_MISC);
}
__device__ __forceinline__ void tr_write(bf16_t* WT, int ldo, int n0, int k0, LAS float* scr, int lane) {
    LDS_WAIT(); asm volatile("" ::: "memory");
#pragma unroll
    for (int it = 0; it < 8; ++it) { const int n = 8 * it + (lane >> 3), kc = lane & 7; const LAS float* s = scr + (8 * kc) * 65 + n;
        u32x4 o; o.x = pk2(s[0], s[65]); o.y = pk2(s[2 * 65], s[3 * 65]); o.z = pk2(s[4 * 65], s[5 * 65]); o.w = pk2(s[6 * 65], s[7 * 65]);
        __builtin_nontemporal_store(o, (u32x4*)(WT + (size_t)(n0 + n) * ldo + k0 + 8 * kc)); }
    LDS_WAIT(); asm volatile("" ::: "memory");
}
__device__ __forceinline__ void tr_item(const float* W, int ldw, int k0, int c0, bf16_t* WT, int ldo, int n0, const float* kscale, LAS float* scr, int lane) {
#pragma unroll
    for (int i = 0; i < 16; ++i) { const int k = 4 * i + (lane >> 4); f32x4 v = __builtin_nontemporal_load((const f32x4*)(W + (size_t)(k0 + k) * ldw + c0 + 4 * (lane & 15)));
        if (kscale) v = v * kscale[k0 + k];
        LAS float* d = scr + k * 65 + 4 * (lane & 15); d[0] = v[0]; d[1] = v[1]; d[2] = v[2]; d[3] = v[3]; }
    tr_write(WT, ldo, n0, k0, scr, lane);
}
__device__ __forceinline__ void tr_item_map(const float* W, int ldw, int k0, int srccol, bf16_t* WT, int ldo, int n0, const float* kscale, LAS float* scr, int lane) {
#pragma unroll 8
    for (int k = 0; k < 64; ++k) { float v = 0.f; if (srccol >= 0) { v = W[(size_t)(k0 + k) * ldw + srccol]; if (kscale) v *= kscale[k0 + k]; } scr[k * 65 + lane] = v; }
    tr_write(WT, ldo, n0, k0, scr, lane);
}

struct XItem { const float* src; bf16_t* dst; int ldw, ldo; };
constexpr int XJ_GU = 32 * 2 * 8 * 32, XJ_D = 32 * 32 * 8, XJ_L = XJ_GU + XJ_D;
__device__ __forceinline__ XItem x_item(Frame& F, int x) {
    unsigned char* ws = F.ws; const int l = x / XJ_L; int r = x % XJ_L; XItem it;
    if (r < XJ_GU) {
        const int e = r / 512, q = r % 512, isup = q >> 8, ntile = q & 7, kt = (q >> 3) & 31, c0 = ntile * 64, n0 = (c0 >> 7) * 256 + isup * 128 + (c0 & 127);
        it.src = inptr(F, isup ? IN_EW_UP : IN_EW_GATE) + ((size_t)l * NE + e) * D * EH + (size_t)(kt * 64) * EH + c0; it.ldw = EH;
        it.dst = (bf16_t*)(ws + WS_WGU + ((size_t)l * NE + e) * SZ_WGU1) + (size_t)n0 * D + kt * 64; it.ldo = D; }
    else { r -= XJ_GU;
        const int e = r / 256, q = r % 256, ntile = q & 31, kt = q >> 5;
        it.src = inptr(F, IN_EW_DOWN) + ((size_t)l * NE + e) * EH * D + (size_t)(kt * 64) * D + ntile * 64; it.ldw = D;
        it.dst = (bf16_t*)(ws + WS_WD + ((size_t)l * NE + e) * SZ_WD1) + (size_t)(ntile * 64) * EH + kt * 64; it.ldo = EH; }
    return it;
}
#define X_LOAD(R, IT) do { _Pragma("unroll") for (int _i = 0; _i < 16; ++_i) R[_i] = __builtin_nontemporal_load((const f32x4*)((IT).src + (size_t)(4 * _i + (lane >> 4)) * (IT).ldw + 4 * (lane & 15))); } while (0)
#define X_OUT(R, IT) do { _Pragma("unroll") for (int _i = 0; _i < 16; ++_i) { LAS float* _d = scr + (4 * _i + (lane >> 4)) * 65 + 4 * (lane & 15); _d[0] = R[_i][0]; _d[1] = R[_i][1]; _d[2] = R[_i][2]; _d[3] = R[_i][3]; } \
        tr_write((IT).dst, (IT).ldo, 0, 0, scr, lane); } while (0)

__device__ __forceinline__ void p0_prologue(Frame& F) {
    frame_refresh(F);
    unsigned char* ws = F.ws;
    {
        LAS float* AsT = (LAS float*)F.lds;
        LAS float* Pw = (LAS float*)(F.lds + 128 * 68 * 4);
        for (int it = F.bx; it < NL * 4 * 32; it += F.G) {
            const int l = it / 128, g = (it / 32) & 3, kb = it & 31;
            const float* win = inptr(F, IN_W_IN) + (size_t)l * D * NIN; const float* pw = inptr(F, IN_POOL_W) + (size_t)(l * 4 + g) * 128 * 128; const float* ps = inptr(F, IN_POOL_SCALE) + l * 512 + g * 128;
            __syncthreads();
#pragma unroll
            for (int i = 0; i < 4; ++i) { const int idx = F.tid + 512 * i, row = idx >> 5, c4 = idx & 31; const f32x4 v = *(const f32x4*)(win + (size_t)(kb * 64 + row) * NIN + g * 128 + 4 * c4);
                LAS float* d = AsT + (4 * c4) * 68 + row; d[0] = v[0]; d[68] = v[1]; d[136] = v[2]; d[204] = v[3]; }
#pragma unroll
            for (int i = 0; i < 8; ++i) { const int idx = F.tid + 512 * i, c = idx >> 5, d4 = idx & 31; f32x4 v = *(const f32x4*)(pw + c * 128 + 4 * d4); const f32x4 sc = *(const f32x4*)(ps + 4 * d4);
                *(LAS f32x4*)(Pw + c * 128 + 4 * d4) = v * sc; }
            __syncthreads();
            const int kg = F.tid & 15, d4 = F.tid >> 4; f32x4 acc[4];
#pragma unroll
            for (int i = 0; i < 4; ++i) acc[i] = (f32x4){0.f, 0.f, 0.f, 0.f};
#pragma unroll 4
            for (int c = 0; c < 128; ++c) { const f32x4 pv = *(const LAS f32x4*)(Pw + c * 128 + 4 * d4), av = *(const LAS f32x4*)(AsT + c * 68 + 4 * kg);
#pragma unroll
                for (int i = 0; i < 4; ++i) acc[i] += pv * av[i]; }
            bf16_t* o = (bf16_t*)(ws + WS_WIN + (size_t)l * SZ_WIN) + (size_t)(g * 128 + 4 * d4) * D + kb * 64 + 4 * kg;
#pragma unroll
            for (int j = 0; j < 4; ++j) { u32x2 w; w.x = pk2(acc[0][j], acc[1][j]); w.y = pk2(acc[2][j], acc[3][j]); *(u32x2*)(o + (size_t)j * D) = w; }
        }
        __syncthreads();
    }
    {
        LAS float* scr = (LAS float*)(F.lds + F.wave * 16640);
        const int gw = F.vcu * NWAVES + F.wave, NGW = F.G * NWAVES, lane = F.lane;
        constexpr int J_WO = 32 * 32, J_A = 12 * 32, J_KR = 32, J_B = 24 * 32, J_DV = 12 * 32, J_UQ = 20 * 8, J_K = 12 * 4, J_V = 12 * 4;
        constexpr int J_L = J_WO + J_A + J_KR + J_B + J_DV + J_UQ + J_K + J_V;
        {
            f32x4 RA[16], RB[16]; int x = gw; XItem ia = x_item(F, x < NL * XJ_L ? x : 0), ib;
            if (x < NL * XJ_L) X_LOAD(RA, ia);
            while (x < NL * XJ_L) {
                const int x1 = x + NGW; if (x1 < NL * XJ_L) { ib = x_item(F, x1); X_LOAD(RB, ib); }
                X_OUT(RA, ia);
                if (x1 >= NL * XJ_L) break;
                const int x2 = x1 + NGW; if (x2 < NL * XJ_L) { ia = x_item(F, x2); X_LOAD(RA, ia); }
                X_OUT(RB, ib);
                x = x2;
            }
        }
        for (int it = gw; it < NL * J_L; it += NGW) {
            const int l = it / J_L; int r = it % J_L;
            const float* win = inptr(F, IN_W_IN) + (size_t)l * D * NIN;
            bf16_t* WinT = (bf16_t*)(ws + WS_WIN + (size_t)l * SZ_WIN);
            if (r < J_WO) { const int ntile = r >> 5, kt = r & 31;
                tr_item(inptr(F, IN_W_OUT) + (size_t)l * D * D, D, kt * 64, ntile * 64, (bf16_t*)(ws + WS_WOUT + (size_t)l * SZ_WOUT), D, ntile * 64, nullptr, scr, lane); continue; }
            r -= J_WO;
            if (r < J_A) { const int ntile = r >> 5, kt = r & 31;
                tr_item(win, NIN, kt * 64, 512 + ntile * 64, WinT, D, 512 + ntile * 64, nullptr, scr, lane); continue; }
            r -= J_A;
            if (r < J_KR) { const int kt = r;
                tr_item_map(win, NIN, kt * 64, 1280 + (lane >> 1) + 32 * (lane & 1), WinT, D, 1280, nullptr, scr, lane); continue; }
            r -= J_KR;
            if (r < J_B) { const int ntile = r >> 5, kt = r & 31;
                tr_item(win, NIN, kt * 64, 1344 + ntile * 64, WinT, D, 1536 + ntile * 64, nullptr, scr, lane); continue; }
            r -= J_B;
            if (r < J_DV) { const int ntile = r >> 5, kt = r & 31;
                tr_item(win, NIN, kt * 64, 2880 + ntile * 64, (bf16_t*)(ws + WS_WDV + (size_t)l * SZ_WDV), D, ntile * 64, nullptr, scr, lane); continue; }
            r -= J_DV;
            if (r < J_UQ) { const int ntile = r >> 3, kt = r & 7;
                const int n = ntile * 64 + lane; int src = -1;
                if (n < 1152) { const int hd = n / 192, w = n % 192; src = hd * 192 + (w < 128 ? w : 128 + ((w - 128) >> 1) + 32 * ((w - 128) & 1)); }
                tr_item_map(inptr(F, IN_W_UQ) + (size_t)l * 512 * 1152, 1152, kt * 64, src, (bf16_t*)(ws + WS_WUQ + (size_t)l * SZ_WUQ), 512, ntile * 64, inptr(F, IN_Q_NORM) + l * 512, scr, lane); continue; }
            r -= J_UQ;
            {
                const bool isv = r >= J_K; if (isv) r -= J_K;
                const int ntile = r >> 2, kt = r & 3, n0 = ntile * 64, hd = n0 >> 7, c0 = hd * 256 + (isv ? 128 : 0) + (n0 & 127);
                tr_item(inptr(F, IN_W_UKV) + (size_t)l * 256 * 1536, 1536, kt * 64, c0, (bf16_t*)(ws + (isv ? WS_WV : WS_WK) + (size_t)l * SZ_WK), 256, n0, inptr(F, IN_KV_NORM) + l * 256, scr, lane);
            }
        }
        for (int l = 0; l < NL; ++l) { u32x4* z = (u32x4*)((bf16_t*)(ws + WS_WIN + (size_t)l * SZ_WIN) + (size_t)1344 * D);
            for (int i = gw * 64 + lane; i < 192 * D / 8; i += NGW * 64) z[i] = (u32x4){0u, 0u, 0u, 0u}; }
        const int* pos = (const int*)inptr(F, IN_POS);
        for (int i = gw * 64 + lane; i < T * 32; i += NGW * 64) { const int t = i >> 5, f = i & 31;
            const double inv = pow(10000.0, -(double)(2 * f) / 64.0); const double ang = (double)pos[t] * inv;
            ((float*)(ws + WS_COS))[i] = (float)cos(ang); ((float*)(ws + WS_SIN))[i] = (float)sin(ang); }
        for (int i = gw * 64 + lane; i < 6 * 132; i += NGW * 64) { const int hd = i / 132, n = i % 132; float v = 0.f;
            if (n <= 128) { int bkt; if (n < 16) bkt = n; else { bkt = 16 + (int)(log((double)n / 16.0) / log(8.0) * 16.0); bkt = bkt < 31 ? bkt : 31; }
                v = inptr(F, IN_REL_BIAS)[bkt * 6 + hd] * LOG2E; }
            ((float*)(ws + WS_LUT))[i] = v; }
        for (int i = gw * 64 + lane; i < NL * 64 * D; i += NGW * 64) { const int l = i / (64 * D), c = (i / D) & 63, k = i & (D - 1); float v = 0.f;
            if (c < 4) v = inptr(F, IN_RG_W)[((size_t)l * D + k) * 4 + c]; else if (c < 36) v = inptr(F, IN_RE_W)[((size_t)l * D + k) * 32 + c - 4];
            v *= inptr(F, IN_FFN_NORM)[l * D + k];
            const unsigned hi = pk2(v, 0.f) & 0xffffu; const float rem = v - __builtin_bit_cast(float, hi << 16);
            const int fo = (((l * 8 + (k >> 8)) * 16 + ((k >> 4) & 15)) * 4 + (c >> 5)) * 512 + ((c & 31) + 32 * ((k >> 3) & 1)) * 8 + (k & 7);
            ((bf16_t*)(ws + WS_WRH))[fo] = (bf16_t)hi; ((bf16_t*)(ws + WS_WRH))[fo + 1024] = (bf16_t)(pk2(rem, 0.f) & 0xffffu); }
        for (int i = gw * 64 + lane; i < NB * 32; i += NGW * 64) { int mx = pos[i * 64]; for (int j = 1; j < 64; ++j) { const int p = pos[i * 64 + j]; mx = p > mx ? p : mx; } ((int*)(ws + WS_TMAX))[i] = mx; }
        const float* x = inptr(F, IN_X); bf16_t* h = (bf16_t*)(ws + WS_H); bf16_t* u = (bf16_t*)(ws + WS_XB); const float* gn = inptr(F, IN_ATTN_NORM);
        f32x4 g0[8];
#pragma unroll
        for (int j = 0; j < 8; ++j) g0[j] = ((const f32x4*)gn)[lane + 64 * j];
        for (int m = gw; m < T; m += NGW) {
            const f32x4* xr = (const f32x4*)(x + (size_t)m * D) + lane; u32x2* hr = (u32x2*)(h + (size_t)m * D) + lane; f32x4 v[8]; float s = 0.f;
#pragma unroll
            for (int j = 0; j < 8; ++j) v[j] = xr[64 * j];
            asm volatile("" ::: "memory");
#pragma unroll
            for (int j = 0; j < 8; ++j) { { u32x2 hw; hw.x = pk2(v[j][0], v[j][1]); hw.y = pk2(v[j][2], v[j][3]); hr[64 * j] = hw; } s += (v[j][0] * v[j][0] + v[j][1] * v[j][1]) + (v[j][2] * v[j][2] + v[j][3] * v[j][3]); }
            const float rs = 1.0f / sqrtf(wave_sum(s) * (1.0f / D) + EPS);
            u32x2* o = (u32x2*)(u + (size_t)m * D) + lane;
#pragma unroll
            for (int j = 0; j < 8; ++j) { const f32x4 gg = g0[j]; u32x2 w; w.x = pk2(v[j][0] * rs * gg[0], v[j][1] * rs * gg[1]); w.y = pk2(v[j][2] * rs * gg[2], v[j][3] * rs * gg[3]); o[64 * j] = w; }
        }
    }
}

enum { K1_ZP = 0, K1_CQ, K1_CKV, K1_KR, K1_DQ, K1_DK, K1_DVT };
struct SchedP1 {
    int G, c, l; unsigned char* ws;
    __device__ __forceinline__ bool next(int i, pg8::Unit& U) const {
        const int L = i * G + c; if (L >= 480) return false;
        const char* u = (const char*)(ws + WS_XB); const char* win = (const char*)(ws + WS_WIN + (size_t)l * SZ_WIN); const char* wdv = (const char*)(ws + WS_WDV + (size_t)l * SZ_WDV);
        U.rowmap = nullptr; U.nrows = 256; U.p3 = 0;
        if (L < 384) { int pm, pn; pg8::tile_of(L, 32, 12, pm, pn);
            U.a = u + (size_t)pm * 256 * D * 2; U.b = win + (size_t)pn * 256 * D * 2; U.p1 = 256 * pm;
            if (pn < 2) { U.p0 = K1_ZP; U.p2 = 256 * pn; } else if (pn < 4) { U.p0 = K1_CQ; U.p2 = 256 * (pn - 2); } else if (pn == 4) { U.p0 = K1_CKV; U.p2 = 0; }
            else if (pn == 5) { U.p0 = K1_KR; U.p2 = 0; } else if (pn < 9) { U.p0 = K1_DQ; U.p2 = 256 * (pn - 6); } else { U.p0 = K1_DK; U.p2 = 256 * (pn - 9); }
        } else { const int Ls = L - 384, pm = Ls % 3, pn = Ls / 3;
            U.a = wdv + (size_t)pm * 256 * D * 2; U.b = u + (size_t)pn * 256 * D * 2; U.p0 = K1_DVT; U.p1 = 256 * pm; U.p2 = 256 * pn; }
        return true;
    }
};
struct EpiP1 {
    static constexpr bool PERM = true;
    unsigned char* ws;
    __device__ __forceinline__ void operator()(const f32x4 (&acc)[2][2][4][2], const pg8::Unit& U, int wr, int wc, int fr, int fq) const {
        const int kind = U.p0, row0 = U.p1, col0 = U.p2;
        bf16_t *zp = (bf16_t*)(ws + WS_ZP), *cq = (bf16_t*)(ws + WS_CQ), *ckv = (bf16_t*)(ws + WS_CKV), *kr = (bf16_t*)(ws + WS_KR), *dq = (bf16_t*)(ws + WS_DQ), *dk = (bf16_t*)(ws + WS_DK), *dvT = (bf16_t*)(ws + WS_DVT);
        float *cqss = (float*)(ws + WS_CQSS), *ckvss = (float*)(ws + WS_CKVSS); const float *cs = (const float*)(ws + WS_COS), *sn = (const float*)(ws + WS_SIN);
        if (kind == K1_ZP) { pg8::store_tile_bf16(acc, zp, 512, row0, col0, 1.0f, wr, wc, fr, fq); }
        else if (kind == K1_CQ || kind == K1_CKV) {
            if (kind == K1_CQ) pg8::store_tile_bf16(acc, cq, 512, row0, col0, 1.0f, wr, wc, fr, fq); else pg8::store_tile_bf16(acc, ckv, 256, row0, 0, 1.0f, wr, wc, fr, fq);
            float* ss = (kind == K1_CQ) ? cqss : ckvss; const int ns = (kind == K1_CQ) ? 8 : 4, slot = (kind == K1_CQ) ? (col0 >> 8) * 4 + wc : wc;
#pragma unroll
            for (int ai = 0; ai < 2; ++ai)
#pragma unroll
                for (int m = 0; m < 4; ++m) { float s = 0.f;
#pragma unroll
                    for (int bj = 0; bj < 2; ++bj)
#pragma unroll
                        for (int n = 0; n < 2; ++n) { const f32x4 x = acc[ai][bj][m][n]; s += (x[0] * x[0] + x[1] * x[1]) + (x[2] * x[2] + x[3] * x[3]); }
                    s += xor_lt32<16>(s); s = sum32(s);
                    if (fq == 0) ss[(size_t)(row0 + ai * 128 + wr * 64 + m * 16 + fr) * ns + slot] = s; }
        }
        else if (kind == K1_KR) {
            if (wc < 2) {
#pragma unroll
                for (int ai = 0; ai < 2; ++ai) { f32x4 cb[4], sb[4];
#pragma unroll
                    for (int i = 0; i < 4; ++i) { const int row = row0 + ai * 128 + wr * 64 + i * 16 + fr; cb[i] = *(const f32x4*)(cs + (size_t)row * 32 + 16 * wc + 4 * fq); sb[i] = *(const f32x4*)(sn + (size_t)row * 32 + 16 * wc + 4 * fq); }
                    asm volatile("" ::: "memory");
#pragma unroll
                    for (int m = 0; m < 4; ++m) { const int row = row0 + ai * 128 + wr * 64 + m * 16 + fr;
                        const f32x4 c4 = cb[m], s4 = sb[m];
                        const f32x4 v0 = acc[ai][0][m][0], v1 = acc[ai][0][m][1]; u32x4 w;
                        w.x = pk2(v0[0] * c4[0] - v0[1] * s4[0], v0[0] * s4[0] + v0[1] * c4[0]); w.y = pk2(v0[2] * c4[1] - v0[3] * s4[1], v0[2] * s4[1] + v0[3] * c4[1]);
                        w.z = pk2(v1[0] * c4[2] - v1[1] * s4[2], v1[0] * s4[2] + v1[1] * c4[2]); w.w = pk2(v1[2] * c4[3] - v1[3] * s4[3], v1[2] * s4[3] + v1[3] * c4[3]);
                        *(u32x4*)(kr + (size_t)row * 64 + 32 * wc + 8 * fq) = w; asm volatile("" ::: "memory"); } }
            }
        }
        else if (kind == K1_DQ) { pg8::store_tile_bf16(acc, dq, 768, row0, col0, 0.125f * LOG2E, wr, wc, fr, fq); }
        else if (kind == K1_DK) { pg8::store_tile_bf16(acc, dk, 768, row0, col0, 1.0f, wr, wc, fr, fq); }
        else { pg8::store_tile_bf16(acc, dvT, T, row0, col0, 1.0f, wr, wc, fr, fq); }
    }
};

struct SchedQ {
    int G, c, l; unsigned char* ws;
    __device__ __forceinline__ bool next(int i, pg8::Unit& U) const {
        const int L = i * G + c; if (L >= 160) return false;
        const char* cq = (const char*)(ws + WS_CQ); const char* wuq = (const char*)(ws + WS_WUQ + (size_t)l * SZ_WUQ);
        int pm, pn; pg8::tile_of(L, 32, 5, pm, pn);
        U.a = cq + (size_t)pm * 256 * 512 * 2; U.b = wuq + (size_t)pn * 256 * 512 * 2; U.rowmap = nullptr; U.nrows = 256; U.p0 = 0; U.p1 = 256 * pm; U.p2 = 256 * pn; U.p3 = 0; return true;
    }
};
constexpr float QM_SCALE = 0.07216878364870322f * LOG2E;
struct EpiQ {
    static constexpr bool PERM = true;
    unsigned char* ws;
    __device__ __forceinline__ void operator()(const f32x4 (&acc)[2][2][4][2], const pg8::Unit& U, int wr, int wc, int fr, int fq) const {
        const int row0 = U.p1, colt = U.p2;
        bf16_t* qm = (bf16_t*)(ws + WS_QM); const float* cqss = (const float*)(ws + WS_CQSS); const float *cs = (const float*)(ws + WS_COS), *sn = (const float*)(ws + WS_SIN);
        bool isr[2], inr[2]; int i0 = 0;
#pragma unroll
        for (int bj = 0; bj < 2; ++bj) { const int cg = colt + bj * 128 + wc * 32 + 8 * fq, w = cg % 192; inr[bj] = cg < 1152; isr[bj] = inr[bj] && w >= 128; if (isr[bj]) i0 = (w - 128) >> 1; }
#pragma unroll
        for (int ai = 0; ai < 2; ++ai)
#pragma unroll
          for (int mh = 0; mh < 4; mh += 2) {
            f32x4 p0[2], p1[2], c4[2], s4[2];
#pragma unroll
            for (int m2 = 0; m2 < 2; ++m2) { const int row = row0 + ai * 128 + wr * 64 + (mh + m2) * 16 + fr;
                p0[m2] = *(const f32x4*)(cqss + (size_t)row * 8); p1[m2] = *(const f32x4*)(cqss + (size_t)row * 8 + 4); c4[m2] = *(const f32x4*)(cs + (size_t)row * 32 + i0); s4[m2] = *(const f32x4*)(sn + (size_t)row * 32 + i0); }
            asm volatile("" ::: "memory");
#pragma unroll
            for (int m2 = 0; m2 < 2; ++m2) { const int m = mh + m2; int row = row0 + ai * 128 + wr * 64 + m * 16 + fr; asm volatile("" : "+v"(row));
                const float ssum = ((p0[m2][0] + p0[m2][1]) + (p0[m2][2] + p0[m2][3])) + ((p1[m2][0] + p1[m2][1]) + (p1[m2][2] + p1[m2][3]));
                const float rs = QM_SCALE / sqrtf(ssum * (1.0f / 512.0f) + EPS); const f32x4 cc = c4[m2], ss = s4[m2];
#pragma unroll
                for (int bj = 0; bj < 2; ++bj) { const int cg = colt + bj * 128 + wc * 32 + 8 * fq;
                    if (inr[bj]) { const f32x4 v0 = acc[ai][bj][m][0] * rs, v1 = acc[ai][bj][m][1] * rs; u32x4 o;
                        if (isr[bj]) {
                            o.x = pk2(v0[0] * cc[0] - v0[1] * ss[0], v0[0] * ss[0] + v0[1] * cc[0]); o.y = pk2(v0[2] * cc[1] - v0[3] * ss[1], v0[2] * ss[1] + v0[3] * cc[1]);
                            o.z = pk2(v1[0] * cc[2] - v1[1] * ss[2], v1[0] * ss[2] + v1[1] * cc[2]); o.w = pk2(v1[2] * cc[3] - v1[3] * ss[3], v1[2] * ss[3] + v1[3] * cc[3]); }
                        else { o.x = pk2(v0[0], v0[1]); o.y = pk2(v0[2], v0[3]); o.z = pk2(v1[0], v1[1]); o.w = pk2(v1[2], v1[3]); }
                        *(u32x4*)(qm + (size_t)row * 1152 + cg) = o; } }
                asm volatile("" ::: "memory"); }
          }
    }
};
struct SchedKV {
    int G, c, l; unsigned char* ws;
    __device__ __forceinline__ bool next(int i, pg8::Unit& U) const {
        const int L = i * G + c; if (c < 0 || L >= 192) return false;
        const char* ckv = (const char*)(ws + WS_CKV); const char* wk = (const char*)(ws + WS_WK + (size_t)l * SZ_WK); const char* wv = (const char*)(ws + WS_WV + (size_t)l * SZ_WK);
        U.rowmap = nullptr; U.nrows = 256; U.p3 = 0;
        if (L < 96) { int pm, pn; pg8::tile_of(L, 32, 3, pm, pn); U.a = ckv + (size_t)pm * 256 * 256 * 2; U.b = wk + (size_t)pn * 256 * 256 * 2; U.p0 = 0; U.p1 = 256 * pm; U.p2 = 256 * pn; }
        else { const int Ls = L - 96, pm = Ls % 3, pn = Ls / 3; U.a = wv + (size_t)pm * 256 * 256 * 2; U.b = ckv + (size_t)pn * 256 * 256 * 2; U.p0 = 1; U.p1 = 256 * pm; U.p2 = 256 * pn; }
        return true;
    }
};
struct EpiKV {
    static constexpr bool PERM = true;
    unsigned char* ws;
    __device__ __forceinline__ float rs_of(int t) const { const float* ckvss = (const float*)(ws + WS_CKVSS); const f32x4 p = *(const f32x4*)(ckvss + (size_t)t * 4); return 1.0f / sqrtf(((p[0] + p[1]) + (p[2] + p[3])) * (1.0f / 256.0f) + EPS); }
    __device__ __forceinline__ void operator()(const f32x4 (&acc)[2][2][4][2], const pg8::Unit& U, int wr, int wc, int fr, int fq) const {
        const int row0 = U.p1, col0 = U.p2; bf16_t *kn = (bf16_t*)(ws + WS_KN), *vmT = (bf16_t*)(ws + WS_VMT);
        if (U.p0 == 0) {
            float rsb[8]; { f32x4 pv[8]; const float* ckvss = (const float*)(ws + WS_CKVSS);
#pragma unroll
              for (int i = 0; i < 8; ++i) pv[i] = *(const f32x4*)(ckvss + (size_t)(row0 + (i >> 2) * 128 + wr * 64 + (i & 3) * 16 + fr) * 4);
              asm volatile("" ::: "memory");
#pragma unroll
              for (int i = 0; i < 8; ++i) rsb[i] = 1.0f / sqrtf(((pv[i][0] + pv[i][1]) + (pv[i][2] + pv[i][3])) * (1.0f / 256.0f) + EPS); }
#pragma unroll
            for (int ai = 0; ai < 2; ++ai)
#pragma unroll
                for (int m = 0; m < 4; ++m) { int row = row0 + ai * 128 + wr * 64 + m * 16 + fr; asm volatile("" : "+v"(row)); const float rs = rsb[ai * 4 + m];
                    bf16_t* rowp = kn + (size_t)row * 768 + col0 + wc * 32 + 8 * fq;
#pragma unroll
                    for (int bj = 0; bj < 2; ++bj) { const f32x4 v0 = acc[ai][bj][m][0] * rs, v1 = acc[ai][bj][m][1] * rs;
                        u32x4 w; w.x = pk2(v0[0], v0[1]); w.y = pk2(v0[2], v0[3]); w.z = pk2(v1[0], v1[1]); w.w = pk2(v1[2], v1[3]); *(u32x4*)(rowp + bj * 128) = w; }
                    asm volatile("" ::: "memory"); }
        } else {
#pragma unroll
            for (int bj = 0; bj < 2; ++bj) { const int t0 = col0 + bj * 128 + wc * 32 + 8 * fq; float rs[8]; { f32x4 pv[8]; const float* ckvss = (const float*)(ws + WS_CKVSS);
#pragma unroll
                for (int j = 0; j < 8; ++j) pv[j] = *(const f32x4*)(ckvss + (size_t)(t0 + j) * 4);
                asm volatile("" ::: "memory");
#pragma unroll
                for (int j = 0; j < 8; ++j) rs[j] = 1.0f / sqrtf(((pv[j][0] + pv[j][1]) + (pv[j][2] + pv[j][3])) * (1.0f / 256.0f) + EPS); }
#pragma unroll
                for (int ai = 0; ai < 2; ++ai)
#pragma unroll
                    for (int m = 0; m < 4; ++m) { int row = row0 + ai * 128 + wr * 64 + m * 16 + fr; asm volatile("" : "+v"(row)); const f32x4 v0 = acc[ai][bj][m][0], v1 = acc[ai][bj][m][1];
                        u32x4 w; w.x = pk2(v0[0] * rs[0], v0[1] * rs[1]); w.y = pk2(v0[2] * rs[2], v0[3] * rs[3]); w.z = pk2(v1[0] * rs[4], v1[1] * rs[5]); w.w = pk2(v1[2] * rs[6], v1[3] * rs[7]);
                        *(u32x4*)(vmT + (size_t)row * T + t0) = w; }
                asm volatile("" ::: "memory"); }
        }
    }
};
template <int WIN> __device__ __forceinline__ void pool_load(u32x4 (&v)[WIN], const bf16_t* zrow, int cnt) {
#pragma unroll
    for (int k = 0; k < WIN; ++k) { const int kk = k < cnt ? k : 0; v[k] = *(const u32x4*)(zrow - (size_t)kk * 512); }
}
template <int WIN> __device__ __forceinline__ void pool_out(const u32x4 (&v)[WIN], bf16_t* orow, int cnt) {
    float sum[8], self[8];
#pragma unroll
    for (int j = 0; j < 4; ++j) { self[2 * j] = __builtin_bit_cast(float, v[0][j] << 16); self[2 * j + 1] = __builtin_bit_cast(float, v[0][j] & 0xffff0000u); sum[2 * j] = self[2 * j]; sum[2 * j + 1] = self[2 * j + 1]; }
#pragma unroll
    for (int k = 1; k < WIN; ++k)
#pragma unroll
        for (int j = 0; j < 4; ++j) { const unsigned w = k < cnt ? v[k][j] : 0u; sum[2 * j] += __builtin_bit_cast(float, w << 16); sum[2 * j + 1] += __builtin_bit_cast(float, w & 0xffff0000u); }
    const float ic = 1.0f / (float)cnt; u32x4 o;
    o.x = pk2(sum[0] * ic - self[0], sum[1] * ic - self[1]); o.y = pk2(sum[2] * ic - self[2], sum[3] * ic - self[3]);
    o.z = pk2(sum[4] * ic - self[4], sum[5] * ic - self[5]); o.w = pk2(sum[6] * ic - self[6], sum[7] * ic - self[7]);
    *(u32x4*)orow = o;
}
__device__ __forceinline__ void pool_stencil(Frame& F) {
    frame_refresh(F);
    const bf16_t* zp = (const bf16_t*)(F.ws + WS_ZP); bf16_t* mix = (bf16_t*)(F.ws + WS_MIX);
    for (int q = F.vcu * NTHR + F.tid; q < T * 16; q += F.G * NTHR) {
        const int t = q >> 4, c16 = q & 15, s = t & (S - 1);
        const int c0 = (s + 1) < 2 ? (s + 1) : 2, c1 = (s + 1) < 4 ? (s + 1) : 4, c2 = (s + 1) < 8 ? (s + 1) : 8, c3 = (s + 1) < 16 ? (s + 1) : 16;
        const bf16_t* zr = zp + (size_t)t * 512 + c16 * 8; bf16_t* orow = mix + (size_t)t * D + c16 * 8;
        u32x4 v0[2], v1[4], v2[8], v3[16];
        pool_load<16>(v3, zr + 384, c3); pool_load<8>(v2, zr + 256, c2); pool_load<4>(v1, zr + 128, c1); pool_load<2>(v0, zr, c0);
        asm volatile("" ::: "memory");
        pool_out<16>(v3, orow + 384, c3); pool_out<8>(v2, orow + 256, c2); pool_out<4>(v1, orow + 128, c1); pool_out<2>(v0, orow, c0);
    }
}

constexpr int ATT_MAXU = 3;
__device__ const unsigned short att_sched[256][ATT_MAXU] = {
  {1407,1266,65535},
  {1391,1250,65535},
  {1375,1234,65535},
  {1359,1218,65535},
  {1343,1202,65535},
  {1327,1186,65535},
  {1311,1170,65535},
  {1295,1154,65535},
  {1279,1138,65535},
  {1263,1122,65535},
  {1247,1106,65535},
  {1231,1090,65535},
  {1215,1074,65535},
  {1199,1058,65535},
  {1183,1042,65535},
  {1167,1026,65535},
  {1151,1393,1265},
  {1135,1377,1249},
  {1119,1361,1233},
  {1103,1345,1217},
  {1087,1329,1201},
  {1071,1313,1185},
  {1055,1297,1169},
  {1039,1281,1153},
  {1406,241,65535},
  {1390,225,65535},
  {1374,209,65535},
  {1358,193,65535},
  {1342,177,65535},
  {1326,161,65535},
  {1310,145,65535},
  {1294,129,65535},
  {1278,113,65535},
  {1262,97,65535},
  {1246,81,65535},
  {1230,65,65535},
  {1214,49,65535},
  {1198,33,65535},
  {1182,17,65535},
  {1166,1,65535},
  {1150,1394,1137},
  {1134,1378,1121},
  {1118,1362,1105},
  {1102,1346,1089},
  {1086,1330,1073},
  {1070,1314,1057},
  {1054,1298,1041},
  {1038,1282,1025},
  {375,1267,65535},
  {359,1251,65535},
  {343,1235,65535},
  {327,1219,65535},
  {311,1203,65535},
  {295,1187,65535},
  {279,1171,65535},
  {263,1155,65535},
  {247,1139,65535},
  {231,1123,65535},
  {215,1107,65535},
  {199,1091,65535},
  {183,1075,65535},
  {167,1059,65535},
  {151,1043,65535},
  {135,1027,65535},
  {119,369,65535},
  {103,353,65535},
  {87,337,65535},
  {71,321,65535},
  {55,305,65535},
  {39,289,65535},
  {23,273,65535},
  {7,257,65535},
  {1405,1268,65535},
  {1389,1252,65535},
  {1373,1236,65535},
  {1357,1220,65535},
  {1341,1204,65535},
  {1325,1188,65535},
  {1309,1172,65535},
  {1293,1156,65535},
  {1277,1140,65535},
  {1261,1124,65535},
  {1245,1108,65535},
  {1229,1092,65535},
  {1213,1076,65535},
  {1197,1060,65535},
  {1181,1044,65535},
  {1165,1028,65535},
  {1149,1395,1392},
  {1133,1379,1376},
  {1117,1363,1360},
  {1101,1347,1344},
  {1085,1331,1328},
  {1069,1315,1312},
  {1053,1299,1296},
  {1037,1283,1280},
  {1404,242,65535},
  {1388,226,65535},
  {1372,210,65535},
  {1356,194,65535},
  {1340,178,65535},
  {1324,162,65535},
  {1308,146,65535},
  {1292,130,65535},
  {1276,114,65535},
  {1260,98,65535},
  {1244,82,65535},
  {1228,66,65535},
  {1212,50,65535},
  {1196,34,65535},
  {1180,18,65535},
  {1164,2,65535},
  {1148,1396,368},
  {1132,1380,352},
  {1116,1364,336},
  {1100,1348,320},
  {1084,1332,304},
  {1068,1316,288},
  {1052,1300,272},
  {1036,1284,256},
  {374,1269,65535},
  {358,1253,65535},
  {342,1237,65535},
  {326,1221,65535},
  {310,1205,65535},
  {294,1189,65535},
  {278,1173,65535},
  {262,1157,65535},
  {246,1141,65535},
  {230,1125,65535},
  {214,1109,65535},
  {198,1093,65535},
  {182,1077,65535},
  {166,1061,65535},
  {150,1045,65535},
  {134,1029,65535},
  {118,370,65535},
  {102,354,65535},
  {86,338,65535},
  {70,322,65535},
  {54,306,65535},
  {38,290,65535},
  {22,274,65535},
  {6,258,65535},
  {1403,1270,65535},
  {1387,1254,65535},
  {1371,1238,65535},
  {1355,1222,65535},
  {1339,1206,65535},
  {1323,1190,65535},
  {1307,1174,65535},
  {1291,1158,65535},
  {1275,1142,65535},
  {1259,1126,65535},
  {1243,1110,65535},
  {1227,1094,65535},
  {1211,1078,65535},
  {1195,1062,65535},
  {1179,1046,65535},
  {1163,1030,65535},
  {1147,1397,240},
  {1131,1381,224},
  {1115,1365,208},
  {1099,1349,192},
  {1083,1333,176},
  {1067,1317,160},
  {1051,1301,144},
  {1035,1285,128},
  {1402,243,65535},
  {1386,227,65535},
  {1370,211,65535},
  {1354,195,65535},
  {1338,179,65535},
  {1322,163,65535},
  {1306,147,65535},
  {1290,131,65535},
  {1274,115,65535},
  {1258,99,65535},
  {1242,83,65535},
  {1226,67,65535},
  {1210,51,65535},
  {1194,35,65535},
  {1178,19,65535},
  {1162,3,65535},
  {1146,1398,1264},
  {1130,1382,1248},
  {1114,1366,1232},
  {1098,1350,1216},
  {1082,1334,1200},
  {1066,1318,1184},
  {1050,1302,1168},
  {1034,1286,1152},
  {373,1271,65535},
  {357,1255,65535},
  {341,1239,65535},
  {325,1223,65535},
  {309,1207,65535},
  {293,1191,65535},
  {277,1175,65535},
  {261,1159,65535},
  {245,1143,65535},
  {229,1127,65535},
  {213,1111,65535},
  {197,1095,65535},
  {181,1079,65535},
  {165,1063,65535},
  {149,1047,65535},
  {133,1031,65535},
  {117,371,65535},
  {101,355,65535},
  {85,339,65535},
  {69,323,65535},
  {53,307,65535},
  {37,291,65535},
  {21,275,65535},
  {5,259,65535},
  {1401,1272,65535},
  {1385,1256,65535},
  {1369,1240,65535},
  {1353,1224,65535},
  {1337,1208,65535},
  {1321,1192,65535},
  {1305,1176,65535},
  {1289,1160,65535},
  {1273,1144,65535},
  {1257,1128,65535},
  {1241,1112,65535},
  {1225,1096,65535},
  {1209,1080,65535},
  {1193,1064,65535},
  {1177,1048,65535},
  {1161,1032,65535},
  {1145,1399,112},
  {1129,1383,96},
  {1113,1367,80},
  {1097,1351,64},
  {1081,1335,48},
  {1065,1319,32},
  {1049,1303,16},
  {1033,1287,0},
  {372,116,65535},
  {356,100,65535},
  {340,84,65535},
  {324,68,65535},
  {308,52,65535},
  {292,36,65535},
  {276,20,65535},
  {260,4,65535},
  {244,1400,1136},
  {228,1384,1120},
  {212,1368,1104},
  {196,1352,1088},
  {180,1336,1072},
  {164,1320,1056},
  {148,1304,1040},
  {132,1288,1024},
};
namespace att {
constexpr int VROW = 136, KBUF = 64 * 400, VBUF = 128 * VROW, BUF = KBUF + VBUF;
constexpr int LUT_OFF = 2 * BUF;
constexpr int TMAX_OFF = LUT_OFF + 3328, POS_OFF = TMAX_OFF + 512;
#define MFMA32(a, b, c) __builtin_amdgcn_mfma_f32_32x32x16_bf16((a), (b), (c), 0, 0, 0)

template <int DQK, int KEL, bool BIAS>
__device__ __forceinline__ void attn_core(LAS unsigned char* lds, int tid, int lane,
        const bf16_t* qrow, const bf16_t* kA, int ldkA, const bf16_t* kB, const bf16_t* vT, int q0, int nj, int koffB,
        const LAS int* posb, const LAS int* tmaxb, const LAS float* lut, f32x16 (&o)[4]) {
    constexpr int KROW = KEL * 2 + 16, KC = KEL / 8, NKL = KC / 8, NKS = DQK / 16;
    const int r31 = lane & 31, hh = lane >> 5;
    const int qi = q0 + r31, jd = q0 >> 6;
    bf16x8 qf[NKS];
#pragma unroll
    for (int ks = 0; ks < NKS; ++ks) qf[ks] = *(const bf16x8*)(qrow + 16 * ks + 8 * hh);
#pragma unroll
    for (int dt = 0; dt < 4; ++dt)
#pragma unroll
        for (int r = 0; r < 16; ++r) o[dt][r] = 0.f;
    float mrun = 0.f, lsum = 0.f;
    int pq = 0; if (BIAS) pq = posb[qi];
    u32x4 kreg[NKL]; u32x4 vreg[2];
#define ATT_LOAD(j) do { _Pragma("unroll") for (int _i = 0; _i < NKL; ++_i) { const int _c = tid + 512 * _i, _row = _c / KC, _ch = _c % KC; \
            const bf16_t* _s = (KEL == 192 && _ch >= 16) ? (kB + (size_t)(64 * (j) + _row) * 64 + (_ch - 16) * 8) : (kA + (size_t)(64 * (j) + _row) * ldkA + _ch * 8); kreg[_i] = *(const u32x4*)_s; } \
        _Pragma("unroll") for (int _i = 0; _i < 2; ++_i) { const int _c = tid + 512 * _i, _d = _c >> 3, _ch = _c & 7; vreg[_i] = *(const u32x4*)(vT + (size_t)_d * T + 64 * (j) + _ch * 8); } } while (0)
#define ATT_WRITE(buf) do { _Pragma("unroll") for (int _i = 0; _i < NKL; ++_i) { const int _c = tid + 512 * _i, _row = _c / KC, _ch = _c % KC; *(LAS u32x4*)((buf) + _row * KROW + _ch * 16) = kreg[_i]; } \
        _Pragma("unroll") for (int _i = 0; _i < 2; ++_i) { const int _c = tid + 512 * _i, _d = _c >> 3, _ch = _c & 7; LAS u32x2* _p = (LAS u32x2*)((buf) + KBUF + _d * VROW + _ch * 16); \
            _p[0] = (u32x2){vreg[_i].x, vreg[_i].y}; _p[1] = (u32x2){vreg[_i].z, vreg[_i].w}; } } while (0)
    ATT_LOAD(0); ATT_WRITE(lds);
    __syncthreads();
    for (int j = 0; j < nj; ++j) {
        LAS unsigned char* cur = lds + (j & 1) * BUF;
        if (j + 1 < nj) ATT_LOAD(j + 1);
        if (j <= jd) {
            bool farb = false; float c0 = -mrun;
            if (BIAS) { farb = __all(pq - tmaxb[j] >= 128); if (farb) c0 += lut[128]; }
            f32x16 s0, s1;
#pragma unroll
            for (int r = 0; r < 16; ++r) { s0[r] = c0; s1[r] = c0; }
            const LAS unsigned char* kp = cur + r31 * KROW + koffB + hh * 16;
            {
                bf16x8 kf[3][2];
#define ATT_LDK(b, g) do { kf[b][0] = *(const LAS bf16x8*)(kp + (g) * 32); kf[b][1] = *(const LAS bf16x8*)(kp + 32 * KROW + (g) * 32); } while (0)
                ATT_LDK(0, 0); ATT_LDK(1, 1);
#pragma unroll
                for (int g = 0; g < NKS; ++g) {
                    if (g + 2 < NKS) ATT_LDK((g + 2) % 3, g + 2);
                    __builtin_amdgcn_sched_barrier(0);
                    s0 = MFMA32(kf[g % 3][0], qf[g], s0); s1 = MFMA32(kf[g % 3][1], qf[g], s1);
                    __builtin_amdgcn_sched_barrier(0);
                }
#undef ATT_LDK
            }
            if (BIAS && !farb) {
#pragma unroll
                for (int r = 0; r < 16; ++r) { const int kj = 64 * j + (r & 3) + 8 * (r >> 2) + 4 * hh;
                    int r0 = pq - posb[kj], r1 = pq - posb[kj + 32]; r0 = r0 < 0 ? 0 : (r0 > 128 ? 128 : r0); r1 = r1 < 0 ? 0 : (r1 > 128 ? 128 : r1);
                    s0[r] += lut[r0]; s1[r] += lut[r1]; }
            }
            if (j == jd) {
#pragma unroll
                for (int r = 0; r < 16; ++r) { const int kj = 64 * j + (r & 3) + 8 * (r >> 2) + 4 * hh;
                    if (kj > qi) s0[r] = -__builtin_inff(); if (kj + 32 > qi) s1[r] = -__builtin_inff(); }
            }
            float mx = fmaxf(fmaxf(s0[0], s0[1]), s0[2]);
#pragma unroll
            for (int r = 3; r < 15; r += 2) mx = fmaxf(fmaxf(mx, s0[r]), s0[r + 1]);
            mx = fmaxf(mx, s0[15]);
#pragma unroll
            for (int r = 0; r < 16; r += 2) mx = fmaxf(fmaxf(mx, s1[r]), s1[r + 1]);
            mx = max32(mx);
            if (j == 0 || !__all(mx <= 8.0f)) {
                if (j != 0) mx = fmaxf(mx, 0.f);
                const float alpha = __builtin_amdgcn_exp2f(-mx);
                mrun += mx; lsum *= alpha;
#pragma unroll
                for (int dt = 0; dt < 4; ++dt)
#pragma unroll
                    for (int r = 0; r < 16; ++r) o[dt][r] *= alpha;
#pragma unroll
                for (int r = 0; r < 16; ++r) { s0[r] -= mx; s1[r] -= mx; }
            }
            float ps0 = 0.f, ps1 = 0.f;
#pragma unroll
            for (int r = 0; r < 16; ++r) { s0[r] = __builtin_amdgcn_exp2f(s0[r]); s1[r] = __builtin_amdgcn_exp2f(s1[r]); ps0 += s0[r]; ps1 += s1[r]; }
            lsum += ps0 + ps1;
            bf16x8 pb[2][2];
            { u32x4 w;
              w.x = pk2(s0[0], s0[1]); w.y = pk2(s0[2], s0[3]); w.z = pk2(s0[4], s0[5]); w.w = pk2(s0[6], s0[7]); pb[0][0] = __builtin_bit_cast(bf16x8, w);
              w.x = pk2(s0[8], s0[9]); w.y = pk2(s0[10], s0[11]); w.z = pk2(s0[12], s0[13]); w.w = pk2(s0[14], s0[15]); pb[0][1] = __builtin_bit_cast(bf16x8, w);
              w.x = pk2(s1[0], s1[1]); w.y = pk2(s1[2], s1[3]); w.z = pk2(s1[4], s1[5]); w.w = pk2(s1[6], s1[7]); pb[1][0] = __builtin_bit_cast(bf16x8, w);
              w.x = pk2(s1[8], s1[9]); w.y = pk2(s1[10], s1[11]); w.z = pk2(s1[12], s1[13]); w.w = pk2(s1[14], s1[15]); pb[1][1] = __builtin_bit_cast(bf16x8, w); }
            const LAS unsigned char* vp = cur + KBUF + r31 * VROW + hh * 8;
            {
                u32x4 vf[3][2];
#define ATT_LDV(b, g) do { _Pragma("unroll") for (int _q = 0; _q < 2; ++_q) { const LAS unsigned char* _a = vp + ((g) >> 1) * 32 * VROW + (2 * ((g) & 1) + _q) * 32; \
                           const u32x2 _lo = *(const LAS u32x2*)_a, _hi = *(const LAS u32x2*)(_a + 16); vf[b][_q] = (u32x4){_lo.x, _lo.y, _hi.x, _hi.y}; } } while (0)
                ATT_LDV(0, 0); ATT_LDV(1, 1);
#pragma unroll
                for (int g = 0; g < 8; ++g) {
                    if (g + 2 < 8) ATT_LDV((g + 2) % 3, g + 2);
                    __builtin_amdgcn_sched_barrier(0);
#pragma unroll
                    for (int q = 0; q < 2; ++q) o[g >> 1] = MFMA32(__builtin_bit_cast(bf16x8, vf[g % 3][q]), pb[g & 1][q], o[g >> 1]);
                    __builtin_amdgcn_sched_barrier(0);
                }
#undef ATT_LDV
            }
        }
        if (j + 1 < nj) ATT_WRITE(lds + ((j + 1) & 1) * BUF);
        __syncthreads();
    }
#undef ATT_LOAD
#undef ATT_WRITE
    const float lt = sum32(lsum), il = 1.0f / lt;
#pragma unroll
    for (int dt = 0; dt < 4; ++dt)
#pragma unroll
        for (int r = 0; r < 16; ++r) o[dt][r] *= il;
}

__device__ __forceinline__ void attn_phase(Frame& F, int l) {
    frame_refresh(F);
    unsigned char* ws = F.ws; LAS unsigned char* lds = F.lds;
    const bf16_t *qm = (const bf16_t*)(ws + WS_QM), *kn = (const bf16_t*)(ws + WS_KN), *kr = (const bf16_t*)(ws + WS_KR), *vmT = (const bf16_t*)(ws + WS_VMT);
    const bf16_t *dq = (const bf16_t*)(ws + WS_DQ), *dk = (const bf16_t*)(ws + WS_DK), *dvT = (const bf16_t*)(ws + WS_DVT);
    bf16_t* mix = (bf16_t*)(ws + WS_MIX);
    const int* pos = (const int*)inptr(F, IN_POS); const int* tmax = (const int*)(ws + WS_TMAX);
    LAS float* lut = (LAS float*)(lds + LUT_OFF);
    for (int i = F.tid; i < 6 * 132; i += NTHR) lut[i] = ((const float*)(ws + WS_LUT))[i];
    LAS int* tmaxl = (LAS int*)(lds + TMAX_OFF); LAS int* posl = (LAS int*)(lds + POS_OFF);
    if (F.tid < NB * 32) tmaxl[F.tid] = tmax[F.tid];
    for (int i = F.tid; i < T; i += NTHR) posl[i] = pos[i];
    float lam, lam_init;
    { const float* lv = inptr(F, IN_LAMBDA) + l * 256;
      const float d1 = wave_sum(lv[F.lane] * lv[64 + F.lane]), d2 = wave_sum(lv[128 + F.lane] * lv[192 + F.lane]);
      lam_init = 0.8f - 0.6f * expf(-0.3f * (float)l);
      lam = __builtin_bit_cast(float, __builtin_amdgcn_readfirstlane(__builtin_bit_cast(int, expf(d1) - expf(d2) + lam_init))); }
    __syncthreads();
    for (int uu = 0; uu < ATT_MAXU * ((256 + F.G - 1) / F.G); ++uu) {
        const int srow = F.bx + (uu / ATT_MAXU) * F.G, ui = uu % ATT_MAXU;
        if (srow >= 256) break;
        const int uid = (int)att_sched[srow][ui];
        if (uid == 0xFFFF) continue;
        frame_refresh(F);
        const int kind = uid >> 10, bh = (uid >> 4) & 63, qb = uid & 15, b = bh / 6, hd = bh % 6;
        const int r31 = F.lane & 31, hh = F.lane >> 5;
        f32x16 o[4];
        if (kind == 0) {
            const int q0 = 256 * qb + 32 * F.wave, t = b * S + q0 + r31;
            attn_core<192, 192, false>(lds, F.tid, F.lane, qm + (size_t)t * 1152 + hd * 192, kn + (size_t)b * S * 768 + hd * 128, 768, kr + (size_t)b * S * 64,
                                       vmT + (size_t)hd * 128 * T + b * S, q0, 4 * qb + 4, 0, nullptr, nullptr, nullptr, o);
            bf16_t* orow = mix + (size_t)t * D + 512 + hd * 128 + 4 * hh;
#pragma unroll
            for (int dt = 0; dt < 4; ++dt)
#pragma unroll
                for (int g = 0; g < 4; ++g) { u32x2 w; w.x = pk2(o[dt][4 * g], o[dt][4 * g + 1]); w.y = pk2(o[dt][4 * g + 2], o[dt][4 * g + 3]); *(u32x2*)(orow + 32 * dt + 8 * g) = w; }
        } else {
            const int map = F.wave >> 2, rg = F.wave & 3, q0 = 128 * qb + 32 * rg, t = b * S + q0 + r31;
            attn_core<64, 128, true>(lds, F.tid, F.lane, dq + (size_t)t * 768 + hd * 128 + 64 * map, dk + (size_t)b * S * 768 + hd * 128, 768, nullptr,
                                     dvT + (size_t)hd * 128 * T + b * S, q0, 2 * qb + 2, 128 * map, posl + b * S, tmaxl + b * 32, lut + hd * 132, o);
            LAS float* xch = (LAS float*)lds + (size_t)rg * 4096 + F.lane;
            if (map == 1) {
#pragma unroll
                for (int dt = 0; dt < 4; ++dt)
#pragma unroll
                    for (int r = 0; r < 16; ++r) xch[(dt * 16 + r) * 64] = o[dt][r] * lam; }
            __syncthreads();
            if (map == 0) {
                float ss = 0.f;
#pragma unroll
                for (int dt = 0; dt < 4; ++dt)
#pragma unroll
                    for (int r = 0; r < 16; ++r) { o[dt][r] -= xch[(dt * 16 + r) * 64]; ss += o[dt][r] * o[dt][r]; }
                ss = sum32(ss);
                const float rr = (1.0f - lam_init) / sqrtf(ss * (1.0f / 128.0f) + EPS);
                const float* sub = inptr(F, IN_SUBLN) + l * 128 + 4 * hh;
                bf16_t* orow = mix + (size_t)t * D + 1280 + hd * 128 + 4 * hh;
                f32x4 sgv[16];
#pragma unroll
                for (int i = 0; i < 16; ++i) sgv[i] = *(const f32x4*)(sub + 32 * (i >> 2) + 8 * (i & 3));
                asm volatile("" ::: "memory");
#pragma unroll
                for (int dt = 0; dt < 4; ++dt)
#pragma unroll
                    for (int g = 0; g < 4; ++g) { const f32x4 sg = sgv[dt * 4 + g]; u32x2 w;
                        w.x = pk2(o[dt][4 * g] * rr * sg[0], o[dt][4 * g + 1] * rr * sg[1]); w.y = pk2(o[dt][4 * g + 2] * rr * sg[2], o[dt][4 * g + 3] * rr * sg[3]); *(u32x2*)(orow + 32 * dt + 8 * g) = w; }
            }
            __syncthreads();
        }
    }
}
}

struct SchedOut {
    int G, c, l; unsigned char* ws;
    __device__ __forceinline__ bool next(int i, pg8::Unit& U) const {
        const int L = i * G + c; if (L >= 256) return false;
        const char* mix = (const char*)(ws + WS_MIX); const char* wout = (const char*)(ws + WS_WOUT + (size_t)l * SZ_WOUT);
        int pm, pn; pg8::tile_of(L, 32, 8, pm, pn);
        U.a = mix + (size_t)pm * 256 * D * 2; U.b = wout + (size_t)pn * 256 * D * 2; U.rowmap = nullptr; U.nrows = 256; U.p0 = 0; U.p1 = 256 * pm; U.p2 = 256 * pn; U.p3 = 0; return true;
    }
};
struct EpiOut {
    static constexpr bool PERM = true;
    unsigned char* ws;
    __device__ __forceinline__ void operator()(const f32x4 (&acc)[2][2][4][2], const pg8::Unit& U, int wr, int wc, int fr, int fq) const {
        const int row0 = U.p1 + wr * 64 + fr, col0 = U.p2 + wc * 32 + 8 * fq; const bf16_t* h = (const bf16_t*)(ws + WS_H); bf16_t* h2 = (bf16_t*)(ws + WS_H2);
        u32x4 hv[2][4][2];
#pragma unroll
        for (int ai = 0; ai < 2; ++ai)
#pragma unroll
            for (int m = 0; m < 4; ++m)
#pragma unroll
                for (int bj = 0; bj < 2; ++bj) hv[ai][m][bj] = *(const u32x4*)(h + (size_t)(row0 + ai * 128 + m * 16) * D + col0 + bj * 128);
        asm volatile("" ::: "memory");
#pragma unroll
        for (int ai = 0; ai < 2; ++ai)
#pragma unroll
            for (int m = 0; m < 4; ++m) { const size_t ro = (size_t)(row0 + ai * 128 + m * 16) * D + col0;
#pragma unroll
                for (int bj = 0; bj < 2; ++bj) { const u32x4 hw = hv[ai][m][bj];
                    const f32x4 v0 = unpk4((u32x2){hw.x, hw.y}) + acc[ai][bj][m][0], v1 = unpk4((u32x2){hw.z, hw.w}) + acc[ai][bj][m][1];
                    u32x4 w; w.x = pk2(v0[0], v0[1]); w.y = pk2(v0[2], v0[3]); w.z = pk2(v1[0], v1[1]); w.w = pk2(v1[2], v1[3]); *(u32x4*)(h2 + ro + bj * 128) = w; }
                asm volatile("" ::: "memory"); }
    }
};

__device__ __forceinline__ void router_phase(Frame& F, int l) {
    frame_refresh(F);
    unsigned char* ws = F.ws; LAS unsigned char* lds = F.lds;
    const bf16_t* h = (const bf16_t*)(ws + WS_H2); bf16_t* xn = (bf16_t*)(ws + WS_XB);
    const float* gain = inptr(F, IN_FFN_NORM) + l * D;

    const float* bg = inptr(F, IN_RG_B) + l * 4; const float* be = inptr(F, IN_RE_B) + l * 32;
    unsigned* cnt = F.ctl + CW_CNT + 2048 * l; int* list = (int*)(ws + WS_LIST); float* gwt = (float*)(ws + WS_GW);
    const int lane = F.lane, w = F.wave, r31 = lane & 31, hh = lane >> 5;
    LAS float* part = (LAS float*)lds;
    LAS float* ssqp = (LAS float*)(lds + 65536);
    LAS float* rsv = (LAS float*)(lds + 65536 + 2048);
    LAS float* lg = (LAS float*)(lds + 65536 + 4096);
    for (int tile = F.bx; tile < T / 32; tile += F.G) {
        const int t0 = tile * 32;
        { const bf16_t* xrow = h + (size_t)(t0 + r31) * D + 256 * w + 8 * hh;
          const unsigned char* wb = ws + WS_WRH + ((size_t)l * 8 + w) * 65536; const unsigned lo16 = (unsigned)lane * 16u;
          f32x16 a0, a1; float ssq = 0.f;
#pragma unroll
          for (int r = 0; r < 16; ++r) { a0[r] = 0.f; a1[r] = 0.f; }
#pragma unroll
          for (int kc = 0; kc < 16; kc += 4) {
              bf16x8 wh0[4], wh1[4], wl0[4], wl1[4]; u32x4 xw[16];
#pragma unroll
              for (int q = 0; q < 4; ++q) xw[kc + q] = *(const u32x4*)(xrow + 16 * (kc + q));
#pragma unroll
              for (int q = 0; q < 4; ++q) { GAS const unsigned char* wq_ = (GAS const unsigned char*)wb + (kc + q) * 4096; asm volatile("" : "+s"(wq_)); const unsigned char* wq = (const unsigned char*)wq_;
                  wh0[q] = *(const bf16x8*)(wq + lo16); wh1[q] = *(const bf16x8*)(wq + 1024 + lo16); wl0[q] = *(const bf16x8*)(wq + 2048 + lo16); wl1[q] = *(const bf16x8*)(wq + 3072 + lo16); }
              asm volatile("" ::: "memory");
#pragma unroll
              for (int q = 0; q < 4; ++q) { const u32x4 xv = xw[kc + q];
                  const f32x4 xa = unpk4((u32x2){xv.x, xv.y}), xb = unpk4((u32x2){xv.z, xv.w});
                  ssq += (xa[0] * xa[0] + xa[1] * xa[1]) + (xa[2] * xa[2] + xa[3] * xa[3]) + (xb[0] * xb[0] + xb[1] * xb[1]) + (xb[2] * xb[2] + xb[3] * xb[3]);
                  const bf16x8 xh = __builtin_bit_cast(bf16x8, xv);
                  a0 = MFMA32(xh, wh0[q], a0); a0 = MFMA32(xh, wl0[q], a0);
                  a1 = MFMA32(xh, wh1[q], a1); a1 = MFMA32(xh, wl1[q], a1); } }
          __syncthreads();
#pragma unroll
          for (int r = 0; r < 16; ++r) { const int tk = (r & 3) + 8 * (r >> 2) + 4 * hh; part[(w * 32 + tk) * 64 + r31] = a0[r]; part[(w * 32 + tk) * 64 + 32 + r31] = a1[r]; }
          ssqp[(w * 2 + hh) * 32 + r31] = ssq; }
        __syncthreads();
        if (F.tid < 32) { float s = 0.f;
#pragma unroll
            for (int q = 0; q < 16; ++q) s += ssqp[q * 32 + F.tid];
            rsv[F.tid] = 1.0f / sqrtf(s * (1.0f / D) + EPS); }
        __syncthreads();
        for (int idx = F.tid; idx < 32 * 36; idx += NTHR) { const int tk = idx / 36, c = idx - tk * 36; float s = 0.f;
#pragma unroll
            for (int q = 0; q < 8; ++q) s += part[(q * 32 + tk) * 64 + c];
            lg[tk * 40 + c] = s * rsv[tk] + (c < 4 ? bg[c] : be[c - 4]); }
        __syncthreads();
        if (w != 0) { f32x4 gg[8]; u32x2 xv[5][8];
#pragma unroll
          for (int j = 0; j < 8; ++j) gg[j] = ((const f32x4*)gain)[lane + 64 * j];
#pragma unroll
          for (int q = 0; q < 5; ++q) { const int r = (w - 1) + 7 * q, rc = r < 32 ? r : 0; const u32x2* xr = (const u32x2*)(h + (size_t)(t0 + rc) * D) + lane;
#pragma unroll
              for (int j = 0; j < 8; ++j) xv[q][j] = xr[64 * j]; }
          asm volatile("" ::: "memory");
#pragma unroll
          for (int q = 0; q < 5; ++q) { const int r = (w - 1) + 7 * q; if (r < 32) { const int t = t0 + r; const float rs = rsv[r]; u32x2* o = (u32x2*)(xn + (size_t)t * D) + lane;
#pragma unroll
              for (int j = 0; j < 8; ++j) { const f32x4 v = unpk4(xv[q][j]) * rs * gg[j]; u32x2 wv; wv.x = pk2(v[0], v[1]); wv.y = pk2(v[2], v[3]); o[64 * j] = wv; } } } }
        if (F.tid < 32) { const int t = t0 + F.tid; const LAS float* L = lg + F.tid * 40;
            int gi = 0; float gm = L[0];
            for (int c = 1; c < 4; ++c) { const float v = L[c]; if (v > gm) { gm = v; gi = c; } }
            float gs = 0.f; for (int c = 0; c < 4; ++c) gs += expf(L[c] - gm);
            const float ggate = 1.0f / gs; const LAS float* E8 = L + 4 + 8 * gi;
            int i0 = 0; float m0 = E8[0];
            for (int q = 1; q < 8; ++q) { const float v = E8[q]; if (v > m0) { m0 = v; i0 = q; } }
            int i1 = -1; float m1 = -__builtin_inff();
            for (int q = 0; q < 8; ++q) { const float v = E8[q]; if (q != i0 && v > m1) { m1 = v; i1 = q; } }
            const float p0 = 1.0f / (1.0f + expf(m1 - m0)), p1 = 1.0f - p0;
            const int e0 = gi * 8 + i0, e1 = gi * 8 + i1;
            LAS unsigned* lcnt = (LAS unsigned*)(lds + 65536 + 4096 + 5120); LAS unsigned* lbase = lcnt + 32;
            lcnt[F.tid] = 0u; LDS_WAIT();
            const unsigned r0 = __hip_atomic_fetch_add(lcnt + e0, 1u, __ATOMIC_RELAXED, __HIP_MEMORY_SCOPE_WORKGROUP);
            const unsigned r1 = __hip_atomic_fetch_add(lcnt + e1, 1u, __ATOMIC_RELAXED, __HIP_MEMORY_SCOPE_WORKGROUP);
            LDS_WAIT();
            { const unsigned n = lcnt[F.tid]; unsigned bs = 0u; if (n) bs = atomicAdd(cnt + 64 * F.tid, n); lbase[F.tid] = bs; }
            LDS_WAIT();
            const unsigned slot0 = lbase[e0] + r0, slot1 = lbase[e1] + r1;
            list[e0 * LISTCAP + slot0] = t * 2; list[e1 * LISTCAP + slot1] = t * 2 + 1;
            *(f32x2*)(gwt + t * 2) = (f32x2){ggate * p0, ggate * p1}; }
    }
    __syncthreads();
}

__device__ __forceinline__ void moe_tables(Frame& F, int l) {
    frame_refresh(F);
    __syncthreads();
    if (F.tid < NE) F.MISC[112 + F.tid] = (F.ctl + CW_CNT + 2048 * l)[64 * F.tid];
    __syncthreads();
    if (F.tid < NE) { const LAS unsigned* C = (const LAS unsigned*)F.MISC + 112; const int e = F.tid;
        const int c = (int)C[e], nfull = c >> 8, part = c & 255;
        int fpre = 0, spre = 0, ftot = 0, ptot = 0, rank = 0;
#pragma unroll 8
        for (int q = 0; q < NE; ++q) { const int cq = (int)C[q], fq = cq >> 8, pq = cq & 255;
            ftot += fq; ptot += (pq != 0); if (q < e) { fpre += fq; spre += cq; }
            rank += (pq > part || (pq == part && q < e)) ? 1 : 0; }
        for (int mt = 0; mt < nfull; ++mt) F.MISC[256 + fpre + mt] = (unsigned)(e | (mt << 8));
        if (part != 0) F.MISC[256 + ftot + rank] = (unsigned)(e | (nfull << 8));
        F.MISC[64 + e] = (unsigned)spre;
        if (e == 0) F.MISC[16 + NE] = (unsigned)(ftot + ptot); }
    __syncthreads();
}
__device__ __forceinline__ int moe_rank4(int c, int G) { if (G % 32 != 0 || c < 0) return c; const int x = c & 7, r = c >> 3; return (((G >> 5) * x + (r >> 2)) << 2) | (r & 3); }
__device__ __forceinline__ int moe_rank8(int c, int G) { if (G % 64 != 0 || c < 0) return c; const int x = c & 7, r = c >> 3; return (((G >> 6) * x + (r >> 3)) << 3) | (r & 7); }
struct SchedMoE {
    int G, c, l; bool down; volatile LAS unsigned* M; unsigned char* ws; int Lb, Le;
    __device__ __forceinline__ bool next(int i, pg8::Unit& U) const {
        const int L = Lb + i * G + c;
        if (c < 0 || L >= Le) return false;
        return make(L, U);
    }
    __device__ __forceinline__ bool make(int L, pg8::Unit& U) const {
        const int ntn = down ? 8 : 4; const char* abase = (const char*)(ws + (down ? WS_ACT : WS_XB));
        const char* wbase = (const char*)(ws + (down ? WS_WD + (size_t)l * NE * SZ_WD1 : WS_WGU + (size_t)l * NE * SZ_WGU1));
        const size_t wstride = down ? SZ_WD1 : SZ_WGU1, tstride = down ? (size_t)256 * EH * 2 : (size_t)256 * D * 2; const int* list = (const int*)(ws + WS_LIST);
        const int TR = (int)M[16 + NE]; const int rt = L / ntn, nt = L - rt * ntn;
        if (rt >= TR) return false;
        const int ent = __builtin_amdgcn_readfirstlane((int)M[256 + rt]), e = ent & 255, mt = ent >> 8;
        const int cnt = (int)M[112 + e], slot0 = (int)M[64 + e] + 256 * mt; int nv = cnt - 256 * mt; nv = nv > 256 ? 256 : nv;
        U.nrows = __builtin_amdgcn_readfirstlane(nv); U.p0 = rt; U.p1 = U.nrows; U.p3 = nt;
        U.b = wbase + (size_t)e * wstride + (size_t)nt * tstride;
        if (down) { U.a = abase + (size_t)__builtin_amdgcn_readfirstlane(slot0) * EH * 2; U.rowmap = nullptr; U.p2 = e * LISTCAP + 256 * mt; }
        else { U.a = abase; U.rowmap = list + e * LISTCAP + 256 * mt; U.p2 = __builtin_amdgcn_readfirstlane(slot0); }
        return true;
    }
};
struct EpiGU {
    static constexpr bool PERM = true;
    unsigned char* ws; int l;
    __device__ __forceinline__ void operator()(const f32x4 (&acc)[2][2][4][2], const pg8::Unit& U, int wr, int wc, int fr, int fq) const {
        const int nv = U.p1, slot0 = U.p2, nt = U.p3; bf16_t* act = (bf16_t*)(ws + WS_ACT);
#pragma unroll
        for (int ai = 0; ai < 2; ++ai)
#pragma unroll
            for (int m = 0; m < 4; ++m) { const int r = ai * 128 + wr * 64 + m * 16 + fr;
                if (r < nv) { float o[8];
#pragma unroll
                    for (int n = 0; n < 2; ++n)
#pragma unroll
                        for (int e = 0; e < 4; ++e) { const float gt = acc[ai][0][m][n][e], up = acc[ai][1][m][n][e]; o[4 * n + e] = gt * up / (1.0f + __builtin_amdgcn_exp2f(-gt * LOG2E)); }
                    const unsigned long long w0 = (unsigned long long)pk2(o[0], o[1]) | ((unsigned long long)pk2(o[2], o[3]) << 32), w1 = (unsigned long long)pk2(o[4], o[5]) | ((unsigned long long)pk2(o[6], o[7]) << 32);
                    GAS unsigned long long* dp = (GAS unsigned long long*)(act + (size_t)(slot0 + r) * EH + nt * 128 + wc * 32 + 8 * fq);
                    __hip_atomic_store(dp, w0, __ATOMIC_RELAXED, __HIP_MEMORY_SCOPE_AGENT); __hip_atomic_store(dp + 1, w1, __ATOMIC_RELAXED, __HIP_MEMORY_SCOPE_AGENT); } }
        asm volatile("s_waitcnt vmcnt(0)" ::: "memory");
        if ((fr | fq) == 0) { GAS unsigned* rdy = (GAS unsigned*)(ws + WS_CTL) + CW_RDY + 8192 * l + 64 * U.p0; __hip_atomic_fetch_add(rdy, 1u, __ATOMIC_RELAXED, __HIP_MEMORY_SCOPE_AGENT); }
    }
};
struct SchedDown2 {
    SchedMoE B; int ind, rem, nd;
    __device__ __forceinline__ bool next(int i, pg8::Unit& U) const {
        const int G = B.G, c = B.c, N1 = G - rem; int Lu;
        if (c >= rem) { const int j = c - rem, nind = (j < ind) ? (ind - j + N1 - 1) / N1 : 0;
            if (i < nind) Lu = j + i * N1;
            else { const int d = (rem + (N1 - 1 - j)) + (i - nind) * G; if (d >= nd - ind) return false; Lu = ind + d; } }
        else { const int d = c + i * G; if (d >= nd - ind) return false; Lu = ind + d; }
        return B.make(Lu, U);
    }
    __device__ __forceinline__ void a_ready(const pg8::Unit& U) const {
        if (__builtin_amdgcn_readfirstlane((int)(threadIdx.x >> 6)) == 0) {
            GAS unsigned* ctl = (GAS unsigned*)(B.ws + WS_CTL); GAS unsigned* rdy = ctl + CW_RDY + 8192 * B.l + 64 * U.p0; unsigned sp = 0u;
            while ((unsigned)__builtin_amdgcn_readfirstlane((int)__hip_atomic_load(rdy, __ATOMIC_RELAXED, __HIP_MEMORY_SCOPE_AGENT)) < 32u) {
                __builtin_amdgcn_s_sleep(2);
                if ((++sp & 255u) == 0u) { if (__hip_atomic_load(ctl + CW_TMO, __ATOMIC_RELAXED, __HIP_MEMORY_SCOPE_AGENT) != 0u) break;
                    if (sp > (1u << 18)) { __hip_atomic_store(ctl + CW_TMO, 1u, __ATOMIC_RELAXED, __HIP_MEMORY_SCOPE_AGENT); break; } } }
            __builtin_amdgcn_fence(__ATOMIC_ACQUIRE, "agent");
            asm volatile("s_waitcnt vmcnt(0)" ::: "memory");
        }
        asm volatile("" ::: "memory"); __builtin_amdgcn_s_barrier(); asm volatile("" ::: "memory");
    }
};
struct EpiDown {
    static constexpr bool PERM = true;
    unsigned char* ws;
    __device__ __forceinline__ void operator()(const f32x4 (&acc)[2][2][4][2], const pg8::Unit& U, int wr, int wc, int fr, int fq) const {
        const int nv = U.p1, lbase = U.p2, col0 = U.p3 * 256 + wc * 32 + 8 * fq;
        bf16_t *y1 = (bf16_t*)(ws + WS_Y1), *y2 = (bf16_t*)(ws + WS_Y2); const int* list = (const int*)(ws + WS_LIST); const float* gwt = (const float*)(ws + WS_GW);
        int ent[8]; float g[8];
#pragma unroll
        for (int i = 0; i < 8; ++i) { const int r = (i >> 2) * 128 + wr * 64 + (i & 3) * 16 + fr; ent[i] = list[lbase + (r < nv ? r : 0)]; }
#pragma unroll
        for (int i = 0; i < 8; ++i) g[i] = gwt[ent[i]];
#pragma unroll
        for (int i = 0; i < 8; ++i) asm volatile("" : "+v"(g[i]), "+v"(ent[i]));
        asm volatile("" ::: "memory");
#pragma unroll
        for (int ai = 0; ai < 2; ++ai)
#pragma unroll
            for (int m = 0; m < 4; ++m) { const int e1 = ent[ai * 4 + m]; const float gg = g[ai * 4 + m];
                if (ai * 128 + wr * 64 + m * 16 + fr < nv) { const int tok = e1 >> 1;
                    bf16_t* rowp = ((e1 & 1) ? y2 : y1) + (size_t)tok * D + col0;
#pragma unroll
                    for (int bj = 0; bj < 2; ++bj) { const f32x4 v0 = acc[ai][bj][m][0] * gg, v1 = acc[ai][bj][m][1] * gg;
                        u32x4 w; w.x = pk2(v0[0], v0[1]); w.y = pk2(v0[2], v0[3]); w.z = pk2(v1[0], v1[1]); w.w = pk2(v1[2], v1[3]); *(u32x4*)(rowp + bj * 128) = w; } }
                asm volatile("" ::: "memory"); }
    }
};

__device__ __forceinline__ void combine_phase(Frame& F, float* outp, int l) {
    frame_refresh(F);
    unsigned char* ws = F.ws; bf16_t* h = (bf16_t*)(ws + WS_H); const bf16_t* h2 = (const bf16_t*)(ws + WS_H2); const bf16_t* y1 = (const bf16_t*)(ws + WS_Y1); const bf16_t* y2 = (const bf16_t*)(ws + WS_Y2); bf16_t* u = (bf16_t*)(ws + WS_XB);
    const bool lastl = (l == NL - 1); const float* gain = lastl ? inptr(F, IN_FINAL_NORM) : inptr(F, IN_ATTN_NORM) + (l + 1) * D;
    const int gw = F.vcu * NWAVES + F.wave, NGW = F.G * NWAVES, lane = F.lane;
    f32x4 gg[8];
#pragma unroll
    for (int j = 0; j < 8; ++j) gg[j] = ((const f32x4*)gain)[lane + 64 * j];
#define CMB_LOAD(A, B, C, mm) do { const u32x2* h2r_ = (const u32x2*)(h2 + (size_t)(mm) * D) + lane; const u32x2* y1r_ = (const u32x2*)(y1 + (size_t)(mm) * D) + lane; const u32x2* y2r_ = (const u32x2*)(y2 + (size_t)(mm) * D) + lane; \
        _Pragma("unroll") for (int j = 0; j < 8; ++j) { A[j] = h2r_[64 * j]; B[j] = y1r_[64 * j]; C[j] = y2r_[64 * j]; } } while (0)
#define CMB_ROW(A, B, C, mm) do { f32x4 v[8]; float s = 0.f; \
        _Pragma("unroll") for (int j = 0; j < 8; ++j) { v[j] = unpk4(A[j]) + (unpk4(B[j]) + unpk4(C[j])); s += (v[j][0] * v[j][0] + v[j][1] * v[j][1]) + (v[j][2] * v[j][2] + v[j][3] * v[j][3]); } \
        const float rs = 1.0f / sqrtf(wave_sum(s) * (1.0f / D) + EPS); \
        if (lastl) { f32x4* o = (f32x4*)(outp + (size_t)(mm) * D) + lane; \
            _Pragma("unroll") for (int j = 0; j < 8; ++j) o[64 * j] = v[j] * rs * gg[j]; } \
        else { u32x2* hr = (u32x2*)(h + (size_t)(mm) * D) + lane; u32x2* o = (u32x2*)(u + (size_t)(mm) * D) + lane; \
            _Pragma("unroll") for (int j = 0; j < 8; ++j) { { u32x2 hw; hw.x = pk2(v[j][0], v[j][1]); hw.y = pk2(v[j][2], v[j][3]); hr[64 * j] = hw; } \
                u32x2 w; w.x = pk2(v[j][0] * rs * gg[j][0], v[j][1] * rs * gg[j][1]); w.y = pk2(v[j][2] * rs * gg[j][2], v[j][3] * rs * gg[j][3]); o[64 * j] = w; } } } while (0)
    for (int m = gw; m < T; m += 2 * NGW) {
        const int m1 = m + NGW; const bool has1 = m1 < T;
        u32x2 A0[8], B0[8], C0[8], A1[8], B1[8], C1[8];
        CMB_LOAD(A0, B0, C0, m); CMB_LOAD(A1, B1, C1, has1 ? m1 : m);
        asm volatile("" ::: "memory");
        CMB_ROW(A0, B0, C0, m);
        if (has1) CMB_ROW(A1, B1, C1, m1);
    }
#undef CMB_LOAD
#undef CMB_ROW
}

__global__ void __launch_bounds__(NTHR, 2) hymba_fwd(Args args) {
    extern __shared__ __attribute__((aligned(16))) unsigned char lds_raw[];
    Frame F;
    F.lds = (LAS unsigned char*)lds_raw; F.MISC = (volatile LAS unsigned*)(F.lds + LDS_MISC);
    F.tid = threadIdx.x; F.lane = F.tid & 63; F.wave = __builtin_amdgcn_readfirstlane(F.tid >> 6);
    F.G = gridDim.x; F.bx = blockIdx.x; F.vcu = (F.G % 8 == 0) ? (F.bx % 8) * (F.G / 8) + F.bx / 8 : F.bx;
    F.ws = args.ws; F.ws0 = args.ws; F.ctl = (unsigned*)(args.ws + WS_CTL);
    unsigned char* ws = args.ws;
    for (int i = F.tid; i < 192; i += NTHR) F.MISC[i] = 0u;
    if (F.tid < 46) F.MISC[MISC_PTAB + F.tid] = ((const __attribute__((address_space(4))) unsigned*)__builtin_amdgcn_kernarg_segment_ptr())[F.tid];
    float* const outp = args.out; const int use_bar = args.use_bar;
    __syncthreads();
    XcdBarrier bar; bar.bar = F.ctl + CW_BAR; bar.x = 0; bar.st = F.MISC;
    if (use_bar) bar = xcd_barrier_post(F.ctl + CW_BAR, F.MISC);
    const int lo = args.g_lo, hi = args.g_hi;
#define IN(k) (lo <= (k) && (k) < hi)
#define GRIDBAR() do { if (use_bar) { XcdBarrier bb_ = bar; GAS unsigned* bp_ = (GAS unsigned*)bar.bar; asm volatile("" : "+s"(bp_), "+s"(bb_.x)); bb_.bar = (unsigned*)bp_; xcd_barrier(bb_); } } while (0)
#define SEAM(k) do { if (IN((k) + 1)) GRIDBAR(); } while (0)
#define PHASE_LOCALS() frame_refresh(F); int bxo = F.bx, Go = F.G; GAS unsigned char* wsg_ = (GAS unsigned char*)ws; asm volatile("" : "+s"(bxo), "+s"(Go), "+s"(wsg_)); unsigned char* wso = (unsigned char*)wsg_

    if (IN(0)) { for (int rep_ = 0; rep_ < DUPN(0); ++rep_) { if (rep_) GRIDBAR(); p0_prologue(F); } SEAM(0); }

    for (int l = 0; l < NL; ++l) {
        const int g0 = 1 + 9 * l;
        if (lo >= g0 + 9 || hi <= g0) continue;
        if (IN(g0)) for (int rep_ = 0; rep_ < DUPN(1); ++rep_) {
            if (rep_) GRIDBAR();
            PHASE_LOCALS();
            const pg8::Gemm g{D, D, D};
            const SchedP1 Sc{Go, bxo, l, wso};
            const EpiP1 E{wso};
            pg8::gemm_phase<EpiP1, SchedP1, false>(F.lds, g, Sc, E);
            if (rep_ == DUPN(1) - 1) SEAM(g0);
        }
        if (IN(g0 + 1)) for (int rep_ = 0; rep_ < DUPN(2); ++rep_) {
            if (rep_) GRIDBAR();
            { PHASE_LOCALS(); const pg8::Gemm g{512, 512, 512};
              const SchedQ Sc{Go, bxo, l, wso};
              const EpiQ E{wso};
              pg8::gemm_phase<EpiQ, SchedQ, false>(F.lds, g, Sc, E); }
            { PHASE_LOCALS(); const pg8::Gemm g{256, 256, 256};
              const SchedKV Sc{Go == 256 ? 96 : Go, Go == 256 ? bxo - 160 : bxo, l, wso};
              const EpiKV E{wso};
              pg8::gemm_phase<EpiKV, SchedKV, false>(F.lds, g, Sc, E); }
            pool_stencil(F);
            if (rep_ == DUPN(2) - 1) SEAM(g0 + 1);
        }
        if (IN(g0 + 2)) { for (int rep_ = 0; rep_ < DUPN(3); ++rep_) { if (rep_) GRIDBAR(); att::attn_phase(F, l); } SEAM(g0 + 2); }
        if (IN(g0 + 3)) for (int rep_ = 0; rep_ < DUPN(4); ++rep_) {
            if (rep_) GRIDBAR();
            PHASE_LOCALS();
            const pg8::Gemm g{D, D, D};
            const SchedOut Sc{Go, bxo, l, wso};
            const EpiOut E{wso};
            pg8::gemm_phase<EpiOut, SchedOut, false>(F.lds, g, Sc, E);
            if (rep_ == DUPN(4) - 1) SEAM(g0 + 3);
        }
        if (IN(g0 + 4)) { for (int rep_ = 0; rep_ < DUPN(5); ++rep_) {
                if (rep_) { GRIDBAR(); if (F.bx == 0 && F.tid < NE) F.ctl[CW_CNT + 2048 * l + 64 * F.tid] = 0u; GRIDBAR(); }
                router_phase(F, l); }
            SEAM(g0 + 4); }
        if (IN(g0 + 5)) {
            moe_tables(F, l);
            { PHASE_LOCALS();
              const int U6 = (int)F.MISC[16 + NE] * 4;
              const pg8::Gemm g{D, D, D};
              const SchedMoE Sc{Go, moe_rank4(bxo, Go), l, false, F.MISC, wso, 0, U6};
              const EpiGU E{wso, l};
              pg8::gemm_phase<EpiGU, SchedMoE, true>(F.lds, g, Sc, E); }
            { PHASE_LOCALS();
              const int TR = (int)F.MISC[16 + NE], U6 = TR * 4, ND = TR * 8;
              const bool fast = (U6 >= Go && U6 - Go <= Go / 2 && Go % 4 == 0);
              const pg8::Gemm g{EH, EH, EH};
              const SchedDown2 Sc{SchedMoE{Go, moe_rank4(bxo, Go), l, true, F.MISC, wso, 0, 0x7fffffff}, fast ? 2 * Go : 0, fast ? U6 - Go : Go, ND};
              const EpiDown E{wso};
              pg8::gemm_phase<EpiDown, SchedDown2, false, true>(F.lds, g, Sc, E); }
            SEAM(g0 + 5);
        }
        if (IN(g0 + 8)) { for (int rep_ = 0; rep_ < DUPN(8); ++rep_) { if (rep_) GRIDBAR(); combine_phase(F, outp, l); } SEAM(g0 + 8); }
    }
}


#ifndef DBG_CHECK
#define DBG_CHECK 0
#endif
#if DBG_CHECK
constexpr int CW_CHK = 20000;
__device__ inline double dbf(const bf16_t* p, size_t i) { return (double)bf2f(p[i]); }
__device__ inline unsigned hsh(unsigned x) { x ^= x >> 16; x *= 0x7feb352du; x ^= x >> 15; x *= 0x846ca68bu; x ^= x >> 16; return x; }
__device__ inline bool bad(double got, double ref, double scale) { const double e = fabs(got - ref); return !(e <= 0.03 * fabs(ref) + 0.03 * scale); }
__global__ void dbg_check(Args A, int which) {
    unsigned char* ws = A.ws; unsigned* chk = (unsigned*)(ws + WS_CTL) + CW_CHK;
    const int sid = blockIdx.x * blockDim.x + threadIdx.x; const unsigned r0 = hsh(sid * 2654435761u + which * 97u + 12345u), r1 = hsh(r0 + 1u), r2 = hsh(r1 + 7u);
    const float* x = A.in[IN_X]; const int* pos = (const int*)A.in[IN_POS];
    const bf16_t* u = (const bf16_t*)(ws + WS_XB); const float* win = A.in[IN_W_IN];
    double* dscr = (double*)(ws + WS_END) + (size_t)sid * 512;
    const int t = r0 % T; bool b = false; int code = which;
    if (which == 0) {
        const int k = r1 % D; double ss = 0; for (int i = 0; i < D; ++i) ss += (double)x[(size_t)t * D + i] * x[(size_t)t * D + i];
        const double ref = x[(size_t)t * D + k] / sqrt(ss / D + 1e-6) * A.in[IN_ATTN_NORM][k]; b = bad(dbf(u, (size_t)t * D + k), ref, 1.0);
    } else if (which >= 1 && which <= 7) {
        auto proj = [&](int col) { double s = 0; for (int k = 0; k < D; ++k) s += dbf(u, (size_t)t * D + k) * (double)win[(size_t)k * NIN + col]; return s; };
        if (which == 1) { const int n = r1 % 512, g = n >> 7, d = n & 127; double s = 0;
            for (int c = 0; c < 128; ++c) s += proj(g * 128 + c) * (double)A.in[IN_POOL_W][(size_t)(g * 128 + c) * 128 + d];
            s *= A.in[IN_POOL_SCALE][n]; b = bad(dbf((const bf16_t*)(ws + WS_ZP), (size_t)t * 512 + n), s, 1.0); }
        if (which == 2) { const int n = r1 % 512; b = bad(dbf((const bf16_t*)(ws + WS_CQ), (size_t)t * 512 + n), proj(512 + n), 1.0);
            if ((sid & 7) == 0) { double ss = 0; for (int c = 0; c < 512; ++c) { const double v = dbf((const bf16_t*)(ws + WS_CQ), (size_t)t * 512 + c); ss += v * v; }
                double got = 0; for (int c = 0; c < 8; ++c) got += ((const float*)(ws + WS_CQSS))[(size_t)t * 8 + c]; b = b || bad(got, ss, 1.0); } }
        if (which == 3) { const int n = r1 % 256; b = bad(dbf((const bf16_t*)(ws + WS_CKV), (size_t)t * 256 + n), proj(1024 + n), 1.0);
            if ((sid & 7) == 0) { double ss = 0; for (int c = 0; c < 256; ++c) { const double v = dbf((const bf16_t*)(ws + WS_CKV), (size_t)t * 256 + c); ss += v * v; }
                double got = 0; for (int c = 0; c < 4; ++c) got += ((const float*)(ws + WS_CKVSS))[(size_t)t * 4 + c]; b = b || bad(got, ss, 1.0); } }
        if (which == 4) { const int i = r1 % 32, p = r2 & 1; const double x1 = proj(1280 + i), x2 = proj(1280 + 32 + i), ang = (double)pos[t] * pow(10000.0, -(double)(2 * i) / 64.0);
            const double ref = p ? x1 * sin(ang) + x2 * cos(ang) : x1 * cos(ang) - x2 * sin(ang); b = bad(dbf((const bf16_t*)(ws + WS_KR), (size_t)t * 64 + 2 * i + p), ref, 1.0); }
        if (which == 5) { const int n = r1 % 768; b = bad(dbf((const bf16_t*)(ws + WS_DQ), (size_t)t * 768 + n), proj(1344 + n) * 0.125 * 1.4426950408889634, 0.2); }
        if (which == 6) { const int n = r1 % 768; b = bad(dbf((const bf16_t*)(ws + WS_DK), (size_t)t * 768 + n), proj(2112 + n), 1.0); }
        if (which == 7) { const int n = r1 % 768; b = bad(dbf((const bf16_t*)(ws + WS_DVT), (size_t)n * T + t), proj(2880 + n), 1.0); }
    } else if (which == 8) {
        const bf16_t* cq = (const bf16_t*)(ws + WS_CQ); double ss = 0; for (int c = 0; c < 512; ++c) { const double v = dbf(cq, (size_t)t * 512 + c); ss += v * v; }
        const double rs = 1.0 / sqrt(ss / 512 + 1e-6);
        auto qraw = [&](int col) { double s = 0; for (int k = 0; k < 512; ++k) s += dbf(cq, (size_t)t * 512 + k) * rs * A.in[IN_Q_NORM][k] * (double)A.in[IN_W_UQ][(size_t)k * 1152 + col]; return s; };
        const int hd = r1 % 6, w = r2 % 192; double ref;
        if (w < 128) ref = qraw(hd * 192 + w); else { const int i = (w - 128) >> 1, p = (w - 128) & 1; const double x1 = qraw(hd * 192 + 128 + i), x2 = qraw(hd * 192 + 160 + i), ang = (double)pos[t] * pow(10000.0, -(double)(2 * i) / 64.0);
            ref = p ? x1 * sin(ang) + x2 * cos(ang) : x1 * cos(ang) - x2 * sin(ang); }
        ref *= 0.07216878364870322 * 1.4426950408889634; b = bad(dbf((const bf16_t*)(ws + WS_QM), (size_t)t * 1152 + hd * 192 + w), ref, 0.1);
    } else if (which == 9 || which == 10) {
        const bf16_t* ckv = (const bf16_t*)(ws + WS_CKV); double ss = 0; for (int c = 0; c < 256; ++c) { const double v = dbf(ckv, (size_t)t * 256 + c); ss += v * v; }
        const double rs = 1.0 / sqrt(ss / 256 + 1e-6); const int hd = r1 % 6, d = r2 % 128, col = hd * 256 + (which == 10 ? 128 : 0) + d;
        double s = 0; for (int k = 0; k < 256; ++k) s += dbf(ckv, (size_t)t * 256 + k) * rs * A.in[IN_KV_NORM][k] * (double)A.in[IN_W_UKV][(size_t)k * 1536 + col];
        const double got = which == 9 ? dbf((const bf16_t*)(ws + WS_KN), (size_t)t * 768 + hd * 128 + d) : dbf((const bf16_t*)(ws + WS_VMT), (size_t)(hd * 128 + d) * T + t); b = bad(got, s, 1.0);
    } else if (which == 11) {
        const bf16_t* zp = (const bf16_t*)(ws + WS_ZP); const int n = r1 % 512, g = n >> 7, wn = 2 << g, s = t & (S - 1), cnt = (s + 1) < wn ? (s + 1) : wn;
        double sm = 0; for (int k = 0; k < cnt; ++k) sm += dbf(zp, (size_t)(t - k) * 512 + n); const double ref = sm / cnt - dbf(zp, (size_t)t * 512 + n);
        b = bad(dbf((const bf16_t*)(ws + WS_MIX), (size_t)t * D + n), ref, 0.5);
    } else if (which == 12) {
        const bf16_t *qm = (const bf16_t*)(ws + WS_QM), *kn = (const bf16_t*)(ws + WS_KN), *kr = (const bf16_t*)(ws + WS_KR), *vmT = (const bf16_t*)(ws + WS_VMT);
        const int hd = r1 % 6, d = r2 % 128, bb = t / S, s = t % S; double mx = -1e300, l = 0, o = 0;
        for (int pass = 0; pass < 2; ++pass) for (int j = 0; j <= s; ++j) { const size_t tj = (size_t)bb * S + j; double sc = 0;
            for (int w = 0; w < 128; ++w) sc += dbf(qm, (size_t)t * 1152 + hd * 192 + w) * dbf(kn, tj * 768 + hd * 128 + w);
            for (int w = 0; w < 64; ++w) sc += dbf(qm, (size_t)t * 1152 + hd * 192 + 128 + w) * dbf(kr, tj * 64 + w);
            if (pass == 0) mx = sc > mx ? sc : mx; else { const double p = exp2(sc - mx); l += p; o += p * dbf(vmT, (size_t)(hd * 128 + d) * T + tj); } }
        b = bad(dbf((const bf16_t*)(ws + WS_MIX), (size_t)t * D + 512 + hd * 128 + d), o / l, 0.3);
    } else if (which == 13) {
        const bf16_t *dq = (const bf16_t*)(ws + WS_DQ), *dk = (const bf16_t*)(ws + WS_DK), *dvT = (const bf16_t*)(ws + WS_DVT);
        const int hd = r1 % 6, bb = t / S, s = t % S; const float* lv = A.in[IN_LAMBDA]; double d1 = 0, d2 = 0; for (int i = 0; i < 64; ++i) { d1 += (double)lv[i] * lv[64 + i]; d2 += (double)lv[128 + i] * lv[192 + i]; }
        const double lam_init = 0.8 - 0.6 * exp(0.0), lam = exp(d1) - exp(d2) + lam_init; double (*om)[128] = (double (*)[128])dscr;
        for (int c = 0; c < 2; ++c) { double mx = -1e300, l = 0; for (int d = 0; d < 128; ++d) om[c][d] = 0;
            for (int pass = 0; pass < 2; ++pass) for (int j = 0; j <= s; ++j) { const size_t tj = (size_t)bb * S + j; double sc = 0;
                for (int w = 0; w < 64; ++w) sc += dbf(dq, (size_t)t * 768 + hd * 128 + c * 64 + w) * dbf(dk, tj * 768 + hd * 128 + c * 64 + w);
                int n = pos[t] - pos[tj]; n = n < 0 ? 0 : n; int bkt; if (n < 16) bkt = n; else { bkt = 16 + (int)(log((double)n / 16.0) / log(8.0) * 16.0); bkt = bkt < 31 ? bkt : 31; }
                sc += (double)A.in[IN_REL_BIAS][bkt * 6 + hd] * 1.4426950408889634;
                if (pass == 0) mx = sc > mx ? sc : mx; else { const double p = exp2(sc - mx); l += p; for (int d = 0; d < 128; ++d) om[c][d] += p * dbf(dvT, (size_t)(hd * 128 + d) * T + tj); } }
            for (int d = 0; d < 128; ++d) om[c][d] /= l; }
        double ss = 0; for (int d = 0; d < 128; ++d) { om[0][d] -= lam * om[1][d]; ss += om[0][d] * om[0][d]; }
        const double rr = (1.0 - lam_init) / sqrt(ss / 128 + 1e-6); const int d = r2 % 128;
        b = bad(dbf((const bf16_t*)(ws + WS_MIX), (size_t)t * D + 1280 + hd * 128 + d), om[0][d] * rr * A.in[IN_SUBLN][d], 0.2);
    } else if (which == 14) {
        const int n = r1 % D; double s = x[(size_t)t * D + n]; for (int k = 0; k < D; ++k) s += dbf((const bf16_t*)(ws + WS_MIX), (size_t)t * D + k) * (double)A.in[IN_W_OUT][(size_t)k * D + n];
        b = bad(dbf((const bf16_t*)(ws + WS_H2), (size_t)t * D + n), s, 1.0);
    } else if (which == 15) {
        const bf16_t* hb_ = (const bf16_t*)(ws + WS_H2); auto hf = [&](size_t i) { return (double)bf2f(hb_[i]); }; double ss = 0; for (int i = 0; i < D; ++i) ss += hf((size_t)t * D + i) * hf((size_t)t * D + i);
        const double rs = 1.0 / sqrt(ss / D + 1e-6); const int k = r1 % D; b = bad(dbf(u, (size_t)t * D + k), hf((size_t)t * D + k) * rs * A.in[IN_FFN_NORM][k], 1.0);
        double* lg = dscr; for (int c = 0; c < 36; ++c) lg[c] = c < 4 ? A.in[IN_RG_B][c] : A.in[IN_RE_B][c - 4];
        for (int i = 0; i < D; ++i) { const double xv = hf((size_t)t * D + i) * rs * A.in[IN_FFN_NORM][i]; for (int c = 0; c < 4; ++c) lg[c] += xv * A.in[IN_RG_W][(size_t)i * 4 + c]; for (int c = 0; c < 32; ++c) lg[4 + c] += xv * A.in[IN_RE_W][(size_t)i * 32 + c]; }
        int gi = 0; for (int c = 1; c < 4; ++c) if (lg[c] > lg[gi]) gi = c; double gs = 0; for (int c = 0; c < 4; ++c) gs += exp(lg[c] - lg[gi]);
        int i0 = 0; for (int q = 1; q < 8; ++q) if (lg[4 + gi * 8 + q] > lg[4 + gi * 8 + i0]) i0 = q; int i1 = -1; for (int q = 0; q < 8; ++q) if (q != i0 && (i1 < 0 || lg[4 + gi * 8 + q] > lg[4 + gi * 8 + i1])) i1 = q;
        const double p0 = 1.0 / (1.0 + exp(lg[4 + gi * 8 + i1] - lg[4 + gi * 8 + i0]));
        const unsigned* cnt_ = (const unsigned*)(ws + WS_CTL) + CW_CNT; auto cntf = [&](int e) { return cnt_[64 * e]; }; const int* list = (const int*)(ws + WS_LIST); const float* gwt = (const float*)(ws + WS_GW);
        for (int kk = 0; kk < 2; ++kk) { const int e = gi * 8 + (kk ? i1 : i0); bool found = false; for (unsigned i = 0; i < cntf(e) && i < LISTCAP; ++i) if (list[e * LISTCAP + i] == t * 2 + kk) found = true;
            b = b || !found || bad(gwt[t * 2 + kk], (kk ? 1.0 - p0 : p0) / gs, 0.01); }
    } else if (which == 16) {
        const unsigned* cnt_ = (const unsigned*)(ws + WS_CTL) + CW_CNT; auto cntf = [&](int e) { return cnt_[64 * e]; }; const int* list = (const int*)(ws + WS_LIST);
        const int e = r0 % NE; if (cntf(e) == 0) return; const int i = r1 % cntf(e), j = r2 % EH; int off = 0; for (int q = 0; q < e; ++q) off += cntf(q);
        const int tok = list[e * LISTCAP + i] >> 1; double g = 0, up = 0;
        for (int k = 0; k < D; ++k) { const double xv = dbf(u, (size_t)tok * D + k); g += xv * (double)A.in[IN_EW_GATE][((size_t)e * D + k) * EH + j]; up += xv * (double)A.in[IN_EW_UP][((size_t)e * D + k) * EH + j]; }
        b = bad(dbf((const bf16_t*)(ws + WS_ACT), (size_t)(off + i) * EH + j), g / (1.0 + exp(-g)) * up, 0.3);
    } else if (which == 17) {
        const unsigned* cnt_ = (const unsigned*)(ws + WS_CTL) + CW_CNT; auto cntf = [&](int e) { return cnt_[64 * e]; }; const int* list = (const int*)(ws + WS_LIST); const float* gwt = (const float*)(ws + WS_GW); const bf16_t* act = (const bf16_t*)(ws + WS_ACT);
        const int n = r1 % D; double s = x[(size_t)t * D + n]; for (int k = 0; k < D; ++k) s += dbf((const bf16_t*)(ws + WS_MIX), (size_t)t * D + k) * (double)A.in[IN_W_OUT][(size_t)k * D + n];
        int off = 0; for (int e = 0; e < NE; ++e) { for (unsigned i = 0; i < cntf(e); ++i) { const int ent = list[e * LISTCAP + i]; if ((ent >> 1) == t) { double y = 0;
                    for (int j = 0; j < EH; ++j) y += dbf(act, (size_t)(off + i) * EH + j) * (double)A.in[IN_EW_DOWN][((size_t)e * EH + j) * D + n]; s += y * gwt[ent]; } } off += cntf(e); }
        b = bad(dbf((const bf16_t*)(ws + WS_H), (size_t)t * D + n), s, 1.0);
    }
    if (b) atomicAdd(chk + code, 1u);
}
__global__ void dbg_apply(Args A) {
    const unsigned* chk = (const unsigned*)(A.ws + WS_CTL) + CW_CHK; double f = 0; for (int k = 0; k < 18; ++k) if (chk[k]) f += pow(4.0, 17 - k);
    if (f == 0) return; const float sc = (float)(1.0 + f);
    for (size_t i = (size_t)blockIdx.x * blockDim.x + threadIdx.x; i < (size_t)T * D; i += (size_t)gridDim.x * blockDim.x) A.out[i] *= sc;
}
#endif

extern "C" void kernel_launch(void* const* d_in, const int* in_sizes, int n_in, void* d_out, int out_size, void* d_ws, size_t ws_size, hipStream_t stream) {
    static int grid = 0;
    if (!grid) {
        if (n_in != 23 || out_size != T * D || ws_size < WS_END) { fprintf(stderr, "kernel_launch: unexpected problem (n_in %d, out %d, ws %zu < %zu)\n", n_in, out_size, ws_size, (size_t)WS_END); grid = -1; return; }
        int dev = 0, cus = 0, per_cu = 0;
        hipGetDevice(&dev); hipDeviceGetAttribute(&cus, hipDeviceAttributeMultiprocessorCount, dev);
        if (hipFuncSetAttribute((const void*)hymba_fwd, hipFuncAttributeMaxDynamicSharedMemorySize, LDS_BYTES) != hipSuccess) { fprintf(stderr, "kernel_launch: hipFuncSetAttribute failed\n"); grid = -1; return; }
        hipOccupancyMaxActiveBlocksPerMultiprocessor(&per_cu, (const void*)hymba_fwd, NTHR, LDS_BYTES);
        if (per_cu < 1) { fprintf(stderr, "kernel_launch: occupancy query says %d blocks per CU\n", per_cu); }
        grid = cus > 0 ? cus : 256;
    }
    if (grid < 0) return;
    hipMemsetAsync((char*)d_ws + WS_CTL, 0, CTL_BYTES, stream);
    Args a{};
    for (int i = 0; i < 23; ++i) a.in[i] = (const float*)d_in[i];
    a.out = (float*)d_out; a.ws = (unsigned char*)d_ws; a.pad = 0;
#if MK_LAUNCHES == 1
    a.g_lo = 0; a.g_hi = 1 + 9 * NL; a.use_bar = 1;
    hipLaunchKernelGGL(hymba_fwd, dim3(grid), dim3(NTHR), LDS_BYTES, stream, a);
#else
    for (int k = 0; k < 1 + 9 * NL; ++k) { a.g_lo = k; a.g_hi = k + 1; a.use_bar = 0; hipLaunchKernelGGL(hymba_fwd, dim3(grid), dim3(NTHR), LDS_BYTES, stream, a);
#if DBG_CHECK
        auto chk = [&](int which, int blocks) { hipLaunchKernelGGL(dbg_check, dim3(blocks), dim3(64), 0, stream, a, which); };
        if (k == 0) chk(0, 4);
        if (k == 1) for (int w = 1; w <= 7; ++w) chk(w, w == 1 ? 1 : 4);
        if (k == 2) for (int w = 8; w <= 11; ++w) chk(w, 4);
        if (k == 3) { chk(12, 2); chk(13, 1); }
        if (k == 4) chk(14, 4);
        if (k == 5) chk(15, 4);
        if (k == 7) chk(16, 4);
        if (k == 9) chk(17, 4);
        if (k == 9 * NL) hipLaunchKernelGGL(dbg_apply, dim3(1024), dim3(256), 0, stream, a);
#endif
    }
#endif
}
```

```cpp
#include <hip/hip_runtime.h>
#include <cstdio>
#include <cstdint>

#ifndef MK_LAUNCHES
#define MK_LAUNCHES 1
#endif

#ifndef DUP_MASK
#define DUP_MASK 0
#endif
#define DUPN(p) (((DUP_MASK) >> (p)) & 1 ? 2 : 1)
#define LAS __attribute__((address_space(3)))
#define GAS __attribute__((address_space(1)))
typedef unsigned short bf16_t;
typedef short bf16x8 __attribute__((ext_vector_type(8)));
typedef float f32x4 __attribute__((ext_vector_type(4)));
typedef float f32x2 __attribute__((ext_vector_type(2)));
typedef float f32x16 __attribute__((ext_vector_type(16)));
typedef unsigned u32x4 __attribute__((ext_vector_type(4)));
typedef unsigned u32x2 __attribute__((ext_vector_type(2)));
typedef __bf16 bfv2 __attribute__((ext_vector_type(2)));

constexpr int T = 8192, D = 2048, S = 2048, NB = 4, NL = 4, NIN = 3648;
constexpr int NE = 32, EH = 512, LISTCAP = 8192;
constexpr float EPS = 1e-6f;
constexpr float LOG2E = 1.4426950408889634f;
constexpr int NWAVES = 8, NTHR = 512;

constexpr size_t MiB = 1u << 20;
constexpr size_t al256(size_t x) { return (x + 255) & ~(size_t)255; }
constexpr size_t WS_CTL = 0, CTL_BYTES = 1 * MiB;
constexpr size_t SZ_WIN = (size_t)3072 * 2048 * 2, SZ_WDV = (size_t)768 * 2048 * 2, SZ_WUQ = (size_t)1280 * 512 * 2, SZ_WK = (size_t)768 * 256 * 2,
                 SZ_WOUT = (size_t)2048 * 2048 * 2, SZ_WGU1 = (size_t)1024 * 2048 * 2, SZ_WD1 = (size_t)2048 * 512 * 2;
constexpr size_t WS_WIN = WS_CTL + CTL_BYTES;
constexpr size_t WS_WDV = WS_WIN + NL * SZ_WIN;
constexpr size_t WS_WUQ = WS_WDV + NL * SZ_WDV;
constexpr size_t WS_WK = WS_WUQ + NL * SZ_WUQ;
constexpr size_t WS_WV = WS_WK + NL * SZ_WK;
constexpr size_t WS_WOUT = WS_WV + NL * SZ_WK;
constexpr size_t WS_WGU = WS_WOUT + NL * SZ_WOUT;
constexpr size_t WS_WD = WS_WGU + (size_t)NL * NE * SZ_WGU1;
constexpr size_t WS_COS = WS_WD + (size_t)NL * NE * SZ_WD1;
constexpr size_t WS_SIN = WS_COS + (size_t)T * 32 * 4;
constexpr size_t WS_LUT = WS_SIN + (size_t)T * 32 * 4;
constexpr size_t WS_TMAX = WS_LUT + al256(6 * 132 * 4);
constexpr size_t WS_H = WS_TMAX + al256(NB * 32 * 4);
constexpr size_t WS_XB = WS_H + (size_t)T * D * 4;
constexpr size_t WS_ZP = WS_XB + (size_t)T * D * 2;
constexpr size_t WS_CQ = WS_ZP + (size_t)T * 512 * 2;
constexpr size_t WS_CKV = WS_CQ + (size_t)T * 512 * 2;
constexpr size_t WS_KR = WS_CKV + (size_t)T * 256 * 2;
constexpr size_t WS_DQ = WS_KR + (size_t)T * 64 * 2;
constexpr size_t WS_DK = WS_DQ + (size_t)T * 768 * 2;
constexpr size_t WS_DVT = WS_DK + (size_t)T * 768 * 2;
constexpr size_t WS_QM = WS_DVT + (size_t)T * 768 * 2;
constexpr size_t WS_KN = WS_QM + (size_t)T * 1152 * 2;
constexpr size_t WS_VMT = WS_KN + (size_t)T * 768 * 2;
constexpr size_t WS_MIX = WS_VMT + (size_t)T * 768 * 2;
constexpr size_t WS_CQSS = WS_MIX + (size_t)T * D * 2;
constexpr size_t WS_CKVSS = WS_CQSS + (size_t)T * 8 * 4;
constexpr size_t WS_GW = WS_CKVSS + (size_t)T * 4 * 4;
constexpr size_t WS_LIST = WS_GW + (size_t)T * 2 * 4;
constexpr size_t WS_ACT = WS_LIST + (size_t)NE * LISTCAP * 4;
constexpr size_t WS_Y2 = WS_ACT + (size_t)(2 * T + 256) * EH * 2;
constexpr size_t WS_Y1 = WS_Y2 + (size_t)T * D * 4;
constexpr size_t WS_H2 = WS_Y1 + (size_t)T * D * 4;
constexpr size_t WS_WRH = WS_H2 + (size_t)T * D * 4;
constexpr size_t WS_WRL = WS_WRH + (size_t)NL * 64 * D * 2;
constexpr size_t WS_END = WS_WRL + (size_t)NL * 64 * D * 2;
constexpr int CW_BAR = 4096, CW_TMO = 12288, CW_CNT = 16384, CW_RDY = 32768;

constexpr int LDS_MISC = 135168;
constexpr int LDS_BYTES = 147456;

__device__ __forceinline__ unsigned pk2(float lo, float hi) { f32x2 v = {lo, hi}; return __builtin_bit_cast(unsigned, __builtin_convertvector(v, bfv2)); }
__device__ __forceinline__ f32x4 unpk4(u32x2 a) { return (f32x4){__builtin_bit_cast(float, a.x << 16), __builtin_bit_cast(float, a.x & 0xffff0000u), __builtin_bit_cast(float, a.y << 16), __builtin_bit_cast(float, a.y & 0xffff0000u)}; }
__device__ __forceinline__ float bf2f(unsigned short b) { return __builtin_bit_cast(float, (unsigned)b << 16); }
template <int M> __device__ __forceinline__ float xor_lt32(float v) { return __builtin_bit_cast(float, __builtin_amdgcn_ds_swizzle(__builtin_bit_cast(int, v), (M << 10) | 0x1f)); }
__device__ __forceinline__ float sum32(float v) { const unsigned x = __builtin_bit_cast(unsigned, v); auto r = __builtin_amdgcn_permlane32_swap(x, x, false, false);
    unsigned a = r[0], b = r[1]; asm volatile("" : "+v"(a), "+v"(b));
    return __builtin_bit_cast(float, a) + __builtin_bit_cast(float, b); }
__device__ __forceinline__ float max32(float v) { const unsigned x = __builtin_bit_cast(unsigned, v); auto r = __builtin_amdgcn_permlane32_swap(x, x, false, false);
    unsigned a = r[0], b = r[1]; asm volatile("" : "+v"(a), "+v"(b));
    return fmaxf(__builtin_bit_cast(float, a), __builtin_bit_cast(float, b)); }
__device__ __forceinline__ float wave_sum(float v) {
    v += xor_lt32<1>(v); v += xor_lt32<2>(v); v += xor_lt32<4>(v); v += xor_lt32<8>(v); v += xor_lt32<16>(v);
    return sum32(v);
}
#define LDS_WAIT() asm volatile("s_waitcnt lgkmcnt(0)" ::: "memory")

#define XB_TMO      128
#define XB_XCNT(j)  (256  + 64 * (j))
#define XB_XSUB(j)  (1280 + 64 * (j))
#define XB_XGEN(j)  (2304 + 64 * (j))
#define XB_TOP      3328
#define XB_TOPGEN   3392
#define XCD_BAR_WORDS 3456
#define XB_SPIN_CAP (1u << 18)
__device__ __forceinline__ unsigned xb_ld(unsigned* p)              { return __hip_atomic_load(p, __ATOMIC_RELAXED, __HIP_MEMORY_SCOPE_AGENT); }
__device__ __forceinline__ unsigned xb_add(unsigned* p, unsigned v) { return __hip_atomic_fetch_add(p, v, __ATOMIC_RELAXED, __HIP_MEMORY_SCOPE_AGENT); }
__device__ __forceinline__ unsigned xb_xcc_id() { return (unsigned)__builtin_amdgcn_s_getreg((3 << 11) | 20) & 0xFu; }
#define XB_SPIN(cond, bar) do { unsigned _sp = 0; while (cond) { __builtin_amdgcn_s_sleep(1); \
    if ((++_sp & 255u) == 0u) { if (xb_ld(&(bar)[XB_TMO])) break; if (_sp > XB_SPIN_CAP) { atomicAdd(&(bar)[XB_TMO], 1u); break; } } } } while (0)
struct XcdBarrier { unsigned* bar; unsigned x; volatile LAS unsigned* st; };
__device__ __forceinline__ XcdBarrier xcd_barrier_post(unsigned* bar, volatile LAS unsigned* st) {
    XcdBarrier b; b.bar = bar; b.x = xb_xcc_id(); b.st = st;
    if (threadIdx.x == 0) (void)xb_add(&bar[XB_XCNT(b.x)], 1u);
    return b;
}
__device__ __forceinline__ void xcd_barrier_complete(unsigned* bar, unsigned x, unsigned& nloc, unsigned& nx) {
    const unsigned G = gridDim.x * gridDim.y * gridDim.z;
    unsigned sum, cnt, mine, sp = 0u;
    for (;;) {
        sum = 0u; cnt = 0u; mine = 0u;
#pragma unroll
        for (unsigned j = 0; j < 16; ++j) { const unsigned c = xb_ld(&bar[XB_XCNT(j)]); sum += c; cnt += (c > 0u) ? 1u : 0u; mine = (j == x) ? c : mine; }
        if (sum == G) break;
        __builtin_amdgcn_s_sleep(1);
        if ((++sp & 255u) == 0u) { if (xb_ld(&bar[XB_TMO])) break; if (sp > XB_SPIN_CAP) { atomicAdd(&bar[XB_TMO], 1u); break; } }
    }
    nloc = mine > 0u ? mine : 1u; nx = cnt > 0u ? cnt : 1u;
}
__device__ __forceinline__ void xcd_barrier(const XcdBarrier& b) {
    asm volatile("s_waitcnt vmcnt(0)" ::: "memory");
    __syncthreads();
    if (threadIdx.x == 0) {
        unsigned* bar = b.bar;
        __builtin_amdgcn_s_waitcnt(0);
        unsigned nloc = b.st[0], nx = b.st[1];
        if (nloc == 0u) { xcd_barrier_complete(bar, b.x, nloc, nx); b.st[0] = nloc; b.st[1] = nx; }
        const unsigned old = xb_add(&bar[XB_XSUB(b.x)], 1u);
        const unsigned gen = old / nloc;
        if (old + 1u == (gen + 1u) * nloc) {
            __builtin_amdgcn_fence(__ATOMIC_RELEASE, "agent");
            asm volatile("s_waitcnt vmcnt(0)" ::: "memory");
            const unsigned og = xb_add(&bar[XB_TOP], 1u);
            const unsigned tg = og / nx;
            if (og + 1u == (tg + 1u) * nx) xb_add(&bar[XB_TOPGEN], 1u);
            else XB_SPIN(xb_ld(&bar[XB_TOPGEN]) == tg, bar);
            __builtin_amdgcn_fence(__ATOMIC_ACQUIRE, "agent");
            xb_add(&bar[XB_XGEN(b.x)], 1u);
            asm volatile("s_waitcnt vmcnt(0)" ::: "memory");
        } else {
            XB_SPIN(xb_ld(&bar[XB_XGEN(b.x)]) == gen, bar);
            __builtin_amdgcn_fence(__ATOMIC_ACQUIRE, "agent");
            asm volatile("s_waitcnt vmcnt(0)" ::: "memory");
        }
    }
    __syncthreads();
}

namespace pg8 {
constexpr int BM = 256, BK = 64, HALF = 128, HTB = HALF * BK * 2, STAGE_BYTES = 8 * HTB, NXCD = 8, WGM = 8;
__host__ __device__ __forceinline__ int lds_byte(int r, int c) { const int st = (r >> 4) * 2 + (c >> 5), rr = r & 15, cc = c & 31, ob = rr * 64 + cc * 2; return st * 1024 + (ob ^ (((ob >> 9) & 1) << 5)); }
__host__ __device__ __forceinline__ void stage_rc(int b, int& R, int& C) { const int st = b / 1024, sb = b % 1024, swz = sb ^ (((sb >> 9) & 1) << 5); R = (st >> 1) * 16 + swz / 64; C = (st & 1) * 32 + (swz % 64) / 2; }
__host__ __device__ __forceinline__ int perm32(int rho) { const int n = rho >> 4, i = rho & 15; return 8 * (i >> 2) + 4 * n + (i & 3); }

struct Unit { const char* a; const char* b; const int* rowmap; int nrows; int p0, p1, p2, p3; };
struct Gemm { int K, lda, ldb; };

__device__ __forceinline__ void tile_of(int L, int nM, int nN, int& pm, int& pn) {
    const int nwg = nM * nN; int wgid = L;
    { const int q = nwg / NXCD, r = nwg % NXCD, xcd = wgid % NXCD, off = wgid / NXCD; wgid = (xcd < r ? xcd * (q + 1) : r * (q + 1) + (xcd - r) * q) + off; }
    const int nig = WGM * nN, gid = wgid / nig, fm = gid * WGM, gsz = (nM - fm) < WGM ? (nM - fm) : WGM;
    pm = fm + ((wgid % nig) % gsz); pn = (wgid % nig) / gsz;
}

template <class Epi, class Sched, bool GATHER, bool HOOK = false>
__device__ __forceinline__ void gemm_phase(LAS unsigned char* lds, const Gemm g, const Sched& S, const Epi& E) {
    int tid_ = threadIdx.x; asm volatile("" : "+v"(tid_));
    const int tid = tid_, wid = __builtin_amdgcn_readfirstlane(tid >> 6), lane = tid & 63, wr = wid >> 2, wc = wid & 3, fr = lane & 15, fq = lane >> 4;
    const int K = g.K, nt = K / BK;
    unsigned voffA[2], voffB[2];
#pragma unroll
    for (int i = 0; i < 2; ++i) { int R, C; stage_rc(tid * 16 + i * 8192, R, C); const int Rb = Epi::PERM ? ((R & ~31) + perm32(R & 31)) : R;
        voffA[i] = (unsigned)(R * g.lda + C) * 2u; voffB[i] = (unsigned)(Rb * g.ldb + C) * 2u; }
    const size_t kstep = (size_t)(BK * 2);
    const size_t hstepA = (size_t)HALF * g.lda * 2, hstepB = (size_t)HALF * g.ldb * 2;
    const unsigned ldsw = (unsigned)wid * 1024u;
    const int aoff = lds_byte(wr * 64 + fr, fq * 8), boff = lds_byte(wc * 32 + fr, fq * 8);
    unsigned ga[2][2], gn[2][2];
#define PG8_SA(b, h) (((b) * 2 + (h)) * HTB)
#define PG8_SB(b, h) ((4 + (b) * 2 + (h)) * HTB)
#define PG8_GLDS(src, dst) __builtin_amdgcn_global_load_lds((const unsigned*)(src), (LAS unsigned*)(dst), 16, 0, 0)
#define PG8_STAGE_B(bufoff, gbase) do { _Pragma("unroll") for (int _i = 0; _i < 2; ++_i) PG8_GLDS((const char*)(gbase) + voffB[_i], lds + (bufoff) + ldsw + _i * 8192); } while (0)
#define PG8_STAGE_A(bufoff, gbase, hh, SEL) do { _Pragma("unroll") for (int _i = 0; _i < 2; ++_i) { \
        if constexpr (GATHER) PG8_GLDS((const char*)(gbase) + ((SEL) ? gn[hh][_i] : ga[hh][_i]), lds + (bufoff) + ldsw + _i * 8192); \
        else PG8_GLDS((const char*)(gbase) + (hh) * hstepA + voffA[_i], lds + (bufoff) + ldsw + _i * 8192); } } while (0)
#define PG8_GMAP(u, O) do { if constexpr (GATHER) { _Pragma("unroll") for (int _h = 0; _h < 2; ++_h) _Pragma("unroll") for (int _i = 0; _i < 2; ++_i) { \
        int _R, _C; stage_rc(tid * 16 + _i * 8192, _R, _C); const int _r = _R + 128 * _h; const int _e0 = (u).rowmap[_r < (u).nrows ? _r : 0] >> 1;   const int _e = (_r < (u).nrows) ? _e0 : 0; O[_h][_i] = (unsigned)(_e * g.lda + _C) * 2u; } } } while (0)
#define PG8_LDA(dst, b, h) do { _Pragma("unroll") for (int m = 0; m < 4; ++m) _Pragma("unroll") for (int k = 0; k < 2; ++k) dst[m][k] = *(const LAS bf16x8*)(lds + PG8_SA(b, h) + aoff + m * 2048 + k * 1024); } while (0)
#define PG8_LDB(dst, b, h) do { _Pragma("unroll") for (int n = 0; n < 2; ++n) _Pragma("unroll") for (int k = 0; k < 2; ++k) dst[n][k] = *(const LAS bf16x8*)(lds + PG8_SB(b, h) + boff + n * 2048 + k * 1024); } while (0)
#define PG8_MMA(ai, bj, At, Bt) do { __builtin_amdgcn_s_setprio(1); _Pragma("unroll") for (int m = 0; m < 4; ++m) _Pragma("unroll") for (int n = 0; n < 2; ++n) _Pragma("unroll") for (int k = 0; k < 2; ++k) \
        acc[ai][bj][m][n] = __builtin_amdgcn_mfma_f32_16x16x32_bf16(Bt[n][k], At[m][k], acc[ai][bj][m][n], 0, 0, 0); __builtin_amdgcn_s_setprio(0); } while (0)
#define PG8_WAIT_V(n) asm volatile("s_waitcnt vmcnt(" #n ")" ::: "memory")
#define PG8_WAIT_L(n) asm volatile("s_waitcnt lgkmcnt(" #n ")" ::: "memory")
#define PG8_BAR __builtin_amdgcn_s_barrier()
#define PG8_SCHED __builtin_amdgcn_sched_barrier(0)
    Unit cur, nxt; int ui = 0;
    if (!S.next(0, cur)) return;
    if constexpr (HOOK) S.a_ready(cur);
    f32x4 acc[2][2][4][2];
#pragma unroll
    for (int a = 0; a < 2; ++a)
#pragma unroll
        for (int b = 0; b < 2; ++b)
#pragma unroll
            for (int m = 0; m < 4; ++m)
#pragma unroll
                for (int n = 0; n < 2; ++n) acc[a][b][m][n] = (f32x4){0.f, 0.f, 0.f, 0.f};
    bf16x8 At[4][2], B0[2][2], B1[2][2];
    const char* cA = cur.a; const char* cB = cur.b;
    PG8_GMAP(cur, ga);
    PG8_STAGE_B(PG8_SB(0, 0), cB); PG8_STAGE_A(PG8_SA(0, 0), cA, 0, false); PG8_STAGE_B(PG8_SB(0, 1), cB + hstepB); PG8_STAGE_A(PG8_SA(0, 1), cA, 1, false);
    if (wr == 1) PG8_BAR;
    PG8_WAIT_V(4); PG8_BAR;
    PG8_STAGE_B(PG8_SB(1, 0), cB + kstep); PG8_STAGE_A(PG8_SA(1, 0), cA + kstep, 0, false); PG8_STAGE_B(PG8_SB(1, 1), cB + hstepB + kstep);
    PG8_WAIT_V(6); PG8_BAR;
    for (;;) {
        const bool has_next = S.next(ui + 1, nxt);
        const char* nA = has_next ? nxt.a : cA; const char* nB = has_next ? nxt.b : cB;
        if constexpr (GATHER) { if (has_next) { PG8_GMAP(nxt, gn); } else {
#pragma unroll
            for (int _h = 0; _h < 2; ++_h)
#pragma unroll
                for (int _i = 0; _i < 2; ++_i) gn[_h][_i] = ga[_h][_i]; } }
        for (int t = 0; t < nt; t += 2) {
            const bool last = (t == nt - 2);
            if constexpr (HOOK) { if (last && has_next) S.a_ready(nxt); }
            const char* a1 = cA + (size_t)(t + 1) * kstep;
            const char* a2 = last ? nA : cA + (size_t)(t + 2) * kstep; const char* b2 = last ? nB : cB + (size_t)(t + 2) * kstep;
            const char* a3 = a2 + kstep; const char* b3 = b2 + kstep;
            PG8_LDB(B0, 0, 0); PG8_SCHED; PG8_LDA(At, 0, 0); PG8_STAGE_A(PG8_SA(1, 1), a1, 1, false);
            PG8_WAIT_L(8); PG8_BAR; PG8_WAIT_L(0); PG8_MMA(0, 0, At, B0); PG8_BAR; PG8_SCHED;
            PG8_LDB(B1, 0, 1); PG8_STAGE_B(PG8_SB(0, 0), b2);
            PG8_BAR; PG8_WAIT_L(0); PG8_MMA(0, 1, At, B1); PG8_BAR;
            PG8_LDA(At, 0, 1); PG8_STAGE_A(PG8_SA(0, 0), a2, 0, last);
            PG8_BAR; PG8_WAIT_L(0); PG8_MMA(1, 0, At, B0); PG8_BAR; PG8_SCHED;
            PG8_STAGE_B(PG8_SB(0, 1), b2 + hstepB);
            PG8_WAIT_V(6); PG8_BAR; PG8_MMA(1, 1, At, B1); PG8_BAR;
            PG8_LDB(B0, 1, 0); PG8_SCHED; PG8_LDA(At, 1, 0); PG8_STAGE_A(PG8_SA(0, 1), a2, 1, last);
            PG8_WAIT_L(8); PG8_BAR; PG8_WAIT_L(0); PG8_MMA(0, 0, At, B0); PG8_BAR; PG8_SCHED;
            PG8_LDB(B1, 1, 1); PG8_STAGE_B(PG8_SB(1, 0), b3);
            PG8_BAR; PG8_WAIT_L(0); PG8_MMA(0, 1, At, B1); PG8_BAR;
            PG8_LDA(At, 1, 1); PG8_STAGE_A(PG8_SA(1, 0), a3, 0, last);
            PG8_BAR; PG8_WAIT_L(0); PG8_MMA(1, 0, At, B0); PG8_BAR; PG8_SCHED;
            PG8_STAGE_B(PG8_SB(1, 1), b3 + hstepB);
            PG8_WAIT_V(6); PG8_BAR; PG8_MMA(1, 1, At, B1); PG8_BAR;
        }
        { int le = threadIdx.x & 63; asm volatile("" : "+v"(le));
          E(acc, cur, wr, wc, le & 15, le >> 4); }
        if (!has_next) break;
#pragma unroll
        for (int a = 0; a < 2; ++a)
#pragma unroll
            for (int b = 0; b < 2; ++b)
#pragma unroll
                for (int m = 0; m < 4; ++m)
#pragma unroll
                    for (int n = 0; n < 2; ++n) acc[a][b][m][n] = (f32x4){0.f, 0.f, 0.f, 0.f};
        cur = nxt; cA = nA; cB = nB; ++ui;
        if constexpr (GATHER) {
#pragma unroll
            for (int _h = 0; _h < 2; ++_h)
#pragma unroll
                for (int _i = 0; _i < 2; ++_i) ga[_h][_i] = gn[_h][_i]; }
    }
    PG8_WAIT_V(0);
    if (wr == 0) PG8_BAR;
    PG8_BAR;
#undef PG8_SA
#undef PG8_SB
#undef PG8_GLDS
#undef PG8_STAGE_A
#undef PG8_STAGE_B
#undef PG8_GMAP
#undef PG8_LDA
#undef PG8_LDB
#undef PG8_MMA
#undef PG8_WAIT_V
#undef PG8_WAIT_L
#undef PG8_BAR
#undef PG8_SCHED
}

__device__ __forceinline__ void store_tile_bf16(const f32x4 (&acc)[2][2][4][2], bf16_t* dst, size_t ld, int row0, int col0, float scale, int wr, int wc, int fr, int fq) {
#pragma unroll
    for (int ai = 0; ai < 2; ++ai)
#pragma unroll
        for (int m = 0; m < 4; ++m) { bf16_t* rowp = dst + (size_t)(row0 + ai * HALF + wr * 64 + m * 16 + fr) * ld + col0 + wc * 32 + 8 * fq;
#pragma unroll
            for (int bj = 0; bj < 2; ++bj) { const f32x4 v0 = acc[ai][bj][m][0] * scale, v1 = acc[ai][bj][m][1] * scale;
                u32x4 w; w.x = pk2(v0[0], v0[1]); w.y = pk2(v0[2], v0[3]); w.z = pk2(v1[0], v1[1]); w.w = pk2(v1[2], v1[3]);
                *(u32x4*)(rowp + bj * HALF) = w; } }
}
}

struct Args { const float* in[23]; float* out; unsigned char* ws; int g_lo, g_hi, use_bar, pad; };
enum { IN_X = 0, IN_POS, IN_ATTN_NORM, IN_W_IN, IN_POOL_W, IN_POOL_SCALE, IN_Q_NORM, IN_W_UQ, IN_KV_NORM, IN_W_UKV, IN_LAMBDA, IN_SUBLN, IN_REL_BIAS, IN_W_OUT, IN_FFN_NORM,
       IN_RG_W, IN_RG_B, IN_RE_W, IN_RE_B, IN_EW_GATE, IN_EW_UP, IN_EW_DOWN, IN_FINAL_NORM };

struct Frame {
    LAS unsigned char* lds;
    volatile LAS unsigned* MISC;
    unsigned* ctl;
    unsigned char* ws;
    unsigned char* ws0;
    int tid, lane, wave, vcu, G, bx;
};
constexpr int MISC_PTAB = 192;
__device__ __forceinline__ const float* inptr(const Frame& F, int i) {
    const unsigned lo = __builtin_amdgcn_readfirstlane(F.MISC[MISC_PTAB + 2 * i]), hi = __builtin_amdgcn_readfirstlane(F.MISC[MISC_PTAB + 2 * i + 1]);
    return (const float*)(GAS const float*)(((unsigned long long)hi << 32) | lo);
}

__device__ __forceinline__ void frame_refresh(Frame& F) {
    int t = threadIdx.x; asm volatile("" : "+v"(t)); F.tid = t; F.lane = t & 63; F.wave = __builtin_amdgcn_readfirstlane(t >> 6);
    int bx = blockIdx.x, G = gridDim.x; asm volatile("" : "+s"(bx), "+s"(G)); F.bx = bx; F.G = G; F.vcu = (G % 8 == 0) ? (bx % 8) * (G / 8) + bx / 8 : bx;
    GAS unsigned char* w = (GAS unsigned char*)F.ws0; asm volatile("" : "+s"(w)); F.ws = (unsigned char*)w; F.ctl = (unsigned*)(F.ws + WS_CTL);
    LAS unsigned char* lb = F.lds; asm volatile("" : "+s"(lb)); F.MISC = (volatile LAS unsigned*)(lb + LDS_MISC);
}
__device__ __forceinline__ void tr_write(bf16_t* WT, int ldo, int n0, int k0, LAS float* scr, int lane) {
    LDS_WAIT(); asm volatile("" ::: "memory");
#pragma unroll
    for (int it = 0; it < 8; ++it) { const int n = 8 * it + (lane >> 3), kc = lane & 7; const LAS float* s = scr + (8 * kc) * 65 + n;
        u32x4 o; o.x = pk2(s[0], s[65]); o.y = pk2(s[2 * 65], s[3 * 65]); o.z = pk2(s[4 * 65], s[5 * 65]); o.w = pk2(s[6 * 65], s[7 * 65]);
        __builtin_nontemporal_store(o, (u32x4*)(WT + (size_t)(n0 + n) * ldo + k0 + 8 * kc)); }
    LDS_WAIT(); asm volatile("" ::: "memory");
}
__device__ __forceinline__ void tr_item(const float* W, int ldw, int k0, int c0, bf16_t* WT, int ldo, int n0, const float* kscale, LAS float* scr, int lane) {
#pragma unroll
    for (int i = 0; i < 16; ++i) { const int k = 4 * i + (lane >> 4); f32x4 v = __builtin_nontemporal_load((const f32x4*)(W + (size_t)(k0 + k) * ldw + c0 + 4 * (lane & 15)));
        if (kscale) v = v * kscale[k0 + k];
        LAS float* d = scr + k * 65 + 4 * (lane & 15); d[0] = v[0]; d[1] = v[1]; d[2] = v[2]; d[3] = v[3]; }
    tr_write(WT, ldo, n0, k0, scr, lane);
}
__device__ __forceinline__ void tr_item_map(const float* W, int ldw, int k0, int srccol, bf16_t* WT, int ldo, int n0, const float* kscale, LAS float* scr, int lane) {
#pragma unroll 8
    for (int k = 0; k < 64; ++k) { float v = 0.f; if (srccol >= 0) { v = W[(size_t)(k0 + k) * ldw + srccol]; if (kscale) v *= kscale[k0 + k]; } scr[k * 65 + lane] = v; }
    tr_write(WT, ldo, n0, k0, scr, lane);
}

struct XItem { const float* src; bf16_t* dst; int ldw, ldo; };
constexpr int XJ_GU = 32 * 2 * 8 * 32, XJ_D = 32 * 32 * 8, XJ_L = XJ_GU + XJ_D;
__device__ __forceinline__ XItem x_item(Frame& F, int x) {
    unsigned char* ws = F.ws; const int l = x / XJ_L; int r = x % XJ_L; XItem it;
    if (r < XJ_GU) {
        const int e = r / 512, q = r % 512, isup = q >> 8, ntile = q & 7, kt = (q >> 3) & 31, c0 = ntile * 64, n0 = (c0 >> 7) * 256 + isup * 128 + (c0 & 127);
        it.src = inptr(F, isup ? IN_EW_UP : IN_EW_GATE) + ((size_t)l * NE + e) * D * EH + (size_t)(kt * 64) * EH + c0; it.ldw = EH;
        it.dst = (bf16_t*)(ws + WS_WGU + ((size_t)l * NE + e) * SZ_WGU1) + (size_t)n0 * D + kt * 64; it.ldo = D; }
    else { r -= XJ_GU;
        const int e = r / 256, q = r % 256, ntile = q & 31, kt = q >> 5;
        it.src = inptr(F, IN_EW_DOWN) + ((size_t)l * NE + e) * EH * D + (size_t)(kt * 64) * D + ntile * 64; it.ldw = D;
        it.dst = (bf16_t*)(ws + WS_WD + ((size_t)l * NE + e) * SZ_WD1) + (size_t)(ntile * 64) * EH + kt * 64; it.ldo = EH; }
    return it;
}
#define X_LOAD(R, IT) do { _Pragma("unroll") for (int _i = 0; _i < 16; ++_i) R[_i] = __builtin_nontemporal_load((const f32x4*)((IT).src + (size_t)(4 * _i + (lane >> 4)) * (IT).ldw + 4 * (lane & 15))); } while (0)
#define X_OUT(R, IT) do { _Pragma("unroll") for (int _i = 0; _i < 16; ++_i) { LAS float* _d = scr + (4 * _i + (lane >> 4)) * 65 + 4 * (lane & 15); _d[0] = R[_i][0]; _d[1] = R[_i][1]; _d[2] = R[_i][2]; _d[3] = R[_i][3]; } \
        tr_write((IT).dst, (IT).ldo, 0, 0, scr, lane); } while (0)

__device__ __forceinline__ void p0_prologue(Frame& F) {
    frame_refresh(F);
    unsigned char* ws = F.ws;
    {
        LAS float* AsT = (LAS float*)F.lds;
        LAS float* Pw = (LAS float*)(F.lds + 128 * 68 * 4);
        for (int it = F.bx; it < NL * 4 * 32; it += F.G) {
            const int l = it / 128, g = (it / 32) & 3, kb = it & 31;
            const float* win = inptr(F, IN_W_IN) + (size_t)l * D * NIN; const float* pw = inptr(F, IN_POOL_W) + (size_t)(l * 4 + g) * 128 * 128; const float* ps = inptr(F, IN_POOL_SCALE) + l * 512 + g * 128;
            __syncthreads();
#pragma unroll
            for (int i = 0; i < 4; ++i) { const int idx = F.tid + 512 * i, row = idx >> 5, c4 = idx & 31; const f32x4 v = *(const f32x4*)(win + (size_t)(kb * 64 + row) * NIN + g * 128 + 4 * c4);
                LAS float* d = AsT + (4 * c4) * 68 + row; d[0] = v[0]; d[68] = v[1]; d[136] = v[2]; d[204] = v[3]; }
#pragma unroll
            for (int i = 0; i < 8; ++i) { const int idx = F.tid + 512 * i, c = idx >> 5, d4 = idx & 31; f32x4 v = *(const f32x4*)(pw + c * 128 + 4 * d4); const f32x4 sc = *(const f32x4*)(ps + 4 * d4);
                *(LAS f32x4*)(Pw + c * 128 + 4 * d4) = v * sc; }
            __syncthreads();
            const int kg = F.tid & 15, d4 = F.tid >> 4; f32x4 acc[4];
#pragma unroll
            for (int i = 0; i < 4; ++i) acc[i] = (f32x4){0.f, 0.f, 0.f, 0.f};
#pragma unroll 4
            for (int c = 0; c < 128; ++c) { const f32x4 pv = *(const LAS f32x4*)(Pw + c * 128 + 4 * d4), av = *(const LAS f32x4*)(AsT + c * 68 + 4 * kg);
#pragma unroll
                for (int i = 0; i < 4; ++i) acc[i] += pv * av[i]; }
            bf16_t* o = (bf16_t*)(ws + WS_WIN + (size_t)l * SZ_WIN) + (size_t)(g * 128 + 4 * d4) * D + kb * 64 + 4 * kg;
#pragma unroll
            for (int j = 0; j < 4; ++j) { u32x2 w; w.x = pk2(acc[0][j], acc[1][j]); w.y = pk2(acc[2][j], acc[3][j]); *(u32x2*)(o + (size_t)j * D) = w; }
        }
        __syncthreads();
    }
    {
        LAS float* scr = (LAS float*)(F.lds + F.wave * 16640);
        const int gw = F.vcu * NWAVES + F.wave, NGW = F.G * NWAVES, lane = F.lane;
        constexpr int J_WO = 32 * 32, J_A = 12 * 32, J_KR = 32, J_B = 24 * 32, J_DV = 12 * 32, J_UQ = 20 * 8, J_K = 12 * 4, J_V = 12 * 4;
        constexpr int J_L = J_WO + J_A + J_KR + J_B + J_DV + J_UQ + J_K + J_V;
        {
            f32x4 RA[16], RB[16]; int x = gw; XItem ia = x_item(F, x < NL * XJ_L ? x : 0), ib;
            if (x < NL * XJ_L) X_LOAD(RA, ia);
            while (x < NL * XJ_L) {
                const int x1 = x + NGW; if (x1 < NL * XJ_L) { ib = x_item(F, x1); X_LOAD(RB, ib); }
                X_OUT(RA, ia);
                if (x1 >= NL * XJ_L) break;
                const int x2 = x1 + NGW; if (x2 < NL * XJ_L) { ia = x_item(F, x2); X_LOAD(RA, ia); }
                X_OUT(RB, ib);
                x = x2;
            }
        }
        for (int it = gw; it < NL * J_L; it += NGW) {
            const int l = it / J_L; int r = it % J_L;
            const float* win = inptr(F, IN_W_IN) + (size_t)l * D * NIN;
            bf16_t* WinT = (bf16_t*)(ws + WS_WIN + (size_t)l * SZ_WIN);
            if (r < J_WO) { const int ntile = r >> 5, kt = r & 31;
                tr_item(inptr(F, IN_W_OUT) + (size_t)l * D * D, D, kt * 64, ntile * 64, (bf16_t*)(ws + WS_WOUT + (size_t)l * SZ_WOUT), D, ntile * 64, nullptr, scr, lane); continue; }
            r -= J_WO;
            if (r < J_A) { const int ntile = r >> 5, kt = r & 31;
                tr_item(win, NIN, kt * 64, 512 + ntile * 64, WinT, D, 512 + ntile * 64, nullptr, scr, lane); continue; }
            r -= J_A;
            if (r < J_KR) { const int kt = r;
                tr_item_map(win, NIN, kt * 64, 1280 + (lane >> 1) + 32 * (lane & 1), WinT, D, 1280, nullptr, scr, lane); continue; }
            r -= J_KR;
            if (r < J_B) { const int ntile = r >> 5, kt = r & 31;
                tr_item(win, NIN, kt * 64, 1344 + ntile * 64, WinT, D, 1536 + ntile * 64, nullptr, scr, lane); continue; }
            r -= J_B;
            if (r < J_DV) { const int ntile = r >> 5, kt = r & 31;
                tr_item(win, NIN, kt * 64, 2880 + ntile * 64, (bf16_t*)(ws + WS_WDV + (size_t)l * SZ_WDV), D, ntile * 64, nullptr, scr, lane); continue; }
            r -= J_DV;
            if (r < J_UQ) { const int ntile = r >> 3, kt = r & 7;
                const int n = ntile * 64 + lane; int src = -1;
                if (n < 1152) { const int hd = n / 192, w = n % 192; src = hd * 192 + (w < 128 ? w : 128 + ((w - 128) >> 1) + 32 * ((w - 128) & 1)); }
                tr_item_map(inptr(F, IN_W_UQ) + (size_t)l * 512 * 1152, 1152, kt * 64, src, (bf16_t*)(ws + WS_WUQ + (size_t)l * SZ_WUQ), 512, ntile * 64, inptr(F, IN_Q_NORM) + l * 512, scr, lane); continue; }
            r -= J_UQ;
            {
                const bool isv = r >= J_K; if (isv) r -= J_K;
                const int ntile = r >> 2, kt = r & 3, n0 = ntile * 64, hd = n0 >> 7, c0 = hd * 256 + (isv ? 128 : 0) + (n0 & 127);
                tr_item(inptr(F, IN_W_UKV) + (size_t)l * 256 * 1536, 1536, kt * 64, c0, (bf16_t*)(ws + (isv ? WS_WV : WS_WK) + (size_t)l * SZ_WK), 256, n0, inptr(F, IN_KV_NORM) + l * 256, scr, lane);
            }
        }
        for (int l = 0; l < NL; ++l) { u32x4* z = (u32x4*)((bf16_t*)(ws + WS_WIN + (size_t)l * SZ_WIN) + (size_t)1344 * D);
            for (int i = gw * 64 + lane; i < 192 * D / 8; i += NGW * 64) z[i] = (u32x4){0u, 0u, 0u, 0u}; }
        const int* pos = (const int*)inptr(F, IN_POS);
        for (int i = gw * 64 + lane; i < T * 32; i += NGW * 64) { const int t = i >> 5, f = i & 31;
            const double inv = pow(10000.0, -(double)(2 * f) / 64.0); const double ang = (double)pos[t] * inv;
            ((float*)(ws + WS_COS))[i] = (float)cos(ang); ((float*)(ws + WS_SIN))[i] = (float)sin(ang); }
        for (int i = gw * 64 + lane; i < 6 * 132; i += NGW * 64) { const int hd = i / 132, n = i % 132; float v = 0.f;
            if (n <= 128) { int bkt; if (n < 16) bkt = n; else { bkt = 16 + (int)(log((double)n / 16.0) / log(8.0) * 16.0); bkt = bkt < 31 ? bkt : 31; }
                v = inptr(F, IN_REL_BIAS)[bkt * 6 + hd] * LOG2E; }
            ((float*)(ws + WS_LUT))[i] = v; }
        for (int i = gw * 64 + lane; i < NL * 64 * D; i += NGW * 64) { const int l = i / (64 * D), c = (i / D) & 63, k = i & (D - 1); float v = 0.f;
            if (c < 4) v = inptr(F, IN_RG_W)[((size_t)l * D + k) * 4 + c]; else if (c < 36) v = inptr(F, IN_RE_W)[((size_t)l * D + k) * 32 + c - 4];
            v *= inptr(F, IN_FFN_NORM)[l * D + k];
            const unsigned hi = pk2(v, 0.f) & 0xffffu; const float rem = v - __builtin_bit_cast(float, hi << 16);
            const int fo = (((l * 8 + (k >> 8)) * 16 + ((k >> 4) & 15)) * 4 + (c >> 5)) * 512 + ((c & 31) + 32 * ((k >> 3) & 1)) * 8 + (k & 7);
            ((bf16_t*)(ws + WS_WRH))[fo] = (bf16_t)hi; ((bf16_t*)(ws + WS_WRH))[fo + 1024] = (bf16_t)(pk2(rem, 0.f) & 0xffffu); }
        for (int i = gw * 64 + lane; i < NB * 32; i += NGW * 64) { int mx = pos[i * 64]; for (int j = 1; j < 64; ++j) { const int p = pos[i * 64 + j]; mx = p > mx ? p : mx; } ((int*)(ws + WS_TMAX))[i] = mx; }
        const float* x = inptr(F, IN_X); bf16_t* h = (bf16_t*)(ws + WS_H); bf16_t* u = (bf16_t*)(ws + WS_XB); const float* gn = inptr(F, IN_ATTN_NORM);
        f32x4 g0[8];
#pragma unroll
        for (int j = 0; j < 8; ++j) g0[j] = ((const f32x4*)gn)[lane + 64 * j];
        for (int m = gw; m < T; m += NGW) {
            const f32x4* xr = (const f32x4*)(x + (size_t)m * D) + lane; u32x2* hr = (u32x2*)(h + (size_t)m * D) + lane; f32x4 v[8]; float s = 0.f;
#pragma unroll
            for (int j = 0; j < 8; ++j) v[j] = xr[64 * j];
            asm volatile("" ::: "memory");
#pragma unroll
            for (int j = 0; j < 8; ++j) { { u32x2 hw; hw.x = pk2(v[j][0], v[j][1]); hw.y = pk2(v[j][2], v[j][3]); hr[64 * j] = hw; } s += (v[j][0] * v[j][0] + v[j][1] * v[j][1]) + (v[j][2] * v[j][2] + v[j][3] * v[j][3]); }
            const float rs = 1.0f / sqrtf(wave_sum(s) * (1.0f / D) + EPS);
            u32x2* o = (u32x2*)(u + (size_t)m * D) + lane;
#pragma unroll
            for (int j = 0; j < 8; ++j) { const f32x4 gg = g0[j]; u32x2 w; w.x = pk2(v[j][0] * rs * gg[0], v[j][1] * rs * gg[1]); w.y = pk2(v[j][2] * rs * gg[2], v[j][3] * rs * gg[3]); o[64 * j] = w; }
        }
    }
}

enum { K1_ZP = 0, K1_CQ, K1_CKV, K1_KR, K1_DQ, K1_DK, K1_DVT };
struct SchedP1 {
    int G, c, l; unsigned char* ws;
    __device__ __forceinline__ bool next(int i, pg8::Unit& U) const {
        const int L = i * G + c; if (L >= 480) return false;
        const char* u = (const char*)(ws + WS_XB); const char* win = (const char*)(ws + WS_WIN + (size_t)l * SZ_WIN); const char* wdv = (const char*)(ws + WS_WDV + (size_t)l * SZ_WDV);
        U.rowmap = nullptr; U.nrows = 256; U.p3 = 0;
        if (L < 384) { int pm, pn; pg8::tile_of(L, 32, 12, pm, pn);
            U.a = u + (size_t)pm * 256 * D * 2; U.b = win + (size_t)pn * 256 * D * 2; U.p1 = 256 * pm;
            if (pn < 2) { U.p0 = K1_ZP; U.p2 = 256 * pn; } else if (pn < 4) { U.p0 = K1_CQ; U.p2 = 256 * (pn - 2); } else if (pn == 4) { U.p0 = K1_CKV; U.p2 = 0; }
            else if (pn == 5) { U.p0 = K1_KR; U.p2 = 0; } else if (pn < 9) { U.p0 = K1_DQ; U.p2 = 256 * (pn - 6); } else { U.p0 = K1_DK; U.p2 = 256 * (pn - 9); }
        } else { const int Ls = L - 384, pm = Ls % 3, pn = Ls / 3;
            U.a = wdv + (size_t)pm * 256 * D * 2; U.b = u + (size_t)pn * 256 * D * 2; U.p0 = K1_DVT; U.p1 = 256 * pm; U.p2 = 256 * pn; }
        return true;
    }
};
struct EpiP1 {
    static constexpr bool PERM = true;
    unsigned char* ws;
    __device__ __forceinline__ void operator()(const f32x4 (&acc)[2][2][4][2], const pg8::Unit& U, int wr, int wc, int fr, int fq) const {
        const int kind = U.p0, row0 = U.p1, col0 = U.p2;
        bf16_t *zp = (bf16_t*)(ws + WS_ZP), *cq = (bf16_t*)(ws + WS_CQ), *ckv = (bf16_t*)(ws + WS_CKV), *kr = (bf16_t*)(ws + WS_KR), *dq = (bf16_t*)(ws + WS_DQ), *dk = (bf16_t*)(ws + WS_DK), *dvT = (bf16_t*)(ws + WS_DVT);
        float *cqss = (float*)(ws + WS_CQSS), *ckvss = (float*)(ws + WS_CKVSS); const float *cs = (const float*)(ws + WS_COS), *sn = (const float*)(ws + WS_SIN);
        if (kind == K1_ZP) { pg8::store_tile_bf16(acc, zp, 512, row0, col0, 1.0f, wr, wc, fr, fq); }
        else if (kind == K1_CQ || kind == K1_CKV) {
            if (kind == K1_CQ) pg8::store_tile_bf16(acc, cq, 512, row0, col0, 1.0f, wr, wc, fr, fq); else pg8::store_tile_bf16(acc, ckv, 256, row0, 0, 1.0f, wr, wc, fr, fq);
            float* ss = (kind == K1_CQ) ? cqss : ckvss; const int ns = (kind == K1_CQ) ? 8 : 4, slot = (kind == K1_CQ) ? (col0 >> 8) * 4 + wc : wc;
#pragma unroll
            for (int ai = 0; ai < 2; ++ai)
#pragma unroll
                for (int m = 0; m < 4; ++m) { float s = 0.f;
#pragma unroll
                    for (int bj = 0; bj < 2; ++bj)
#pragma unroll
                        for (int n = 0; n < 2; ++n) { const f32x4 x = acc[ai][bj][m][n]; s += (x[0] * x[0] + x[1] * x[1]) + (x[2] * x[2] + x[3] * x[3]); }
                    s += xor_lt32<16>(s); s = sum32(s);
                    if (fq == 0) ss[(size_t)(row0 + ai * 128 + wr * 64 + m * 16 + fr) * ns + slot] = s; }
        }
        else if (kind == K1_KR) {
            if (wc < 2) {
#pragma unroll
                for (int ai = 0; ai < 2; ++ai) { f32x4 cb[4], sb[4];
#pragma unroll
                    for (int i = 0; i < 4; ++i) { const int row = row0 + ai * 128 + wr * 64 + i * 16 + fr; cb[i] = *(const f32x4*)(cs + (size_t)row * 32 + 16 * wc + 4 * fq); sb[i] = *(const f32x4*)(sn + (size_t)row * 32 + 16 * wc + 4 * fq); }
                    asm volatile("" ::: "memory");
#pragma unroll
                    for (int m = 0; m < 4; ++m) { const int row = row0 + ai * 128 + wr * 64 + m * 16 + fr;
                        const f32x4 c4 = cb[m], s4 = sb[m];
                        const f32x4 v0 = acc[ai][0][m][0], v1 = acc[ai][0][m][1]; u32x4 w;
                        w.x = pk2(v0[0] * c4[0] - v0[1] * s4[0], v0[0] * s4[0] + v0[1] * c4[0]); w.y = pk2(v0[2] * c4[1] - v0[3] * s4[1], v0[2] * s4[1] + v0[3] * c4[1]);
                        w.z = pk2(v1[0] * c4[2] - v1[1] * s4[2], v1[0] * s4[2] + v1[1] * c4[2]); w.w = pk2(v1[2] * c4[3] - v1[3] * s4[3], v1[2] * s4[3] + v1[3] * c4[3]);
                        *(u32x4*)(kr + (size_t)row * 64 + 32 * wc + 8 * fq) = w; asm volatile("" ::: "memory"); } }
            }
        }
        else if (kind == K1_DQ) { pg8::store_tile_bf16(acc, dq, 768, row0, col0, 0.125f * LOG2E, wr, wc, fr, fq); }
        else if (kind == K1_DK) { pg8::store_tile_bf16(acc, dk, 768, row0, col0, 1.0f, wr, wc, fr, fq); }
        else { pg8::store_tile_bf16(acc, dvT, T, row0, col0, 1.0f, wr, wc, fr, fq); }
    }
};

struct SchedQ {
    int G, c, l; unsigned char* ws;
    __device__ __forceinline__ bool next(int i, pg8::Unit& U) const {
        const int L = i * G + c; if (L >= 160) return false;
        const char* cq = (const char*)(ws + WS_CQ); const char* wuq = (const char*)(ws + WS_WUQ + (size_t)l * SZ_WUQ);
        int pm, pn; pg8::tile_of(L, 32, 5, pm, pn);
        U.a = cq + (size_t)pm * 256 * 512 * 2; U.b = wuq + (size_t)pn * 256 * 512 * 2; U.rowmap = nullptr; U.nrows = 256; U.p0 = 0; U.p1 = 256 * pm; U.p2 = 256 * pn; U.p3 = 0; return true;
    }
};
constexpr float QM_SCALE = 0.07216878364870322f * LOG2E;
struct EpiQ {
    static constexpr bool PERM = true;
    unsigned char* ws;
    __device__ __forceinline__ void operator()(const f32x4 (&acc)[2][2][4][2], const pg8::Unit& U, int wr, int wc, int fr, int fq) const {
        const int row0 = U.p1, colt = U.p2;
        bf16_t* qm = (bf16_t*)(ws + WS_QM); const float* cqss = (const float*)(ws + WS_CQSS); const float *cs = (const float*)(ws + WS_COS), *sn = (const float*)(ws + WS_SIN);
        bool isr[2], inr[2]; int i0 = 0;
#pragma unroll
        for (int bj = 0; bj < 2; ++bj) { const int cg = colt + bj * 128 + wc * 32 + 8 * fq, w = cg % 192; inr[bj] = cg < 1152; isr[bj] = inr[bj] && w >= 128; if (isr[bj]) i0 = (w - 128) >> 1; }
#pragma unroll
        for (int ai = 0; ai < 2; ++ai)
#pragma unroll
          for (int mh = 0; mh < 4; mh += 2) {
            f32x4 p0[2], p1[2], c4[2], s4[2];
#pragma unroll
            for (int m2 = 0; m2 < 2; ++m2) { const int row = row0 + ai * 128 + wr * 64 + (mh + m2) * 16 + fr;
                p0[m2] = *(const f32x4*)(cqss + (size_t)row * 8); p1[m2] = *(const f32x4*)(cqss + (size_t)row * 8 + 4); c4[m2] = *(const f32x4*)(cs + (size_t)row * 32 + i0); s4[m2] = *(const f32x4*)(sn + (size_t)row * 32 + i0); }
            asm volatile("" ::: "memory");
#pragma unroll
            for (int m2 = 0; m2 < 2; ++m2) { const int m = mh + m2; int row = row0 + ai * 128 + wr * 64 + m * 16 + fr; asm volatile("" : "+v"(row));
                const float ssum = ((p0[m2][0] + p0[m2][1]) + (p0[m2][2] + p0[m2][3])) + ((p1[m2][0] + p1[m2][1]) + (p1[m2][2] + p1[m2][3]));
                const float rs = QM_SCALE / sqrtf(ssum * (1.0f / 512.0f) + EPS); const f32x4 cc = c4[m2], ss = s4[m2];
#pragma unroll
                for (int bj = 0; bj < 2; ++bj) { const int cg = colt + bj * 128 + wc * 32 + 8 * fq;
                    if (inr[bj]) { const f32x4 v0 = acc[ai][bj][m][0] * rs, v1 = acc[ai][bj][m][1] * rs; u32x4 o;
                        if (isr[bj]) {
                            o.x = pk2(v0[0] * cc[0] - v0[1] * ss[0], v0[0] * ss[0] + v0[1] * cc[0]); o.y = pk2(v0[2] * cc[1] - v0[3] * ss[1], v0[2] * ss[1] + v0[3] * cc[1]);
                            o.z = pk2(v1[0] * cc[2] - v1[1] * ss[2], v1[0] * ss[2] + v1[1] * cc[2]); o.w = pk2(v1[2] * cc[3] - v1[3] * ss[3], v1[2] * ss[3] + v1[3] * cc[3]); }
                        else { o.x = pk2(v0[0], v0[1]); o.y = pk2(v0[2], v0[3]); o.z = pk2(v1[0], v1[1]); o.w = pk2(v1[2], v1[3]); }
                        *(u32x4*)(qm + (size_t)row * 1152 + cg) = o; } }
                asm volatile("" ::: "memory"); }
          }
    }
};
struct SchedKV {
    int G, c, l; unsigned char* ws;
    __device__ __forceinline__ bool next(int i, pg8::Unit& U) const {
        const int L = i * G + c; if (c < 0 || L >= 192) return false;
        const char* ckv = (const char*)(ws + WS_CKV); const char* wk = (const char*)(ws + WS_WK + (size_t)l * SZ_WK); const char* wv = (const char*)(ws + WS_WV + (size_t)l * SZ_WK);
        U.rowmap = nullptr; U.nrows = 256; U.p3 = 0;
        if (L < 96) { int pm, pn; pg8::tile_of(L, 32, 3, pm, pn); U.a = ckv + (size_t)pm * 256 * 256 * 2; U.b = wk + (size_t)pn * 256 * 256 * 2; U.p0 = 0; U.p1 = 256 * pm; U.p2 = 256 * pn; }
        else { const int Ls = L - 96, pm = Ls % 3, pn = Ls / 3; U.a = wv + (size_t)pm * 256 * 256 * 2; U.b = ckv + (size_t)pn * 256 * 256 * 2; U.p0 = 1; U.p1 = 256 * pm; U.p2 = 256 * pn; }
        return true;
    }
};
struct EpiKV {
    static constexpr bool PERM = true;
    unsigned char* ws;
    __device__ __forceinline__ float rs_of(int t) const { const float* ckvss = (const float*)(ws + WS_CKVSS); const f32x4 p = *(const f32x4*)(ckvss + (size_t)t * 4); return 1.0f / sqrtf(((p[0] + p[1]) + (p[2] + p[3])) * (1.0f / 256.0f) + EPS); }
    __device__ __forceinline__ void operator()(const f32x4 (&acc)[2][2][4][2], const pg8::Unit& U, int wr, int wc, int fr, int fq) const {
        const int row0 = U.p1, col0 = U.p2; bf16_t *kn = (bf16_t*)(ws + WS_KN), *vmT = (bf16_t*)(ws + WS_VMT);
        if (U.p0 == 0) {
            float rsb[8]; { f32x4 pv[8]; const float* ckvss = (const float*)(ws + WS_CKVSS);
#pragma unroll
              for (int i = 0; i < 8; ++i) pv[i] = *(const f32x4*)(ckvss + (size_t)(row0 + (i >> 2) * 128 + wr * 64 + (i & 3) * 16 + fr) * 4);
              asm volatile("" ::: "memory");
#pragma unroll
              for (int i = 0; i < 8; ++i) rsb[i] = 1.0f / sqrtf(((pv[i][0] + pv[i][1]) + (pv[i][2] + pv[i][3])) * (1.0f / 256.0f) + EPS); }
#pragma unroll
            for (int ai = 0; ai < 2; ++ai)
#pragma unroll
                for (int m = 0; m < 4; ++m) { int row = row0 + ai * 128 + wr * 64 + m * 16 + fr; asm volatile("" : "+v"(row)); const float rs = rsb[ai * 4 + m];
                    bf16_t* rowp = kn + (size_t)row * 768 + col0 + wc * 32 + 8 * fq;
#pragma unroll
                    for (int bj = 0; bj < 2; ++bj) { const f32x4 v0 = acc[ai][bj][m][0] * rs, v1 = acc[ai][bj][m][1] * rs;
                        u32x4 w; w.x = pk2(v0[0], v0[1]); w.y = pk2(v0[2], v0[3]); w.z = pk2(v1[0], v1[1]); w.w = pk2(v1[2], v1[3]); *(u32x4*)(rowp + bj * 128) = w; }
                    asm volatile("" ::: "memory"); }
        } else {
#pragma unroll
            for (int bj = 0; bj < 2; ++bj) { const int t0 = col0 + bj * 128 + wc * 32 + 8 * fq; float rs[8]; { f32x4 pv[8]; const float* ckvss = (const float*)(ws + WS_CKVSS);
#pragma unroll
                for (int j = 0; j < 8; ++j) pv[j] = *(const f32x4*)(ckvss + (size_t)(t0 + j) * 4);
                asm volatile("" ::: "memory");
#pragma unroll
                for (int j = 0; j < 8; ++j) rs[j] = 1.0f / sqrtf(((pv[j][0] + pv[j][1]) + (pv[j][2] + pv[j][3])) * (1.0f / 256.0f) + EPS); }
#pragma unroll
                for (int ai = 0; ai < 2; ++ai)
#pragma unroll
                    for (int m = 0; m < 4; ++m) { int row = row0 + ai * 128 + wr * 64 + m * 16 + fr; asm volatile("" : "+v"(row)); const f32x4 v0 = acc[ai][bj][m][0], v1 = acc[ai][bj][m][1];
                        u32x4 w; w.x = pk2(v0[0] * rs[0], v0[1] * rs[1]); w.y = pk2(v0[2] * rs[2], v0[3] * rs[3]); w.z = pk2(v1[0] * rs[4], v1[1] * rs[5]); w.w = pk2(v1[2] * rs[6], v1[3] * rs[7]);
                        *(u32x4*)(vmT + (size_t)row * T + t0) = w; }
                asm volatile("" ::: "memory"); }
        }
    }
};
template <int WIN> __device__ __forceinline__ void pool_load(u32x4 (&v)[WIN], const bf16_t* zrow, int cnt) {
#pragma unroll
    for (int k = 0; k < WIN; ++k) { const int kk = k < cnt ? k : 0; v[k] = *(const u32x4*)(zrow - (size_t)kk * 512); }
}
template <int WIN> __device__ __forceinline__ void pool_out(const u32x4 (&v)[WIN], bf16_t* orow, int cnt) {
    float sum[8], self[8];
#pragma unroll
    for (int j = 0; j < 4; ++j) { self[2 * j] = __builtin_bit_cast(float, v[0][j] << 16); self[2 * j + 1] = __builtin_bit_cast(float, v[0][j] & 0xffff0000u); sum[2 * j] = self[2 * j]; sum[2 * j + 1] = self[2 * j + 1]; }
#pragma unroll
    for (int k = 1; k < WIN; ++k)
#pragma unroll
        for (int j = 0; j < 4; ++j) { const unsigned w = k < cnt ? v[k][j] : 0u; sum[2 * j] += __builtin_bit_cast(float, w << 16); sum[2 * j + 1] += __builtin_bit_cast(float, w & 0xffff0000u); }
    const float ic = 1.0f / (float)cnt; u32x4 o;
    o.x = pk2(sum[0] * ic - self[0], sum[1] * ic - self[1]); o.y = pk2(sum[2] * ic - self[2], sum[3] * ic - self[3]);
    o.z = pk2(sum[4] * ic - self[4], sum[5] * ic - self[5]); o.w = pk2(sum[6] * ic - self[6], sum[7] * ic - self[7]);
    *(u32x4*)orow = o;
}
__device__ __forceinline__ void pool_stencil(Frame& F) {
    frame_refresh(F);
    const bf16_t* zp = (const bf16_t*)(F.ws + WS_ZP); bf16_t* mix = (bf16_t*)(F.ws + WS_MIX);
    for (int q = F.vcu * NTHR + F.tid; q < T * 16; q += F.G * NTHR) {
        const int t = q >> 4, c16 = q & 15, s = t & (S - 1);
        const int c0 = (s + 1) < 2 ? (s + 1) : 2, c1 = (s + 1) < 4 ? (s + 1) : 4, c2 = (s + 1) < 8 ? (s + 1) : 8, c3 = (s + 1) < 16 ? (s + 1) : 16;
        const bf16_t* zr = zp + (size_t)t * 512 + c16 * 8; bf16_t* orow = mix + (size_t)t * D + c16 * 8;
        u32x4 v0[2], v1[4], v2[8], v3[16];
        pool_load<16>(v3, zr + 384, c3); pool_load<8>(v2, zr + 256, c2); pool_load<4>(v1, zr + 128, c1); pool_load<2>(v0, zr, c0);
        asm volatile("" ::: "memory");
        pool_out<16>(v3, orow + 384, c3); pool_out<8>(v2, orow + 256, c2); pool_out<4>(v1, orow + 128, c1); pool_out<2>(v0, orow, c0);
    }
}

constexpr int ATT_MAXU = 3;
__device__ const unsigned short att_sched[256][ATT_MAXU] = {
  {1407,1266,65535},
  {1391,1250,65535},
  {1375,1234,65535},
  {1359,1218,65535},
  {1343,1202,65535},
  {1327,1186,65535},
  {1311,1170,65535},
  {1295,1154,65535},
  {1279,1138,65535},
  {1263,1122,65535},
  {1247,1106,65535},
  {1231,1090,65535},
  {1215,1074,65535},
  {1199,1058,65535},
  {1183,1042,65535},
  {1167,1026,65535},
  {1151,1393,1265},
  {1135,1377,1249},
  {1119,1361,1233},
  {1103,1345,1217},
  {1087,1329,1201},
  {1071,1313,1185},
  {1055,1297,1169},
  {1039,1281,1153},
  {1406,241,65535},
  {1390,225,65535},
  {1374,209,65535},
  {1358,193,65535},
  {1342,177,65535},
  {1326,161,65535},
  {1310,145,65535},
  {1294,129,65535},
  {1278,113,65535},
  {1262,97,65535},
  {1246,81,65535},
  {1230,65,65535},
  {1214,49,65535},
  {1198,33,65535},
  {1182,17,65535},
  {1166,1,65535},
  {1150,1394,1137},
  {1134,1378,1121},
  {1118,1362,1105},
  {1102,1346,1089},
  {1086,1330,1073},
  {1070,1314,1057},
  {1054,1298,1041},
  {1038,1282,1025},
  {375,1267,65535},
  {359,1251,65535},
  {343,1235,65535},
  {327,1219,65535},
  {311,1203,65535},
  {295,1187,65535},
  {279,1171,65535},
  {263,1155,65535},
  {247,1139,65535},
  {231,1123,65535},
  {215,1107,65535},
  {199,1091,65535},
  {183,1075,65535},
  {167,1059,65535},
  {151,1043,65535},
  {135,1027,65535},
  {119,369,65535},
  {103,353,65535},
  {87,337,65535},
  {71,321,65535},
  {55,305,65535},
  {39,289,65535},
  {23,273,65535},
  {7,257,65535},
  {1405,1268,65535},
  {1389,1252,65535},
  {1373,1236,65535},
  {1357,1220,65535},
  {1341,1204,65535},
  {1325,1188,65535},
  {1309,1172,65535},
  {1293,1156,65535},
  {1277,1140,65535},
  {1261,1124,65535},
  {1245,1108,65535},
  {1229,1092,65535},
  {1213,1076,65535},
  {1197,1060,65535},
  {1181,1044,65535},
  {1165,1028,65535},
  {1149,1395,1392},
  {1133,1379,1376},
  {1117,1363,1360},
  {1101,1347,1344},
  {1085,1331,1328},
  {1069,1315,1312},
  {1053,1299,1296},
  {1037,1283,1280},
  {1404,242,65535},
  {1388,226,65535},
  {1372,210,65535},
  {1356,194,65535},
  {1340,178,65535},
  {1324,162,65535},
  {1308,146,65535},
  {1292,130,65535},
  {1276,114,65535},
  {1260,98,65535},
  {1244,82,65535},
  {1228,66,65535},
  {1212,50,65535},
  {1196,34,65535},
  {1180,18,65535},
  {1164,2,65535},
  {1148,1396,368},
  {1132,1380,352},
  {1116,1364,336},
  {1100,1348,320},
  {1084,1332,304},
  {1068,1316,288},
  {1052,1300,272},
  {1036,1284,256},
  {374,1269,65535},
  {358,1253,65535},
  {342,1237,65535},
  {326,1221,65535},
  {310,1205,65535},
  {294,1189,65535},
  {278,1173,65535},
  {262,1157,65535},
  {246,1141,65535},
  {230,1125,65535},
  {214,1109,65535},
  {198,1093,65535},
  {182,1077,65535},
  {166,1061,65535},
  {150,1045,65535},
  {134,1029,65535},
  {118,370,65535},
  {102,354,65535},
  {86,338,65535},
  {70,322,65535},
  {54,306,65535},
  {38,290,65535},
  {22,274,65535},
  {6,258,65535},
  {1403,1270,65535},
  {1387,1254,65535},
  {1371,1238,65535},
  {1355,1222,65535},
  {1339,1206,65535},
  {1323,1190,65535},
  {1307,1174,65535},
  {1291,1158,65535},
  {1275,1142,65535},
  {1259,1126,65535},
  {1243,1110,65535},
  {1227,1094,65535},
  {1211,1078,65535},
  {1195,1062,65535},
  {1179,1046,65535},
  {1163,1030,65535},
  {1147,1397,240},
  {1131,1381,224},
  {1115,1365,208},
  {1099,1349,192},
  {1083,1333,176},
  {1067,1317,160},
  {1051,1301,144},
  {1035,1285,128},
  {1402,243,65535},
  {1386,227,65535},
  {1370,211,65535},
  {1354,195,65535},
  {1338,179,65535},
  {1322,163,65535},
  {1306,147,65535},
  {1290,131,65535},
  {1274,115,65535},
  {1258,99,65535},
  {1242,83,65535},
  {1226,67,65535},
  {1210,51,65535},
  {1194,35,65535},
  {1178,19,65535},
  {1162,3,65535},
  {1146,1398,1264},
  {1130,1382,1248},
  {1114,1366,1232},
  {1098,1350,1216},
  {1082,1334,1200},
  {1066,1318,1184},
  {1050,1302,1168},
  {1034,1286,1152},
  {373,1271,65535},
  {357,1255,65535},
  {341,1239,65535},
  {325,1223,65535},
  {309,1207,65535},
  {293,1191,65535},
  {277,1175,65535},
  {261,1159,65535},
  {245,1143,65535},
  {229,1127,65535},
  {213,1111,65535},
  {197,1095,65535},
  {181,1079,65535},
  {165,1063,65535},
  {149,1047,65535},
  {133,1031,65535},
  {117,371,65535},
  {101,355,65535},
  {85,339,65535},
  {69,323,65535},
  {53,307,65535},
  {37,291,65535},
  {21,275,65535},
  {5,259,65535},
  {1401,1272,65535},
  {1385,1256,65535},
  {1369,1240,65535},
  {1353,1224,65535},
  {1337,1208,65535},
  {1321,1192,65535},
  {1305,1176,65535},
  {1289,1160,65535},
  {1273,1144,65535},
  {1257,1128,65535},
  {1241,1112,65535},
  {1225,1096,65535},
  {1209,1080,65535},
  {1193,1064,65535},
  {1177,1048,65535},
  {1161,1032,65535},
  {1145,1399,112},
  {1129,1383,96},
  {1113,1367,80},
  {1097,1351,64},
  {1081,1335,48},
  {1065,1319,32},
  {1049,1303,16},
  {1033,1287,0},
  {372,116,65535},
  {356,100,65535},
  {340,84,65535},
  {324,68,65535},
  {308,52,65535},
  {292,36,65535},
  {276,20,65535},
  {260,4,65535},
  {244,1400,1136},
  {228,1384,1120},
  {212,1368,1104},
  {196,1352,1088},
  {180,1336,1072},
  {164,1320,1056},
  {148,1304,1040},
  {132,1288,1024},
};
namespace att {
constexpr int VROW = 136, KBUF = 64 * 400, VBUF = 128 * VROW, BUF = KBUF + VBUF;
constexpr int LUT_OFF = 2 * BUF;
constexpr int TMAX_OFF = LUT_OFF + 3328, POS_OFF = TMAX_OFF + 512;
#define MFMA32(a, b, c) __builtin_amdgcn_mfma_f32_32x32x16_bf16((a), (b), (c), 0, 0, 0)

template <int DQK, int KEL, bool BIAS>
__device__ __forceinline__ void attn_core(LAS unsigned char* lds, int tid, int lane,
        const bf16_t* qrow, const bf16_t* kA, int ldkA, const bf16_t* kB, const bf16_t* vT, int q0, int nj, int koffB,
        const LAS int* posb, const LAS int* tmaxb, const LAS float* lut, f32x16 (&o)[4]) {
    constexpr int KROW = KEL * 2 + 16, KC = KEL / 8, NKL = KC / 8, NKS = DQK / 16;
    const int r31 = lane & 31, hh = lane >> 5;
    const int qi = q0 + r31, jd = q0 >> 6;
    bf16x8 qf[NKS];
#pragma unroll
    for (int ks = 0; ks < NKS; ++ks) qf[ks] = *(const bf16x8*)(qrow + 16 * ks + 8 * hh);
#pragma unroll
    for (int dt = 0; dt < 4; ++dt)
#pragma unroll
        for (int r = 0; r < 16; ++r) o[dt][r] = 0.f;
    float mrun = 0.f, lsum = 0.f;
    int pq = 0; if (BIAS) pq = posb[qi];
    u32x4 kreg[NKL]; u32x4 vreg[2];
#define ATT_LOAD(j) do { _Pragma("unroll") for (int _i = 0; _i < NKL; ++_i) { const int _c = tid + 512 * _i, _row = _c / KC, _ch = _c % KC; \
            const bf16_t* _s = (KEL == 192 && _ch >= 16) ? (kB + (size_t)(64 * (j) + _row) * 64 + (_ch - 16) * 8) : (kA + (size_t)(64 * (j) + _row) * ldkA + _ch * 8); kreg[_i] = *(const u32x4*)_s; } \
        _Pragma("unroll") for (int _i = 0; _i < 2; ++_i) { const int _c = tid + 512 * _i, _d = _c >> 3, _ch = _c & 7; vreg[_i] = *(const u32x4*)(vT + (size_t)_d * T + 64 * (j) + _ch * 8); } } while (0)
#define ATT_WRITE(buf) do { _Pragma("unroll") for (int _i = 0; _i < NKL; ++_i) { const int _c = tid + 512 * _i, _row = _c / KC, _ch = _c % KC; *(LAS u32x4*)((buf) + _row * KROW + _ch * 16) = kreg[_i]; } \
        _Pragma("unroll") for (int _i = 0; _i < 2; ++_i) { const int _c = tid + 512 * _i, _d = _c >> 3, _ch = _c & 7; LAS u32x2* _p = (LAS u32x2*)((buf) + KBUF + _d * VROW + _ch * 16); \
            _p[0] = (u32x2){vreg[_i].x, vreg[_i].y}; _p[1] = (u32x2){vreg[_i].z, vreg[_i].w}; } } while (0)
    ATT_LOAD(0); ATT_WRITE(lds);
    __syncthreads();
    for (int j = 0; j < nj; ++j) {
        LAS unsigned char* cur = lds + (j & 1) * BUF;
        if (j + 1 < nj) ATT_LOAD(j + 1);
        if (j <= jd) {
            bool farb = false; float c0 = -mrun;
            if (BIAS) { farb = __all(pq - tmaxb[j] >= 128); if (farb) c0 += lut[128]; }
            f32x16 s0, s1;
#pragma unroll
            for (int r = 0; r < 16; ++r) { s0[r] = c0; s1[r] = c0; }
            const LAS unsigned char* kp = cur + r31 * KROW + koffB + hh * 16;
            {
                bf16x8 kf[3][2];
#define ATT_LDK(b, g) do { kf[b][0] = *(const LAS bf16x8*)(kp + (g) * 32); kf[b][1] = *(const LAS bf16x8*)(kp + 32 * KROW + (g) * 32); } while (0)
                ATT_LDK(0, 0); ATT_LDK(1, 1);
#pragma unroll
                for (int g = 0; g < NKS; ++g) {
                    if (g + 2 < NKS) ATT_LDK((g + 2) % 3, g + 2);
                    __builtin_amdgcn_sched_barrier(0);
                    s0 = MFMA32(kf[g % 3][0], qf[g], s0); s1 = MFMA32(kf[g % 3][1], qf[g], s1);
                    __builtin_amdgcn_sched_barrier(0);
                }
#undef ATT_LDK
            }
            if (BIAS && !farb) {
#pragma unroll
                for (int r = 0; r < 16; ++r) { const int kj = 64 * j + (r & 3) + 8 * (r >> 2) + 4 * hh;
                    int r0 = pq - posb[kj], r1 = pq - posb[kj + 32]; r0 = r0 < 0 ? 0 : (r0 > 128 ? 128 : r0); r1 = r1 < 0 ? 0 : (r1 > 128 ? 128 : r1);
                    s0[r] += lut[r0]; s1[r] += lut[r1]; }
            }
            if (j == jd) {
#pragma unroll
                for (int r = 0; r < 16; ++r) { const int kj = 64 * j + (r & 3) + 8 * (r >> 2) + 4 * hh;
                    if (kj > qi) s0[r] = -__builtin_inff(); if (kj + 32 > qi) s1[r] = -__builtin_inff(); }
            }
            float mx = fmaxf(fmaxf(s0[0], s0[1]), s0[2]);
#pragma unroll
            for (int r = 3; r < 15; r += 2) mx = fmaxf(fmaxf(mx, s0[r]), s0[r + 1]);
            mx = fmaxf(mx, s0[15]);
#pragma unroll
            for (int r = 0; r < 16; r += 2) mx = fmaxf(fmaxf(mx, s1[r]), s1[r + 1]);
            mx = max32(mx);
            if (j == 0 || !__all(mx <= 8.0f)) {
                if (j != 0) mx = fmaxf(mx, 0.f);
                const float alpha = __builtin_amdgcn_exp2f(-mx);
                mrun += mx; lsum *= alpha;
#pragma unroll
                for (int dt = 0; dt < 4; ++dt)
#pragma unroll
                    for (int r = 0; r < 16; ++r) o[dt][r] *= alpha;
#pragma unroll
                for (int r = 0; r < 16; ++r) { s0[r] -= mx; s1[r] -= mx; }
            }
            float ps0 = 0.f, ps1 = 0.f;
#pragma unroll
            for (int r = 0; r < 16; ++r) { s0[r] = __builtin_amdgcn_exp2f(s0[r]); s1[r] = __builtin_amdgcn_exp2f(s1[r]); ps0 += s0[r]; ps1 += s1[r]; }
            lsum += ps0 + ps1;
            bf16x8 pb[2][2];
            { u32x4 w;
              w.x = pk2(s0[0], s0[1]); w.y = pk2(s0[2], s0[3]); w.z = pk2(s0[4], s0[5]); w.w = pk2(s0[6], s0[7]); pb[0][0] = __builtin_bit_cast(bf16x8, w);
              w.x = pk2(s0[8], s0[9]); w.y = pk2(s0[10], s0[11]); w.z = pk2(s0[12], s0[13]); w.w = pk2(s0[14], s0[15]); pb[0][1] = __builtin_bit_cast(bf16x8, w);
              w.x = pk2(s1[0], s1[1]); w.y = pk2(s1[2], s1[3]); w.z = pk2(s1[4], s1[5]); w.w = pk2(s1[6], s1[7]); pb[1][0] = __builtin_bit_cast(bf16x8, w);
              w.x = pk2(s1[8], s1[9]); w.y = pk2(s1[10], s1[11]); w.z = pk2(s1[12], s1[13]); w.w = pk2(s1[14], s1[15]); pb[1][1] = __builtin_bit_cast(bf16x8, w); }
            const LAS unsigned char* vp = cur + KBUF + r31 * VROW + hh * 8;
            {
                u32x4 vf[3][2];
#define ATT_LDV(b, g) do { _Pragma("unroll") for (int _q = 0; _q < 2; ++_q) { const LAS unsigned char* _a = vp + ((g) >> 1) * 32 * VROW + (2 * ((g) & 1) + _q) * 32; \
                           const u32x2 _lo = *(const LAS u32x2*)_a, _hi = *(const LAS u32x2*)(_a + 16); vf[b][_q] = (u32x4){_lo.x, _lo.y, _hi.x, _hi.y}; } } while (0)
                ATT_LDV(0, 0); ATT_LDV(1, 1);
#pragma unroll
                for (int g = 0; g < 8; ++g) {
                    if (g + 2 < 8) ATT_LDV((g + 2) % 3, g + 2);
                    __builtin_amdgcn_sched_barrier(0);
#pragma unroll
                    for (int q = 0; q < 2; ++q) o[g >> 1] = MFMA32(__builtin_bit_cast(bf16x8, vf[g % 3][q]), pb[g & 1][q], o[g >> 1]);
                    __builtin_amdgcn_sched_barrier(0);
                }
#undef ATT_LDV
            }
        }
        if (j + 1 < nj) ATT_WRITE(lds + ((j + 1) & 1) * BUF);
        __syncthreads();
    }
#undef ATT_LOAD
#undef ATT_WRITE
    const float lt = sum32(lsum), il = 1.0f / lt;
#pragma unroll
    for (int dt = 0; dt < 4; ++dt)
#pragma unroll
        for (int r = 0; r < 16; ++r) o[dt][r] *= il;
}

__device__ __forceinline__ void attn_phase(Frame& F, int l) {
    frame_refresh(F);
    unsigned char* ws = F.ws; LAS unsigned char* lds = F.lds;
    const bf16_t *qm = (const bf16_t*)(ws + WS_QM), *kn = (const bf16_t*)(ws + WS_KN), *kr = (const bf16_t*)(ws + WS_KR), *vmT = (const bf16_t*)(ws + WS_VMT);
    const bf16_t *dq = (const bf16_t*)(ws + WS_DQ), *dk = (const bf16_t*)(ws + WS_DK), *dvT = (const bf16_t*)(ws + WS_DVT);
    bf16_t* mix = (bf16_t*)(ws + WS_MIX);
    const int* pos = (const int*)inptr(F, IN_POS); const int* tmax = (const int*)(ws + WS_TMAX);
    LAS float* lut = (LAS float*)(lds + LUT_OFF);
    for (int i = F.tid; i < 6 * 132; i += NTHR) lut[i] = ((const float*)(ws + WS_LUT))[i];
    LAS int* tmaxl = (LAS int*)(lds + TMAX_OFF); LAS int* posl = (LAS int*)(lds + POS_OFF);
    if (F.tid < NB * 32) tmaxl[F.tid] = tmax[F.tid];
    for (int i = F.tid; i < T; i += NTHR) posl[i] = pos[i];
    float lam, lam_init;
    { const float* lv = inptr(F, IN_LAMBDA) + l * 256;
      const float d1 = wave_sum(lv[F.lane] * lv[64 + F.lane]), d2 = wave_sum(lv[128 + F.lane] * lv[192 + F.lane]);
      lam_init = 0.8f - 0.6f * expf(-0.3f * (float)l);
      lam = __builtin_bit_cast(float, __builtin_amdgcn_readfirstlane(__builtin_bit_cast(int, expf(d1) - expf(d2) + lam_init))); }
    __syncthreads();
    for (int uu = 0; uu < ATT_MAXU * ((256 + F.G - 1) / F.G); ++uu) {
        const int srow = F.bx + (uu / ATT_MAXU) * F.G, ui = uu % ATT_MAXU;
        if (srow >= 256) break;
        const int uid = (int)att_sched[srow][ui];
        if (uid == 0xFFFF) continue;
        frame_refresh(F);
        const int kind = uid >> 10, bh = (uid >> 4) & 63, qb = uid & 15, b = bh / 6, hd = bh % 6;
        const int r31 = F.lane & 31, hh = F.lane >> 5;
        f32x16 o[4];
        if (kind == 0) {
            const int q0 = 256 * qb + 32 * F.wave, t = b * S + q0 + r31;
            attn_core<192, 192, false>(lds, F.tid, F.lane, qm + (size_t)t * 1152 + hd * 192, kn + (size_t)b * S * 768 + hd * 128, 768, kr + (size_t)b * S * 64,
                                       vmT + (size_t)hd * 128 * T + b * S, q0, 4 * qb + 4, 0, nullptr, nullptr, nullptr, o);
            bf16_t* orow = mix + (size_t)t * D + 512 + hd * 128 + 4 * hh;
#pragma unroll
            for (int dt = 0; dt < 4; ++dt)
#pragma unroll
                for (int g = 0; g < 4; ++g) { u32x2 w; w.x = pk2(o[dt][4 * g], o[dt][4 * g + 1]); w.y = pk2(o[dt][4 * g + 2], o[dt][4 * g + 3]); *(u32x2*)(orow + 32 * dt + 8 * g) = w; }
        } else {
            const int map = F.wave >> 2, rg = F.wave & 3, q0 = 128 * qb + 32 * rg, t = b * S + q0 + r31;
            attn_core<64, 128, true>(lds, F.tid, F.lane, dq + (size_t)t * 768 + hd * 128 + 64 * map, dk + (size_t)b * S * 768 + hd * 128, 768, nullptr,
                                     dvT + (size_t)hd * 128 * T + b * S, q0, 2 * qb + 2, 128 * map, posl + b * S, tmaxl + b * 32, lut + hd * 132, o);
            LAS float* xch = (LAS float*)lds + (size_t)rg * 4096 + F.lane;
            if (map == 1) {
#pragma unroll
                for (int dt = 0; dt < 4; ++dt)
#pragma unroll
                    for (int r = 0; r < 16; ++r) xch[(dt * 16 + r) * 64] = o[dt][r] * lam; }
            __syncthreads();
            if (map == 0) {
                float ss = 0.f;
#pragma unroll
                for (int dt = 0; dt < 4; ++dt)
#pragma unroll
                    for (int r = 0; r < 16; ++r) { o[dt][r] -= xch[(dt * 16 + r) * 64]; ss += o[dt][r] * o[dt][r]; }
                ss = sum32(ss);
                const float rr = (1.0f - lam_init) / sqrtf(ss * (1.0f / 128.0f) + EPS);
                const float* sub = inptr(F, IN_SUBLN) + l * 128 + 4 * hh;
                bf16_t* orow = mix + (size_t)t * D + 1280 + hd * 128 + 4 * hh;
                f32x4 sgv[16];
#pragma unroll
                for (int i = 0; i < 16; ++i) sgv[i] = *(const f32x4*)(sub + 32 * (i >> 2) + 8 * (i & 3));
                asm volatile("" ::: "memory");
#pragma unroll
                for (int dt = 0; dt < 4; ++dt)
#pragma unroll
                    for (int g = 0; g < 4; ++g) { const f32x4 sg = sgv[dt * 4 + g]; u32x2 w;
                        w.x = pk2(o[dt][4 * g] * rr * sg[0], o[dt][4 * g + 1] * rr * sg[1]); w.y = pk2(o[dt][4 * g + 2] * rr * sg[2], o[dt][4 * g + 3] * rr * sg[3]); *(u32x2*)(orow + 32 * dt + 8 * g) = w; }
            }
            __syncthreads();
        }
    }
}
}

struct SchedOut {
    int G, c, l; unsigned char* ws;
    __device__ __forceinline__ bool next(int i, pg8::Unit& U) const {
        const int L = i * G + c; if (L >= 256) return false;
        const char* mix = (const char*)(ws + WS_MIX); const char* wout = (const char*)(ws + WS_WOUT + (size_t)l * SZ_WOUT);
        int pm, pn; pg8::tile_of(L, 32, 8, pm, pn);
        U.a = mix + (size_t)pm * 256 * D * 2; U.b = wout + (size_t)pn * 256 * D * 2; U.rowmap = nullptr; U.nrows = 256; U.p0 = 0; U.p1 = 256 * pm; U.p2 = 256 * pn; U.p3 = 0; return true;
    }
};
struct EpiOut {
    static constexpr bool PERM = true;
    unsigned char* ws;
    __device__ __forceinline__ void operator()(const f32x4 (&acc)[2][2][4][2], const pg8::Unit& U, int wr, int wc, int fr, int fq) const {
        const int row0 = U.p1 + wr * 64 + fr, col0 = U.p2 + wc * 32 + 8 * fq; const bf16_t* h = (const bf16_t*)(ws + WS_H); bf16_t* h2 = (bf16_t*)(ws + WS_H2);
        u32x4 hv[2][4][2];
#pragma unroll
        for (int ai = 0; ai < 2; ++ai)
#pragma unroll
            for (int m = 0; m < 4; ++m)
#pragma unroll
                for (int bj = 0; bj < 2; ++bj) hv[ai][m][bj] = *(const u32x4*)(h + (size_t)(row0 + ai * 128 + m * 16) * D + col0 + bj * 128);
        asm volatile("" ::: "memory");
#pragma unroll
        for (int ai = 0; ai < 2; ++ai)
#pragma unroll
            for (int m = 0; m < 4; ++m) { const size_t ro = (size_t)(row0 + ai * 128 + m * 16) * D + col0;
#pragma unroll
                for (int bj = 0; bj < 2; ++bj) { const u32x4 hw = hv[ai][m][bj];
                    const f32x4 v0 = unpk4((u32x2){hw.x, hw.y}) + acc[ai][bj][m][0], v1 = unpk4((u32x2){hw.z, hw.w}) + acc[ai][bj][m][1];
                    u32x4 w; w.x = pk2(v0[0], v0[1]); w.y = pk2(v0[2], v0[3]); w.z = pk2(v1[0], v1[1]); w.w = pk2(v1[2], v1[3]); *(u32x4*)(h2 + ro + bj * 128) = w; }
                asm volatile("" ::: "memory"); }
    }
};

__device__ __forceinline__ void router_phase(Frame& F, int l) {
    frame_refresh(F);
    unsigned char* ws = F.ws; LAS unsigned char* lds = F.lds;
    const bf16_t* h = (const bf16_t*)(ws + WS_H2); bf16_t* xn = (bf16_t*)(ws + WS_XB);
    const float* gain = inptr(F, IN_FFN_NORM) + l * D;

    const float* bg = inptr(F, IN_RG_B) + l * 4; const float* be = inptr(F, IN_RE_B) + l * 32;
    unsigned* cnt = F.ctl + CW_CNT + 2048 * l; int* list = (int*)(ws + WS_LIST); float* gwt = (float*)(ws + WS_GW);
    const int lane = F.lane, w = F.wave, r31 = lane & 31, hh = lane >> 5;
    LAS float* part = (LAS float*)lds;
    LAS float* ssqp = (LAS float*)(lds + 65536);
    LAS float* rsv = (LAS float*)(lds + 65536 + 2048);
    LAS float* lg = (LAS float*)(lds + 65536 + 4096);
    for (int tile = F.bx; tile < T / 32; tile += F.G) {
        const int t0 = tile * 32;
        { const bf16_t* xrow = h + (size_t)(t0 + r31) * D + 256 * w + 8 * hh;
          const unsigned char* wb = ws + WS_WRH + ((size_t)l * 8 + w) * 65536; const unsigned lo16 = (unsigned)lane * 16u;
          f32x16 a0, a1; float ssq = 0.f;
#pragma unroll
          for (int r = 0; r < 16; ++r) { a0[r] = 0.f; a1[r] = 0.f; }
#pragma unroll
          for (int kc = 0; kc < 16; kc += 4) {
              bf16x8 wh0[4], wh1[4], wl0[4], wl1[4]; u32x4 xw[16];
#pragma unroll
              for (int q = 0; q < 4; ++q) xw[kc + q] = *(const u32x4*)(xrow + 16 * (kc + q));
#pragma unroll
              for (int q = 0; q < 4; ++q) { GAS const unsigned char* wq_ = (GAS const unsigned char*)wb + (kc + q) * 4096; asm volatile("" : "+s"(wq_)); const unsigned char* wq = (const unsigned char*)wq_;
                  wh0[q] = *(const bf16x8*)(wq + lo16); wh1[q] = *(const bf16x8*)(wq + 1024 + lo16); wl0[q] = *(const bf16x8*)(wq + 2048 + lo16); wl1[q] = *(const bf16x8*)(wq + 3072 + lo16); }
              asm volatile("" ::: "memory");
#pragma unroll
              for (int q = 0; q < 4; ++q) { const u32x4 xv = xw[kc + q];
                  const f32x4 xa = unpk4((u32x2){xv.x, xv.y}), xb = unpk4((u32x2){xv.z, xv.w});
                  ssq += (xa[0] * xa[0] + xa[1] * xa[1]) + (xa[2] * xa[2] + xa[3] * xa[3]) + (xb[0] * xb[0] + xb[1] * xb[1]) + (xb[2] * xb[2] + xb[3] * xb[3]);
                  const bf16x8 xh = __builtin_bit_cast(bf16x8, xv);
                  a0 = MFMA32(xh, wh0[q], a0); a0 = MFMA32(xh, wl0[q], a0);
                  a1 = MFMA32(xh, wh1[q], a1); a1 = MFMA32(xh, wl1[q], a1); } }
          __syncthreads();
#pragma unroll
          for (int r = 0; r < 16; ++r) { const int tk = (r & 3) + 8 * (r >> 2) + 4 * hh; part[(w * 32 + tk) * 64 + r31] = a0[r]; part[(w * 32 + tk) * 64 + 32 + r31] = a1[r]; }
          ssqp[(w * 2 + hh) * 32 + r31] = ssq; }
        __syncthreads();
        if (F.tid < 32) { float s = 0.f;
#pragma unroll
            for (int q = 0; q < 16; ++q) s += ssqp[q * 32 + F.tid];
            rsv[F.tid] = 1.0f / sqrtf(s * (1.0f / D) + EPS); }
        __syncthreads();
        for (int idx = F.tid; idx < 32 * 36; idx += NTHR) { const int tk = idx / 36, c = idx - tk * 36; float s = 0.f;
#pragma unroll
            for (int q = 0; q < 8; ++q) s += part[(q * 32 + tk) * 64 + c];
            lg[tk * 40 + c] = s * rsv[tk] + (c < 4 ? bg[c] : be[c - 4]); }
        { f32x4 gg[8]; u32x2 xv[4][8];
#pragma unroll
          for (int j = 0; j < 8; ++j) gg[j] = ((const f32x4*)gain)[lane + 64 * j];
#pragma unroll
          for (int q = 0; q < 4; ++q) { const u32x2* xr = (const u32x2*)(h + (size_t)(t0 + 4 * w + q) * D) + lane;
#pragma unroll
              for (int j = 0; j < 8; ++j) xv[q][j] = xr[64 * j]; }
          asm volatile("" ::: "memory");
#pragma unroll
          for (int q = 0; q < 4; ++q) { const int t = t0 + 4 * w + q; const float rs = rsv[4 * w + q]; u32x2* o = (u32x2*)(xn + (size_t)t * D) + lane;
#pragma unroll
              for (int j = 0; j < 8; ++j) { const f32x4 v = unpk4(xv[q][j]) * rs * gg[j]; u32x2 wv; wv.x = pk2(v[0], v[1]); wv.y = pk2(v[2], v[3]); o[64 * j] = wv; } } }
        __syncthreads();
        if (F.tid < 32) { const int t = t0 + F.tid; const LAS float* L = lg + F.tid * 40;
            int gi = 0; float gm = L[0];
            for (int c = 1; c < 4; ++c) { const float v = L[c]; if (v > gm) { gm = v; gi = c; } }
            float gs = 0.f; for (int c = 0; c < 4; ++c) gs += expf(L[c] - gm);
            const float ggate = 1.0f / gs; const LAS float* E8 = L + 4 + 8 * gi;
            int i0 = 0; float m0 = E8[0];
            for (int q = 1; q < 8; ++q) { const float v = E8[q]; if (v > m0) { m0 = v; i0 = q; } }
            int i1 = -1; float m1 = -__builtin_inff();
            for (int q = 0; q < 8; ++q) { const float v = E8[q]; if (q != i0 && v > m1) { m1 = v; i1 = q; } }
            const float p0 = 1.0f / (1.0f + expf(m1 - m0)), p1 = 1.0f - p0;
            const int e0 = gi * 8 + i0, e1 = gi * 8 + i1;
            LAS unsigned* lcnt = (LAS unsigned*)(lds + 65536 + 4096 + 5120); LAS unsigned* lbase = lcnt + 32;
            lcnt[F.tid] = 0u; LDS_WAIT();
            const unsigned r0 = __hip_atomic_fetch_add(lcnt + e0, 1u, __ATOMIC_RELAXED, __HIP_MEMORY_SCOPE_WORKGROUP);
            const unsigned r1 = __hip_atomic_fetch_add(lcnt + e1, 1u, __ATOMIC_RELAXED, __HIP_MEMORY_SCOPE_WORKGROUP);
            LDS_WAIT();
            { const unsigned n = lcnt[F.tid]; unsigned bs = 0u; if (n) bs = atomicAdd(cnt + 64 * F.tid, n); lbase[F.tid] = bs; }
            LDS_WAIT();
            const unsigned slot0 = lbase[e0] + r0, slot1 = lbase[e1] + r1;
            list[e0 * LISTCAP + slot0] = t * 2; list[e1 * LISTCAP + slot1] = t * 2 + 1;
            *(f32x2*)(gwt + t * 2) = (f32x2){ggate * p0, ggate * p1}; }
    }
    __syncthreads();
}

__device__ __forceinline__ void moe_tables(Frame& F, int l) {
    frame_refresh(F);
    __syncthreads();
    if (F.tid < NE) F.MISC[112 + F.tid] = (F.ctl + CW_CNT + 2048 * l)[64 * F.tid];
    __syncthreads();
    if (F.tid < NE) { const LAS unsigned* C = (const LAS unsigned*)F.MISC + 112; const int e = F.tid;
        const int c = (int)C[e], nfull = c >> 8, part = c & 255;
        int fpre = 0, spre = 0, ftot = 0, ptot = 0, rank = 0;
#pragma unroll 8
        for (int q = 0; q < NE; ++q) { const int cq = (int)C[q], fq = cq >> 8, pq = cq & 255;
            ftot += fq; ptot += (pq != 0); if (q < e) { fpre += fq; spre += cq; }
            rank += (pq > part || (pq == part && q < e)) ? 1 : 0; }
        for (int mt = 0; mt < nfull; ++mt) F.MISC[256 + fpre + mt] = (unsigned)(e | (mt << 8));
        if (part != 0) F.MISC[256 + ftot + rank] = (unsigned)(e | (nfull << 8));
        F.MISC[64 + e] = (unsigned)spre;
        if (e == 0) F.MISC[16 + NE] = (unsigned)(ftot + ptot); }
    __syncthreads();
}
__device__ __forceinline__ int moe_rank4(int c, int G) { if (G % 32 != 0 || c < 0) return c; const int x = c & 7, r = c >> 3; return (((G >> 5) * x + (r >> 2)) << 2) | (r & 3); }
__device__ __forceinline__ int moe_rank8(int c, int G) { if (G % 64 != 0 || c < 0) return c; const int x = c & 7, r = c >> 3; return (((G >> 6) * x + (r >> 3)) << 3) | (r & 7); }
struct SchedMoE {
    int G, c, l; bool down; volatile LAS unsigned* M; unsigned char* ws; int Lb, Le;
    __device__ __forceinline__ bool next(int i, pg8::Unit& U) const {
        const int L = Lb + i * G + c;
        if (c < 0 || L >= Le) return false;
        return make(L, U);
    }
    __device__ __forceinline__ bool make(int L, pg8::Unit& U) const {
        const int ntn = down ? 8 : 4; const char* abase = (const char*)(ws + (down ? WS_ACT : WS_XB));
        const char* wbase = (const char*)(ws + (down ? WS_WD + (size_t)l * NE * SZ_WD1 : WS_WGU + (size_t)l * NE * SZ_WGU1));
        const size_t wstride = down ? SZ_WD1 : SZ_WGU1, tstride = down ? (size_t)256 * EH * 2 : (size_t)256 * D * 2; const int* list = (const int*)(ws + WS_LIST);
        const int TR = (int)M[16 + NE]; const int rt = L / ntn, nt = L - rt * ntn;
        if (rt >= TR) return false;
        const int ent = __builtin_amdgcn_readfirstlane((int)M[256 + rt]), e = ent & 255, mt = ent >> 8;
        const int cnt = (int)M[112 + e], slot0 = (int)M[64 + e] + 256 * mt; int nv = cnt - 256 * mt; nv = nv > 256 ? 256 : nv;
        U.nrows = __builtin_amdgcn_readfirstlane(nv); U.p0 = rt; U.p1 = U.nrows; U.p3 = nt;
        U.b = wbase + (size_t)e * wstride + (size_t)nt * tstride;
        if (down) { U.a = abase + (size_t)__builtin_amdgcn_readfirstlane(slot0) * EH * 2; U.rowmap = nullptr; U.p2 = e * LISTCAP + 256 * mt; }
        else { U.a = abase; U.rowmap = list + e * LISTCAP + 256 * mt; U.p2 = __builtin_amdgcn_readfirstlane(slot0); }
        return true;
    }
};
struct EpiGU {
    static constexpr bool PERM = true;
    unsigned char* ws; int l;
    __device__ __forceinline__ void operator()(const f32x4 (&acc)[2][2][4][2], const pg8::Unit& U, int wr, int wc, int fr, int fq) const {
        const int nv = U.p1, slot0 = U.p2, nt = U.p3; bf16_t* act = (bf16_t*)(ws + WS_ACT);
#pragma unroll
        for (int ai = 0; ai < 2; ++ai)
#pragma unroll
            for (int m = 0; m < 4; ++m) { const int r = ai * 128 + wr * 64 + m * 16 + fr;
                if (r < nv) { float o[8];
#pragma unroll
                    for (int n = 0; n < 2; ++n)
#pragma unroll
                        for (int e = 0; e < 4; ++e) { const float gt = acc[ai][0][m][n][e], up = acc[ai][1][m][n][e]; o[4 * n + e] = gt * up / (1.0f + __builtin_amdgcn_exp2f(-gt * LOG2E)); }
                    const unsigned long long w0 = (unsigned long long)pk2(o[0], o[1]) | ((unsigned long long)pk2(o[2], o[3]) << 32), w1 = (unsigned long long)pk2(o[4], o[5]) | ((unsigned long long)pk2(o[6], o[7]) << 32);
                    GAS unsigned long long* dp = (GAS unsigned long long*)(act + (size_t)(slot0 + r) * EH + nt * 128 + wc * 32 + 8 * fq);
                    __hip_atomic_store(dp, w0, __ATOMIC_RELAXED, __HIP_MEMORY_SCOPE_AGENT); __hip_atomic_store(dp + 1, w1, __ATOMIC_RELAXED, __HIP_MEMORY_SCOPE_AGENT); } }
        asm volatile("s_waitcnt vmcnt(0)" ::: "memory");
        if ((fr | fq) == 0) { GAS unsigned* rdy = (GAS unsigned*)(ws + WS_CTL) + CW_RDY + 8192 * l + 64 * U.p0; __hip_atomic_fetch_add(rdy, 1u, __ATOMIC_RELAXED, __HIP_MEMORY_SCOPE_AGENT); }
    }
};
struct SchedDown2 {
    SchedMoE B; int ind, rem, nd;
    __device__ __forceinline__ bool next(int i, pg8::Unit& U) const {
        const int G = B.G, c = B.c, N1 = G - rem; int Lu;
        if (c >= rem) { const int j = c - rem, nind = (j < ind) ? (ind - j + N1 - 1) / N1 : 0;
            if (i < nind) Lu = j + i * N1;
            else { const int d = (rem + (N1 - 1 - j)) + (i - nind) * G; if (d >= nd - ind) return false; Lu = ind + d; } }
        else { const int d = c + i * G; if (d >= nd - ind) return false; Lu = ind + d; }
        return B.make(Lu, U);
    }
    __device__ __forceinline__ void a_ready(const pg8::Unit& U) const {
        if (__builtin_amdgcn_readfirstlane((int)(threadIdx.x >> 6)) == 0) {
            GAS unsigned* ctl = (GAS unsigned*)(B.ws + WS_CTL); GAS unsigned* rdy = ctl + CW_RDY + 8192 * B.l + 64 * U.p0; unsigned sp = 0u;
            while ((unsigned)__builtin_amdgcn_readfirstlane((int)__hip_atomic_load(rdy, __ATOMIC_RELAXED, __HIP_MEMORY_SCOPE_AGENT)) < 32u) {
                __builtin_amdgcn_s_sleep(2);
                if ((++sp & 255u) == 0u) { if (__hip_atomic_load(ctl + CW_TMO, __ATOMIC_RELAXED, __HIP_MEMORY_SCOPE_AGENT) != 0u) break;
                    if (sp > (1u << 18)) { __hip_atomic_store(ctl + CW_TMO, 1u, __ATOMIC_RELAXED, __HIP_MEMORY_SCOPE_AGENT); break; } } }
            __builtin_amdgcn_fence(__ATOMIC_ACQUIRE, "agent");
            asm volatile("s_waitcnt vmcnt(0)" ::: "memory");
        }
        asm volatile("" ::: "memory"); __builtin_amdgcn_s_barrier(); asm volatile("" ::: "memory");
    }
};
struct EpiDown {
    static constexpr bool PERM = true;
    unsigned char* ws;
    __device__ __forceinline__ void operator()(const f32x4 (&acc)[2][2][4][2], const pg8::Unit& U, int wr, int wc, int fr, int fq) const {
        const int nv = U.p1, lbase = U.p2, col0 = U.p3 * 256 + wc * 32 + 8 * fq;
        bf16_t *y1 = (bf16_t*)(ws + WS_Y1), *y2 = (bf16_t*)(ws + WS_Y2); const int* list = (const int*)(ws + WS_LIST); const float* gwt = (const float*)(ws + WS_GW);
        int ent[8]; float g[8];
#pragma unroll
        for (int i = 0; i < 8; ++i) { const int r = (i >> 2) * 128 + wr * 64 + (i & 3) * 16 + fr; ent[i] = list[lbase + (r < nv ? r : 0)]; }
#pragma unroll
        for (int i = 0; i < 8; ++i) g[i] = gwt[ent[i]];
#pragma unroll
        for (int i = 0; i < 8; ++i) asm volatile("" : "+v"(g[i]), "+v"(ent[i]));
        asm volatile("" ::: "memory");
#pragma unroll
        for (int ai = 0; ai < 2; ++ai)
#pragma unroll
            for (int m = 0; m < 4; ++m) { const int e1 = ent[ai * 4 + m]; const float gg = g[ai * 4 + m];
                if (ai * 128 + wr * 64 + m * 16 + fr < nv) { const int tok = e1 >> 1;
                    bf16_t* rowp = ((e1 & 1) ? y2 : y1) + (size_t)tok * D + col0;
#pragma unroll
                    for (int bj = 0; bj < 2; ++bj) { const f32x4 v0 = acc[ai][bj][m][0] * gg, v1 = acc[ai][bj][m][1] * gg;
                        u32x4 w; w.x = pk2(v0[0], v0[1]); w.y = pk2(v0[2], v0[3]); w.z = pk2(v1[0], v1[1]); w.w = pk2(v1[2], v1[3]); *(u32x4*)(rowp + bj * 128) = w; } }
                asm volatile("" ::: "memory"); }
    }
};

__device__ __forceinline__ void combine_phase(Frame& F, float* outp, int l) {
    frame_refresh(F);
    unsigned char* ws = F.ws; bf16_t* h = (bf16_t*)(ws + WS_H); const bf16_t* h2 = (const bf16_t*)(ws + WS_H2); const bf16_t* y1 = (const bf16_t*)(ws + WS_Y1); const bf16_t* y2 = (const bf16_t*)(ws + WS_Y2); bf16_t* u = (bf16_t*)(ws + WS_XB);
    const bool lastl = (l == NL - 1); const float* gain = lastl ? inptr(F, IN_FINAL_NORM) : inptr(F, IN_ATTN_NORM) + (l + 1) * D;
    const int gw = F.vcu * NWAVES + F.wave, NGW = F.G * NWAVES, lane = F.lane;
    f32x4 gg[8];
#pragma unroll
    for (int j = 0; j < 8; ++j) gg[j] = ((const f32x4*)gain)[lane + 64 * j];
#define CMB_LOAD(A, B, C, mm) do { const u32x2* h2r_ = (const u32x2*)(h2 + (size_t)(mm) * D) + lane; const u32x2* y1r_ = (const u32x2*)(y1 + (size_t)(mm) * D) + lane; const u32x2* y2r_ = (const u32x2*)(y2 + (size_t)(mm) * D) + lane; \
        _Pragma("unroll") for (int j = 0; j < 8; ++j) { A[j] = h2r_[64 * j]; B[j] = y1r_[64 * j]; C[j] = y2r_[64 * j]; } } while (0)
#define CMB_ROW(A, B, C, mm) do { f32x4 v[8]; float s = 0.f; \
        _Pragma("unroll") for (int j = 0; j < 8; ++j) { v[j] = unpk4(A[j]) + (unpk4(B[j]) + unpk4(C[j])); s += (v[j][0] * v[j][0] + v[j][1] * v[j][1]) + (v[j][2] * v[j][2] + v[j][3] * v[j][3]); } \
        const float rs = 1.0f / sqrtf(wave_sum(s) * (1.0f / D) + EPS); \
        if (lastl) { f32x4* o = (f32x4*)(outp + (size_t)(mm) * D) + lane; \
            _Pragma("unroll") for (int j = 0; j < 8; ++j) o[64 * j] = v[j] * rs * gg[j]; } \
        else { u32x2* hr = (u32x2*)(h + (size_t)(mm) * D) + lane; u32x2* o = (u32x2*)(u + (size_t)(mm) * D) + lane; \
            _Pragma("unroll") for (int j = 0; j < 8; ++j) { { u32x2 hw; hw.x = pk2(v[j][0], v[j][1]); hw.y = pk2(v[j][2], v[j][3]); hr[64 * j] = hw; } \
                u32x2 w; w.x = pk2(v[j][0] * rs * gg[j][0], v[j][1] * rs * gg[j][1]); w.y = pk2(v[j][2] * rs * gg[j][2], v[j][3] * rs * gg[j][3]); o[64 * j] = w; } } } while (0)
    for (int m = gw; m < T; m += 2 * NGW) {
        const int m1 = m + NGW; const bool has1 = m1 < T;
        u32x2 A0[8], B0[8], C0[8], A1[8], B1[8], C1[8];
        CMB_LOAD(A0, B0, C0, m); CMB_LOAD(A1, B1, C1, has1 ? m1 : m);
        asm volatile("" ::: "memory");
        CMB_ROW(A0, B0, C0, m);
        if (has1) CMB_ROW(A1, B1, C1, m1);
    }
#undef CMB_LOAD
#undef CMB_ROW
}

__global__ void __launch_bounds__(NTHR, 2) hymba_fwd(Args args) {
    extern __shared__ __attribute__((aligned(16))) unsigned char lds_raw[];
    Frame F;
    F.lds = (LAS unsigned char*)lds_raw; F.MISC = (volatile LAS unsigned*)(F.lds + LDS_MISC);
    F.tid = threadIdx.x; F.lane = F.tid & 63; F.wave = __builtin_amdgcn_readfirstlane(F.tid >> 6);
    F.G = gridDim.x; F.bx = blockIdx.x; F.vcu = (F.G % 8 == 0) ? (F.bx % 8) * (F.G / 8) + F.bx / 8 : F.bx;
    F.ws = args.ws; F.ws0 = args.ws; F.ctl = (unsigned*)(args.ws + WS_CTL);
    unsigned char* ws = args.ws;
    for (int i = F.tid; i < 192; i += NTHR) F.MISC[i] = 0u;
    if (F.tid < 46) F.MISC[MISC_PTAB + F.tid] = ((const __attribute__((address_space(4))) unsigned*)__builtin_amdgcn_kernarg_segment_ptr())[F.tid];
    float* const outp = args.out; const int use_bar = args.use_bar;
    __syncthreads();
    XcdBarrier bar; bar.bar = F.ctl + CW_BAR; bar.x = 0; bar.st = F.MISC;
    if (use_bar) bar = xcd_barrier_post(F.ctl + CW_BAR, F.MISC);
    const int lo = args.g_lo, hi = args.g_hi;
#define IN(k) (lo <= (k) && (k) < hi)
#define GRIDBAR() do { if (use_bar) { XcdBarrier bb_ = bar; GAS unsigned* bp_ = (GAS unsigned*)bar.bar; asm volatile("" : "+s"(bp_), "+s"(bb_.x)); bb_.bar = (unsigned*)bp_; xcd_barrier(bb_); } } while (0)
#define SEAM(k) do { if (IN((k) + 1)) GRIDBAR(); } while (0)
#define PHASE_LOCALS() frame_refresh(F); int bxo = F.bx, Go = F.G; GAS unsigned char* wsg_ = (GAS unsigned char*)ws; asm volatile("" : "+s"(bxo), "+s"(Go), "+s"(wsg_)); unsigned char* wso = (unsigned char*)wsg_

    if (IN(0)) { for (int rep_ = 0; rep_ < DUPN(0); ++rep_) { if (rep_) GRIDBAR(); p0_prologue(F); } SEAM(0); }

    for (int l = 0; l < NL; ++l) {
        const int g0 = 1 + 9 * l;
        if (lo >= g0 + 9 || hi <= g0) continue;
        if (IN(g0)) for (int rep_ = 0; rep_ < DUPN(1); ++rep_) {
            if (rep_) GRIDBAR();
            PHASE_LOCALS();
            const pg8::Gemm g{D, D, D};
            const SchedP1 Sc{Go, bxo, l, wso};
            const EpiP1 E{wso};
            pg8::gemm_phase<EpiP1, SchedP1, false>(F.lds, g, Sc, E);
            if (rep_ == DUPN(1) - 1) SEAM(g0);
        }
        if (IN(g0 + 1)) for (int rep_ = 0; rep_ < DUPN(2); ++rep_) {
            if (rep_) GRIDBAR();
            { PHASE_LOCALS(); const pg8::Gemm g{512, 512, 512};
              const SchedQ Sc{Go, bxo, l, wso};
              const EpiQ E{wso};
              pg8::gemm_phase<EpiQ, SchedQ, false>(F.lds, g, Sc, E); }
            { PHASE_LOCALS(); const pg8::Gemm g{256, 256, 256};
              const SchedKV Sc{Go == 256 ? 96 : Go, Go == 256 ? bxo - 160 : bxo, l, wso};
              const EpiKV E{wso};
              pg8::gemm_phase<EpiKV, SchedKV, false>(F.lds, g, Sc, E); }
            pool_stencil(F);
            if (rep_ == DUPN(2) - 1) SEAM(g0 + 1);
        }
        if (IN(g0 + 2)) { for (int rep_ = 0; rep_ < DUPN(3); ++rep_) { if (rep_) GRIDBAR(); att::attn_phase(F, l); } SEAM(g0 + 2); }
        if (IN(g0 + 3)) for (int rep_ = 0; rep_ < DUPN(4); ++rep_) {
            if (rep_) GRIDBAR();
            PHASE_LOCALS();
            const pg8::Gemm g{D, D, D};
            const SchedOut Sc{Go, bxo, l, wso};
            const EpiOut E{wso};
            pg8::gemm_phase<EpiOut, SchedOut, false>(F.lds, g, Sc, E);
            if (rep_ == DUPN(4) - 1) SEAM(g0 + 3);
        }
        if (IN(g0 + 4)) { for (int rep_ = 0; rep_ < DUPN(5); ++rep_) {
                if (rep_) { GRIDBAR(); if (F.bx == 0 && F.tid < NE) F.ctl[CW_CNT + 2048 * l + 64 * F.tid] = 0u; GRIDBAR(); }
                router_phase(F, l); }
            SEAM(g0 + 4); }
        if (IN(g0 + 5)) {
            moe_tables(F, l);
            { PHASE_LOCALS();
              const int U6 = (int)F.MISC[16 + NE] * 4;
              const pg8::Gemm g{D, D, D};
              const SchedMoE Sc{Go, moe_rank4(bxo, Go), l, false, F.MISC, wso, 0, U6};
              const EpiGU E{wso, l};
              pg8::gemm_phase<EpiGU, SchedMoE, true>(F.lds, g, Sc, E); }
            { PHASE_LOCALS();
              const int TR = (int)F.MISC[16 + NE], U6 = TR * 4, ND = TR * 8;
              const bool fast = (U6 >= Go && U6 - Go <= Go / 2 && Go % 4 == 0);
              const pg8::Gemm g{EH, EH, EH};
              const SchedDown2 Sc{SchedMoE{Go, moe_rank4(bxo, Go), l, true, F.MISC, wso, 0, 0x7fffffff}, fast ? 2 * Go : 0, fast ? U6 - Go : Go, ND};
              const EpiDown E{wso};
              pg8::gemm_phase<EpiDown, SchedDown2, false, true>(F.lds, g, Sc, E); }
            SEAM(g0 + 5);
        }
        if (IN(g0 + 8)) { for (int rep_ = 0; rep_ < DUPN(8); ++rep_) { if (rep_) GRIDBAR(); combine_phase(F, outp, l); } SEAM(g0 + 8); }
    }
}


#ifndef DBG_CHECK
#define DBG_CHECK 0
#endif
#if DBG_CHECK
constexpr int CW_CHK = 20000;
__device__ inline double dbf(const bf16_t* p, size_t i) { return (double)bf2f(p[i]); }
__device__ inline unsigned hsh(unsigned x) { x ^= x >> 16; x *= 0x7feb352du; x ^= x >> 15; x *= 0x846ca68bu; x ^= x >> 16; return x; }
__device__ inline bool bad(double got, double ref, double scale) { const double e = fabs(got - ref); return !(e <= 0.03 * fabs(ref) + 0.03 * scale); }
__global__ void dbg_check(Args A, int which) {
    unsigned char* ws = A.ws; unsigned* chk = (unsigned*)(ws + WS_CTL) + CW_CHK;
    const int sid = blockIdx.x * blockDim.x + threadIdx.x; const unsigned r0 = hsh(sid * 2654435761u + which * 97u + 12345u), r1 = hsh(r0 + 1u), r2 = hsh(r1 + 7u);
    const float* x = A.in[IN_X]; const int* pos = (const int*)A.in[IN_POS];
    const bf16_t* u = (const bf16_t*)(ws + WS_XB); const float* win = A.in[IN_W_IN];
    double* dscr = (double*)(ws + WS_END) + (size_t)sid * 512;
    const int t = r0 % T; bool b = false; int code = which;
    if (which == 0) {
        const int k = r1 % D; double ss = 0; for (int i = 0; i < D; ++i) ss += (double)x[(size_t)t * D + i] * x[(size_t)t * D + i];
        const double ref = x[(size_t)t * D + k] / sqrt(ss / D + 1e-6) * A.in[IN_ATTN_NORM][k]; b = bad(dbf(u, (size_t)t * D + k), ref, 1.0);
    } else if (which >= 1 && which <= 7) {
        auto proj = [&](int col) { double s = 0; for (int k = 0; k < D; ++k) s += dbf(u, (size_t)t * D + k) * (double)win[(size_t)k * NIN + col]; return s; };
        if (which == 1) { const int n = r1 % 512, g = n >> 7, d = n & 127; double s = 0;
            for (int c = 0; c < 128; ++c) s += proj(g * 128 + c) * (double)A.in[IN_POOL_W][(size_t)(g * 128 + c) * 128 + d];
            s *= A.in[IN_POOL_SCALE][n]; b = bad(dbf((const bf16_t*)(ws + WS_ZP), (size_t)t * 512 + n), s, 1.0); }
        if (which == 2) { const int n = r1 % 512; b = bad(dbf((const bf16_t*)(ws + WS_CQ), (size_t)t * 512 + n), proj(512 + n), 1.0);
            if ((sid & 7) == 0) { double ss = 0; for (int c = 0; c < 512; ++c) { const double v = dbf((const bf16_t*)(ws + WS_CQ), (size_t)t * 512 + c); ss += v * v; }
                double got = 0; for (int c = 0; c < 8; ++c) got += ((const float*)(ws + WS_CQSS))[(size_t)t * 8 + c]; b = b || bad(got, ss, 1.0); } }
        if (which == 3) { const int n = r1 % 256; b = bad(dbf((const bf16_t*)(ws + WS_CKV), (size_t)t * 256 + n), proj(1024 + n), 1.0);
            if ((sid & 7) == 0) { double ss = 0; for (int c = 0; c < 256; ++c) { const double v = dbf((const bf16_t*)(ws + WS_CKV), (size_t)t * 256 + c); ss += v * v; }
                double got = 0; for (int c = 0; c < 4; ++c) got += ((const float*)(ws + WS_CKVSS))[(size_t)t * 4 + c]; b = b || bad(got, ss, 1.0); } }
        if (which == 4) { const int i = r1 % 32, p = r2 & 1; const double x1 = proj(1280 + i), x2 = proj(1280 + 32 + i), ang = (double)pos[t] * pow(10000.0, -(double)(2 * i) / 64.0);
            const double ref = p ? x1 * sin(ang) + x2 * cos(ang) : x1 * cos(ang) - x2 * sin(ang); b = bad(dbf((const bf16_t*)(ws + WS_KR), (size_t)t * 64 + 2 * i + p), ref, 1.0); }
        if (which == 5) { const int n = r1 % 768; b = bad(dbf((const bf16_t*)(ws + WS_DQ), (size_t)t * 768 + n), proj(1344 + n) * 0.125 * 1.4426950408889634, 0.2); }
        if (which == 6) { const int n = r1 % 768; b = bad(dbf((const bf16_t*)(ws + WS_DK), (size_t)t * 768 + n), proj(2112 + n), 1.0); }
        if (which == 7) { const int n = r1 % 768; b = bad(dbf((const bf16_t*)(ws + WS_DVT), (size_t)n * T + t), proj(2880 + n), 1.0); }
    } else if (which == 8) {
        const bf16_t* cq = (const bf16_t*)(ws + WS_CQ); double ss = 0; for (int c = 0; c < 512; ++c) { const double v = dbf(cq, (size_t)t * 512 + c); ss += v * v; }
        const double rs = 1.0 / sqrt(ss / 512 + 1e-6);
        auto qraw = [&](int col) { double s = 0; for (int k = 0; k < 512; ++k) s += dbf(cq, (size_t)t * 512 + k) * rs * A.in[IN_Q_NORM][k] * (double)A.in[IN_W_UQ][(size_t)k * 1152 + col]; return s; };
        const int hd = r1 % 6, w = r2 % 192; double ref;
        if (w < 128) ref = qraw(hd * 192 + w); else { const int i = (w - 128) >> 1, p = (w - 128) & 1; const double x1 = qraw(hd * 192 + 128 + i), x2 = qraw(hd * 192 + 160 + i), ang = (double)pos[t] * pow(10000.0, -(double)(2 * i) / 64.0);
            ref = p ? x1 * sin(ang) + x2 * cos(ang) : x1 * cos(ang) - x2 * sin(ang); }
        ref *= 0.07216878364870322 * 1.4426950408889634; b = bad(dbf((const bf16_t*)(ws + WS_QM), (size_t)t * 1152 + hd * 192 + w), ref, 0.1);
    } else if (which == 9 || which == 10) {
        const bf16_t* ckv = (const bf16_t*)(ws + WS_CKV); double ss = 0; for (int c = 0; c < 256; ++c) { const double v = dbf(ckv, (size_t)t * 256 + c); ss += v * v; }
        const double rs = 1.0 / sqrt(ss / 256 + 1e-6); const int hd = r1 % 6, d = r2 % 128, col = hd * 256 + (which == 10 ? 128 : 0) + d;
        double s = 0; for (int k = 0; k < 256; ++k) s += dbf(ckv, (size_t)t * 256 + k) * rs * A.in[IN_KV_NORM][k] * (double)A.in[IN_W_UKV][(size_t)k * 1536 + col];
        const double got = which == 9 ? dbf((const bf16_t*)(ws + WS_KN), (size_t)t * 768 + hd * 128 + d) : dbf((const bf16_t*)(ws + WS_VMT), (size_t)(hd * 128 + d) * T + t); b = bad(got, s, 1.0);
    } else if (which == 11) {
        const bf16_t* zp = (const bf16_t*)(ws + WS_ZP); const int n = r1 % 512, g = n >> 7, wn = 2 << g, s = t & (S - 1), cnt = (s + 1) < wn ? (s + 1) : wn;
        double sm = 0; for (int k = 0; k < cnt; ++k) sm += dbf(zp, (size_t)(t - k) * 512 + n); const double ref = sm / cnt - dbf(zp, (size_t)t * 512 + n);
        b = bad(dbf((const bf16_t*)(ws + WS_MIX), (size_t)t * D + n), ref, 0.5);
    } else if (which == 12) {
        const bf16_t *qm = (const bf16_t*)(ws + WS_QM), *kn = (const bf16_t*)(ws + WS_KN), *kr = (const bf16_t*)(ws + WS_KR), *vmT = (const bf16_t*)(ws + WS_VMT);
        const int hd = r1 % 6, d = r2 % 128, bb = t / S, s = t % S; double mx = -1e300, l = 0, o = 0;
        for (int pass = 0; pass < 2; ++pass) for (int j = 0; j <= s; ++j) { const size_t tj = (size_t)bb * S + j; double sc = 0;
            for (int w = 0; w < 128; ++w) sc += dbf(qm, (size_t)t * 1152 + hd * 192 + w) * dbf(kn, tj * 768 + hd * 128 + w);
            for (int w = 0; w < 64; ++w) sc += dbf(qm, (size_t)t * 1152 + hd * 192 + 128 + w) * dbf(kr, tj * 64 + w);
            if (pass == 0) mx = sc > mx ? sc : mx; else { const double p = exp2(sc - mx); l += p; o += p * dbf(vmT, (size_t)(hd * 128 + d) * T + tj); } }
        b = bad(dbf((const bf16_t*)(ws + WS_MIX), (size_t)t * D + 512 + hd * 128 + d), o / l, 0.3);
    } else if (which == 13) {
        const bf16_t *dq = (const bf16_t*)(ws + WS_DQ), *dk = (const bf16_t*)(ws + WS_DK), *dvT = (const bf16_t*)(ws + WS_DVT);
        const int hd = r1 % 6, bb = t / S, s = t % S; const float* lv = A.in[IN_LAMBDA]; double d1 = 0, d2 = 0; for (int i = 0; i < 64; ++i) { d1 += (double)lv[i] * lv[64 + i]; d2 += (double)lv[128 + i] * lv[192 + i]; }
        const double lam_init = 0.8 - 0.6 * exp(0.0), lam = exp(d1) - exp(d2) + lam_init; double (*om)[128] = (double (*)[128])dscr;
        for (int c = 0; c < 2; ++c) { double mx = -1e300, l = 0; for (int d = 0; d < 128; ++d) om[c][d] = 0;
            for (int pass = 0; pass < 2; ++pass) for (int j = 0; j <= s; ++j) { const size_t tj = (size_t)bb * S + j; double sc = 0;
                for (int w = 0; w < 64; ++w) sc += dbf(dq, (size_t)t * 768 + hd * 128 + c * 64 + w) * dbf(dk, tj * 768 + hd * 128 + c * 64 + w);
                int n = pos[t] - pos[tj]; n = n < 0 ? 0 : n; int bkt; if (n < 16) bkt = n; else { bkt = 16 + (int)(log((double)n / 16.0) / log(8.0) * 16.0); bkt = bkt < 31 ? bkt : 31; }
                sc += (double)A.in[IN_REL_BIAS][bkt * 6 + hd] * 1.4426950408889634;
                if (pass == 0) mx = sc > mx ? sc : mx; else { const double p = exp2(sc - mx); l += p; for (int d = 0; d < 128; ++d) om[c][d] += p * dbf(dvT, (size_t)(hd * 128 + d) * T + tj); } }
            for (int d = 0; d < 128; ++d) om[c][d] /= l; }
        double ss = 0; for (int d = 0; d < 128; ++d) { om[0][d] -= lam * om[1][d]; ss += om[0][d] * om[0][d]; }
        const double rr = (1.0 - lam_init) / sqrt(ss / 128 + 1e-6); const int d = r2 % 128;
        b = bad(dbf((const bf16_t*)(ws + WS_MIX), (size_t)t * D + 1280 + hd * 128 + d), om[0][d] * rr * A.in[IN_SUBLN][d], 0.2);
    } else if (which == 14) {
        const int n = r1 % D; double s = x[(size_t)t * D + n]; for (int k = 0; k < D; ++k) s += dbf((const bf16_t*)(ws + WS_MIX), (size_t)t * D + k) * (double)A.in[IN_W_OUT][(size_t)k * D + n];
        b = bad(dbf((const bf16_t*)(ws + WS_H2), (size_t)t * D + n), s, 1.0);
    } else if (which == 15) {
        const bf16_t* hb_ = (const bf16_t*)(ws + WS_H2); auto hf = [&](size_t i) { return (double)bf2f(hb_[i]); }; double ss = 0; for (int i = 0; i < D; ++i) ss += hf((size_t)t * D + i) * hf((size_t)t * D + i);
        const double rs = 1.0 / sqrt(ss / D + 1e-6); const int k = r1 % D; b = bad(dbf(u, (size_t)t * D + k), hf((size_t)t * D + k) * rs * A.in[IN_FFN_NORM][k], 1.0);
        double* lg = dscr; for (int c = 0; c < 36; ++c) lg[c] = c < 4 ? A.in[IN_RG_B][c] : A.in[IN_RE_B][c - 4];
        for (int i = 0; i < D; ++i) { const double xv = hf((size_t)t * D + i) * rs * A.in[IN_FFN_NORM][i]; for (int c = 0; c < 4; ++c) lg[c] += xv * A.in[IN_RG_W][(size_t)i * 4 + c]; for (int c = 0; c < 32; ++c) lg[4 + c] += xv * A.in[IN_RE_W][(size_t)i * 32 + c]; }
        int gi = 0; for (int c = 1; c < 4; ++c) if (lg[c] > lg[gi]) gi = c; double gs = 0; for (int c = 0; c < 4; ++c) gs += exp(lg[c] - lg[gi]);
        int i0 = 0; for (int q = 1; q < 8; ++q) if (lg[4 + gi * 8 + q] > lg[4 + gi * 8 + i0]) i0 = q; int i1 = -1; for (int q = 0; q < 8; ++q) if (q != i0 && (i1 < 0 || lg[4 + gi * 8 + q] > lg[4 + gi * 8 + i1])) i1 = q;
        const double p0 = 1.0 / (1.0 + exp(lg[4 + gi * 8 + i1] - lg[4 + gi * 8 + i0]));
        const unsigned* cnt_ = (const unsigned*)(ws + WS_CTL) + CW_CNT; auto cntf = [&](int e) { return cnt_[64 * e]; }; const int* list = (const int*)(ws + WS_LIST); const float* gwt = (const float*)(ws + WS_GW);
        for (int kk = 0; kk < 2; ++kk) { const int e = gi * 8 + (kk ? i1 : i0); bool found = false; for (unsigned i = 0; i < cntf(e) && i < LISTCAP; ++i) if (list[e * LISTCAP + i] == t * 2 + kk) found = true;
            b = b || !found || bad(gwt[t * 2 + kk], (kk ? 1.0 - p0 : p0) / gs, 0.01); }
    } else if (which == 16) {
        const unsigned* cnt_ = (const unsigned*)(ws + WS_CTL) + CW_CNT; auto cntf = [&](int e) { return cnt_[64 * e]; }; const int* list = (const int*)(ws + WS_LIST);
        const int e = r0 % NE; if (cntf(e) == 0) return; const int i = r1 % cntf(e), j = r2 % EH; int off = 0; for (int q = 0; q < e; ++q) off += cntf(q);
        const int tok = list[e * LISTCAP + i] >> 1; double g = 0, up = 0;
        for (int k = 0; k < D; ++k) { const double xv = dbf(u, (size_t)tok * D + k); g += xv * (double)A.in[IN_EW_GATE][((size_t)e * D + k) * EH + j]; up += xv * (double)A.in[IN_EW_UP][((size_t)e * D + k) * EH + j]; }
        b = bad(dbf((const bf16_t*)(ws + WS_ACT), (size_t)(off + i) * EH + j), g / (1.0 + exp(-g)) * up, 0.3);
    } else if (which == 17) {
        const unsigned* cnt_ = (const unsigned*)(ws + WS_CTL) + CW_CNT; auto cntf = [&](int e) { return cnt_[64 * e]; }; const int* list = (const int*)(ws + WS_LIST); const float* gwt = (const float*)(ws + WS_GW); const bf16_t* act = (const bf16_t*)(ws + WS_ACT);
        const int n = r1 % D; double s = x[(size_t)t * D + n]; for (int k = 0; k < D; ++k) s += dbf((const bf16_t*)(ws + WS_MIX), (size_t)t * D + k) * (double)A.in[IN_W_OUT][(size_t)k * D + n];
        int off = 0; for (int e = 0; e < NE; ++e) { for (unsigned i = 0; i < cntf(e); ++i) { const int ent = list[e * LISTCAP + i]; if ((ent >> 1) == t) { double y = 0;
                    for (int j = 0; j < EH; ++j) y += dbf(act, (size_t)(off + i) * EH + j) * (double)A.in[IN_EW_DOWN][((size_t)e * EH + j) * D + n]; s += y * gwt[ent]; } } off += cntf(e); }
        b = bad(dbf((const bf16_t*)(ws + WS_H), (size_t)t * D + n), s, 1.0);
    }
    if (b) atomicAdd(chk + code, 1u);
}
__global__ void dbg_apply(Args A) {
    const unsigned* chk = (const unsigned*)(A.ws + WS_CTL) + CW_CHK; double f = 0; for (int k = 0; k < 18; ++k) if (chk[k]) f += pow(4.0, 17 - k);
    if (f == 0) return; const float sc = (float)(1.0 + f);
    for (size_t i = (size_t)blockIdx.x * blockDim.x + threadIdx.x; i < (size_t)T * D; i += (size_t)gridDim.x * blockDim.x) A.out[i] *= sc;
}
#endif

extern "C" void kernel_launch(void* const* d_in, const int* in_sizes, int n_in, void* d_out, int out_size, void* d_ws, size_t ws_size, hipStream_t stream) {
    static int grid = 0;
    if (!grid) {
        if (n_in != 23 || out_size != T * D || ws_size < WS_END) { fprintf(stderr, "kernel_launch: unexpected problem (n_in %d, out %d, ws %zu < %zu)\n", n_in, out_size, ws_size, (size_t)WS_END); grid = -1; return; }
        int dev = 0, cus = 0, per_cu = 0;
        hipGetDevice(&dev); hipDeviceGetAttribute(&cus, hipDeviceAttributeMultiprocessorCount, dev);
        if (hipFuncSetAttribute((const void*)hymba_fwd, hipFuncAttributeMaxDynamicSharedMemorySize, LDS_BYTES) != hipSuccess) { fprintf(stderr, "kernel_launch: hipFuncSetAttribute failed\n"); grid = -1; return; }
        hipOccupancyMaxActiveBlocksPerMultiprocessor(&per_cu, (const void*)hymba_fwd, NTHR, LDS_BYTES);
        if (per_cu < 1) { fprintf(stderr, "kernel_launch: occupancy query says %d blocks per CU\n", per_cu); }
        grid = cus > 0 ? cus : 256;
    }
    if (grid < 0) return;
    hipMemsetAsync((char*)d_ws + WS_CTL, 0, CTL_BYTES, stream);
    Args a{};
    for (int i = 0; i < 23; ++i) a.in[i] = (const float*)d_in[i];
    a.out = (float*)d_out; a.ws = (unsigned char*)d_ws; a.pad = 0;
#if MK_LAUNCHES == 1
    a.g_lo = 0; a.g_hi = 1 + 9 * NL; a.use_bar = 1;
    hipLaunchKernelGGL(hymba_fwd, dim3(grid), dim3(NTHR), LDS_BYTES, stream, a);
#else
    for (int k = 0; k < 1 + 9 * NL; ++k) { a.g_lo = k; a.g_hi = k + 1; a.use_bar = 0; hipLaunchKernelGGL(hymba_fwd, dim3(grid), dim3(NTHR), LDS_BYTES, stream, a);
#if DBG_CHECK
        auto chk = [&](int which, int blocks) { hipLaunchKernelGGL(dbg_check, dim3(blocks), dim3(64), 0, stream, a, which); };
        if (k == 0) chk(0, 4);
        if (k == 1) for (int w = 1; w <= 7; ++w) chk(w, w == 1 ? 1 : 4);
        if (k == 2) for (int w = 8; w <= 11; ++w) chk(w, 4);
        if (k == 3) { chk(12, 2); chk(13, 1); }
        if (k == 4) chk(14, 4);
        if (k == 5) chk(15, 4);
        if (k == 7) chk(16, 4);
        if (k == 9) chk(17, 4);
        if (k == 9 * NL) hipLaunchKernelGGL(dbg_apply, dim3(1024), dim3(256), 0, stream, a);
#endif
    }
#endif
}
```

```cpp
#include <hip/hip_runtime.h>
#include <cstdio>
#include <cstdint>

#ifndef MK_LAUNCHES
#define MK_LAUNCHES 1
#endif

#ifndef DUP_MASK
#define DUP_MASK 0
#endif
#define DUPN(p) (((DUP_MASK) >> (p)) & 1 ? 2 : 1)
#define LAS __attribute__((address_space(3)))
#define GAS __attribute__((address_space(1)))
typedef unsigned short bf16_t;
typedef short bf16x8 __attribute__((ext_vector_type(8)));
typedef float f32x4 __attribute__((ext_vector_type(4)));
typedef float f32x2 __attribute__((ext_vector_type(2)));
typedef float f32x16 __attribute__((ext_vector_type(16)));
typedef unsigned u32x4 __attribute__((ext_vector_type(4)));
typedef unsigned u32x2 __attribute__((ext_vector_type(2)));
typedef __bf16 bfv2 __attribute__((ext_vector_type(2)));

constexpr int T = 8192, D = 2048, S = 2048, NB = 4, NL = 4, NIN = 3648;
constexpr int NE = 32, EH = 512, LISTCAP = 8192;
constexpr float EPS = 1e-6f;
constexpr float LOG2E = 1.4426950408889634f;
constexpr int NWAVES = 8, NTHR = 512;

constexpr size_t MiB = 1u << 20;
constexpr size_t al256(size_t x) { return (x + 255) & ~(size_t)255; }
constexpr size_t WS_CTL = 0, CTL_BYTES = 1 * MiB;
constexpr size_t SZ_WIN = (size_t)3072 * 2048 * 2, SZ_WDV = (size_t)768 * 2048 * 2, SZ_WUQ = (size_t)1280 * 512 * 2, SZ_WK = (size_t)768 * 256 * 2,
                 SZ_WOUT = (size_t)2048 * 2048 * 2, SZ_WGU1 = (size_t)1024 * 2048 * 2, SZ_WD1 = (size_t)2048 * 512 * 2;
constexpr size_t WS_WIN = WS_CTL + CTL_BYTES;
constexpr size_t WS_WDV = WS_WIN + NL * SZ_WIN;
constexpr size_t WS_WUQ = WS_WDV + NL * SZ_WDV;
constexpr size_t WS_WK = WS_WUQ + NL * SZ_WUQ;
constexpr size_t WS_WV = WS_WK + NL * SZ_WK;
constexpr size_t WS_WOUT = WS_WV + NL * SZ_WK;
constexpr size_t WS_WGU = WS_WOUT + NL * SZ_WOUT;
constexpr size_t WS_WD = WS_WGU + (size_t)NL * NE * SZ_WGU1;
constexpr size_t WS_COS = WS_WD + (size_t)NL * NE * SZ_WD1;
constexpr size_t WS_SIN = WS_COS + (size_t)T * 32 * 4;
constexpr size_t WS_LUT = WS_SIN + (size_t)T * 32 * 4;
constexpr size_t WS_TMAX = WS_LUT + al256(6 * 132 * 4);
constexpr size_t WS_H = WS_TMAX + al256(NB * 32 * 4);
constexpr size_t WS_XB = WS_H + (size_t)T * D * 4;
constexpr size_t WS_ZP = WS_XB + (size_t)T * D * 2;
constexpr size_t WS_CQ = WS_ZP + (size_t)T * 512 * 2;
constexpr size_t WS_CKV = WS_CQ + (size_t)T * 512 * 2;
constexpr size_t WS_KR = WS_CKV + (size_t)T * 256 * 2;
constexpr size_t WS_DQ = WS_KR + (size_t)T * 64 * 2;
constexpr size_t WS_DK = WS_DQ + (size_t)T * 768 * 2;
constexpr size_t WS_DVT = WS_DK + (size_t)T * 768 * 2;
constexpr size_t WS_QM = WS_DVT + (size_t)T * 768 * 2;
constexpr size_t WS_KN = WS_QM + (size_t)T * 1152 * 2;
constexpr size_t WS_VMT = WS_KN + (size_t)T * 768 * 2;
constexpr size_t WS_MIX = WS_VMT + (size_t)T * 768 * 2;
constexpr size_t WS_CQSS = WS_MIX + (size_t)T * D * 2;
constexpr size_t WS_CKVSS = WS_CQSS + (size_t)T * 8 * 4;
constexpr size_t WS_GW = WS_CKVSS + (size_t)T * 4 * 4;
constexpr size_t WS_LIST = WS_GW + (size_t)T * 2 * 4;
constexpr size_t WS_ACT = WS_LIST + (size_t)NE * LISTCAP * 4;
constexpr size_t WS_Y2 = WS_ACT + (size_t)(2 * T + 256) * EH * 2;
constexpr size_t WS_Y1 = WS_Y2 + (size_t)T * D * 4;
constexpr size_t WS_H2 = WS_Y1 + (size_t)T * D * 4;
constexpr size_t WS_WRH = WS_H2 + (size_t)T * D * 4;
constexpr size_t WS_WRL = WS_WRH + (size_t)NL * 64 * D * 2;
constexpr size_t WS_END = WS_WRL + (size_t)NL * 64 * D * 2;
constexpr int CW_BAR = 4096, CW_TMO = 12288, CW_CNT = 16384, CW_RDY = 32768;

constexpr int LDS_MISC = 135168;
constexpr int LDS_BYTES = 147456;

__device__ __forceinline__ unsigned pk2(float lo, float hi) { f32x2 v = {lo, hi}; return __builtin_bit_cast(unsigned, __builtin_convertvector(v, bfv2)); }
__device__ __forceinline__ f32x4 unpk4(u32x2 a) { return (f32x4){__builtin_bit_cast(float, a.x << 16), __builtin_bit_cast(float, a.x & 0xffff0000u), __builtin_bit_cast(float, a.y << 16), __builtin_bit_cast(float, a.y & 0xffff0000u)}; }
__device__ __forceinline__ float bf2f(unsigned short b) { return __builtin_bit_cast(float, (unsigned)b << 16); }
template <int M> __device__ __forceinline__ float xor_lt32(float v) { return __builtin_bit_cast(float, __builtin_amdgcn_ds_swizzle(__builtin_bit_cast(int, v), (M << 10) | 0x1f)); }
__device__ __forceinline__ float sum32(float v) { const unsigned x = __builtin_bit_cast(unsigned, v); auto r = __builtin_amdgcn_permlane32_swap(x, x, false, false);
    unsigned a = r[0], b = r[1]; asm volatile("" : "+v"(a), "+v"(b));
    return __builtin_bit_cast(float, a) + __builtin_bit_cast(float, b); }
__device__ __forceinline__ float max32(float v) { const unsigned x = __builtin_bit_cast(unsigned, v); auto r = __builtin_amdgcn_permlane32_swap(x, x, false, false);
    unsigned a = r[0], b = r[1]; asm volatile("" : "+v"(a), "+v"(b));
    return fmaxf(__builtin_bit_cast(float, a), __builtin_bit_cast(float, b)); }
__device__ __forceinline__ float wave_sum(float v) {
    v += xor_lt32<1>(v); v += xor_lt32<2>(v); v += xor_lt32<4>(v); v += xor_lt32<8>(v); v += xor_lt32<16>(v);
    return sum32(v);
}
#define LDS_WAIT() asm volatile("s_waitcnt lgkmcnt(0)" ::: "memory")

#define XB_TMO      128
#define XB_XCNT(j)  (256  + 64 * (j))
#define XB_XSUB(j)  (1280 + 64 * (j))
#define XB_XGEN(j)  (2304 + 64 * (j))
#define XB_TOP      3328
#define XB_TOPGEN   3392
#define XCD_BAR_WORDS 3456
#define XB_SPIN_CAP (1u << 18)
__device__ __forceinline__ unsigned xb_ld(unsigned* p)              { return __hip_atomic_load(p, __ATOMIC_RELAXED, __HIP_MEMORY_SCOPE_AGENT); }
__device__ __forceinline__ unsigned xb_add(unsigned* p, unsigned v) { return __hip_atomic_fetch_add(p, v, __ATOMIC_RELAXED, __HIP_MEMORY_SCOPE_AGENT); }
__device__ __forceinline__ unsigned xb_xcc_id() { return (unsigned)__builtin_amdgcn_s_getreg((3 << 11) | 20) & 0xFu; }
#define XB_SPIN(cond, bar) do { unsigned _sp = 0; while (cond) { __builtin_amdgcn_s_sleep(1); \
    if ((++_sp & 255u) == 0u) { if (xb_ld(&(bar)[XB_TMO])) break; if (_sp > XB_SPIN_CAP) { atomicAdd(&(bar)[XB_TMO], 1u); break; } } } } while (0)
struct XcdBarrier { unsigned* bar; unsigned x; volatile LAS unsigned* st; };
__device__ __forceinline__ XcdBarrier xcd_barrier_post(unsigned* bar, volatile LAS unsigned* st) {
    XcdBarrier b; b.bar = bar; b.x = xb_xcc_id(); b.st = st;
    if (threadIdx.x == 0) (void)xb_add(&bar[XB_XCNT(b.x)], 1u);
    return b;
}
__device__ __forceinline__ void xcd_barrier_complete(unsigned* bar, unsigned x, unsigned& nloc, unsigned& nx) {
    const unsigned G = gridDim.x * gridDim.y * gridDim.z;
    unsigned sum, cnt, mine, sp = 0u;
    for (;;) {
        sum = 0u; cnt = 0u; mine = 0u;
#pragma unroll
        for (unsigned j = 0; j < 16; ++j) { const unsigned c = xb_ld(&bar[XB_XCNT(j)]); sum += c; cnt += (c > 0u) ? 1u : 0u; mine = (j == x) ? c : mine; }
        if (sum == G) break;
        __builtin_amdgcn_s_sleep(1);
        if ((++sp & 255u) == 0u) { if (xb_ld(&bar[XB_TMO])) break; if (sp > XB_SPIN_CAP) { atomicAdd(&bar[XB_TMO], 1u); break; } }
    }
    nloc = mine > 0u ? mine : 1u; nx = cnt > 0u ? cnt : 1u;
}
__device__ __forceinline__ void xcd_barrier(const XcdBarrier& b) {
    asm volatile("s_waitcnt vmcnt(0)" ::: "memory");
    __syncthreads();
    if (threadIdx.x == 0) {
        unsigned* bar = b.bar;
        __builtin_amdgcn_s_waitcnt(0);
        unsigned nloc = b.st[0], nx = b.st[1];
        if (nloc == 0u) { xcd_barrier_complete(bar, b.x, nloc, nx); b.st[0] = nloc; b.st[1] = nx; }
        const unsigned old = xb_add(&bar[XB_XSUB(b.x)], 1u);
        const unsigned gen = old / nloc;
        if (old + 1u == (gen + 1u) * nloc) {
            __builtin_amdgcn_fence(__ATOMIC_RELEASE, "agent");
            asm volatile("s_waitcnt vmcnt(0)" ::: "memory");
            const unsigned og = xb_add(&bar[XB_TOP], 1u);
            const unsigned tg = og / nx;
            if (og + 1u == (tg + 1u) * nx) xb_add(&bar[XB_TOPGEN], 1u);
            else XB_SPIN(xb_ld(&bar[XB_TOPGEN]) == tg, bar);
            __builtin_amdgcn_fence(__ATOMIC_ACQUIRE, "agent");
            xb_add(&bar[XB_XGEN(b.x)], 1u);
            asm volatile("s_waitcnt vmcnt(0)" ::: "memory");
        } else {
            XB_SPIN(xb_ld(&bar[XB_XGEN(b.x)]) == gen, bar);
            __builtin_amdgcn_fence(__ATOMIC_ACQUIRE, "agent");
            asm volatile("s_waitcnt vmcnt(0)" ::: "memory");
        }
    }
    __syncthreads();
}

namespace pg8 {
constexpr int BM = 256, BK = 64, HALF = 128, HTB = HALF * BK * 2, STAGE_BYTES = 8 * HTB, NXCD = 8, WGM = 8;
__host__ __device__ __forceinline__ int lds_byte(int r, int c) { const int st = (r >> 4) * 2 + (c >> 5), rr = r & 15, cc = c & 31, ob = rr * 64 + cc * 2; return st * 1024 + (ob ^ (((ob >> 9) & 1) << 5)); }
__host__ __device__ __forceinline__ void stage_rc(int b, int& R, int& C) { const int st = b / 1024, sb = b % 1024, swz = sb ^ (((sb >> 9) & 1) << 5); R = (st >> 1) * 16 + swz / 64; C = (st & 1) * 32 + (swz % 64) / 2; }
__host__ __device__ __forceinline__ int perm32(int rho) { const int n = rho >> 4, i = rho & 15; return 8 * (i >> 2) + 4 * n + (i & 3); }

struct Unit { const char* a; const char* b; const int* rowmap; int nrows; int p0, p1, p2, p3; };
struct Gemm { int K, lda, ldb; };

__device__ __forceinline__ void tile_of(int L, int nM, int nN, int& pm, int& pn) {
    const int nwg = nM * nN; int wgid = L;
    { const int q = nwg / NXCD, r = nwg % NXCD, xcd = wgid % NXCD, off = wgid / NXCD; wgid = (xcd < r ? xcd * (q + 1) : r * (q + 1) + (xcd - r) * q) + off; }
    const int nig = WGM * nN, gid = wgid / nig, fm = gid * WGM, gsz = (nM - fm) < WGM ? (nM - fm) : WGM;
    pm = fm + ((wgid % nig) % gsz); pn = (wgid % nig) / gsz;
}

template <class Epi, class Sched, bool GATHER, bool HOOK = false>
__device__ __forceinline__ void gemm_phase(LAS unsigned char* lds, const Gemm g, const Sched& S, const Epi& E) {
    int tid_ = threadIdx.x; asm volatile("" : "+v"(tid_));
    const int tid = tid_, wid = __builtin_amdgcn_readfirstlane(tid >> 6), lane = tid & 63, wr = wid >> 2, wc = wid & 3, fr = lane & 15, fq = lane >> 4;
    const int K = g.K, nt = K / BK;
    unsigned voffA[2], voffB[2];
#pragma unroll
    for (int i = 0; i < 2; ++i) { int R, C; stage_rc(tid * 16 + i * 8192, R, C); const int Rb = Epi::PERM ? ((R & ~31) + perm32(R & 31)) : R;
        voffA[i] = (unsigned)(R * g.lda + C) * 2u; voffB[i] = (unsigned)(Rb * g.ldb + C) * 2u; }
    const size_t kstep = (size_t)(BK * 2);
    const size_t hstepA = (size_t)HALF * g.lda * 2, hstepB = (size_t)HALF * g.ldb * 2;
    const unsigned ldsw = (unsigned)wid * 1024u;
    const int aoff = lds_byte(wr * 64 + fr, fq * 8), boff = lds_byte(wc * 32 + fr, fq * 8);
    unsigned ga[2][2], gn[2][2];
#define PG8_SA(b, h) (((b) * 2 + (h)) * HTB)
#define PG8_SB(b, h) ((4 + (b) * 2 + (h)) * HTB)
#define PG8_GLDS(src, dst) __builtin_amdgcn_global_load_lds((const unsigned*)(src), (LAS unsigned*)(dst), 16, 0, 0)
#define PG8_STAGE_B(bufoff, gbase) do { _Pragma("unroll") for (int _i = 0; _i < 2; ++_i) PG8_GLDS((const char*)(gbase) + voffB[_i], lds + (bufoff) + ldsw + _i * 8192); } while (0)
#define PG8_STAGE_A(bufoff, gbase, hh, SEL) do { _Pragma("unroll") for (int _i = 0; _i < 2; ++_i) { \
        if constexpr (GATHER) PG8_GLDS((const char*)(gbase) + ((SEL) ? gn[hh][_i] : ga[hh][_i]), lds + (bufoff) + ldsw + _i * 8192); \
        else PG8_GLDS((const char*)(gbase) + (hh) * hstepA + voffA[_i], lds + (bufoff) + ldsw + _i * 8192); } } while (0)
#define PG8_GMAP(u, O) do { if constexpr (GATHER) { _Pragma("unroll") for (int _h = 0; _h < 2; ++_h) _Pragma("unroll") for (int _i = 0; _i < 2; ++_i) { \
        int _R, _C; stage_rc(tid * 16 + _i * 8192, _R, _C); const int _r = _R + 128 * _h; const int _e0 = (u).rowmap[_r < (u).nrows ? _r : 0] >> 1;   const int _e = (_r < (u).nrows) ? _e0 : 0; O[_h][_i] = (unsigned)(_e * g.lda + _C) * 2u; } } } while (0)
#define PG8_LDA(dst, b, h) do { _Pragma("unroll") for (int m = 0; m < 4; ++m) _Pragma("unroll") for (int k = 0; k < 2; ++k) dst[m][k] = *(const LAS bf16x8*)(lds + PG8_SA(b, h) + aoff + m * 2048 + k * 1024); } while (0)
#define PG8_LDB(dst, b, h) do { _Pragma("unroll") for (int n = 0; n < 2; ++n) _Pragma("unroll") for (int k = 0; k < 2; ++k) dst[n][k] = *(const LAS bf16x8*)(lds + PG8_SB(b, h) + boff + n * 2048 + k * 1024); } while (0)
#define PG8_MMA(ai, bj, At, Bt) do { __builtin_amdgcn_s_setprio(1); _Pragma("unroll") for (int m = 0; m < 4; ++m) _Pragma("unroll") for (int n = 0; n < 2; ++n) _Pragma("unroll") for (int k = 0; k < 2; ++k) \
        acc[ai][bj][m][n] = __builtin_amdgcn_mfma_f32_16x16x32_bf16(Bt[n][k], At[m][k], acc[ai][bj][m][n], 0, 0, 0); __builtin_amdgcn_s_setprio(0); } while (0)
#define PG8_WAIT_V(n) asm volatile("s_waitcnt vmcnt(" #n ")" ::: "memory")
#define PG8_WAIT_L(n) asm volatile("s_waitcnt lgkmcnt(" #n ")" ::: "memory")
#define PG8_BAR __builtin_amdgcn_s_barrier()
#define PG8_SCHED __builtin_amdgcn_sched_barrier(0)
    Unit cur, nxt; int ui = 0;
    if (!S.next(0, cur)) return;
    if constexpr (HOOK) S.a_ready(cur);
    f32x4 acc[2][2][4][2];
#pragma unroll
    for (int a = 0; a < 2; ++a)
#pragma unroll
        for (int b = 0; b < 2; ++b)
#pragma unroll
            for (int m = 0; m < 4; ++m)
#pragma unroll
                for (int n = 0; n < 2; ++n) acc[a][b][m][n] = (f32x4){0.f, 0.f, 0.f, 0.f};
    bf16x8 At[4][2], B0[2][2], B1[2][2];
    const char* cA = cur.a; const char* cB = cur.b;
    PG8_GMAP(cur, ga);
    PG8_STAGE_B(PG8_SB(0, 0), cB); PG8_STAGE_A(PG8_SA(0, 0), cA, 0, false); PG8_STAGE_B(PG8_SB(0, 1), cB + hstepB); PG8_STAGE_A(PG8_SA(0, 1), cA, 1, false);
    if (wr == 1) PG8_BAR;
    PG8_WAIT_V(4); PG8_BAR;
    PG8_STAGE_B(PG8_SB(1, 0), cB + kstep); PG8_STAGE_A(PG8_SA(1, 0), cA + kstep, 0, false); PG8_STAGE_B(PG8_SB(1, 1), cB + hstepB + kstep);
    PG8_WAIT_V(6); PG8_BAR;
    for (;;) {
        const bool has_next = S.next(ui + 1, nxt);
        const char* nA = has_next ? nxt.a : cA; const char* nB = has_next ? nxt.b : cB;
        if constexpr (GATHER) { if (has_next) { PG8_GMAP(nxt, gn); } else {
#pragma unroll
            for (int _h = 0; _h < 2; ++_h)
#pragma unroll
                for (int _i = 0; _i < 2; ++_i) gn[_h][_i] = ga[_h][_i]; } }
        for (int t = 0; t < nt; t += 2) {
            const bool last = (t == nt - 2);
            if constexpr (HOOK) { if (last && has_next) S.a_ready(nxt); }
            const char* a1 = cA + (size_t)(t + 1) * kstep;
            const char* a2 = last ? nA : cA + (size_t)(t + 2) * kstep; const char* b2 = last ? nB : cB + (size_t)(t + 2) * kstep;
            const char* a3 = a2 + kstep; const char* b3 = b2 + kstep;
            PG8_LDB(B0, 0, 0); PG8_SCHED; PG8_LDA(At, 0, 0); PG8_STAGE_A(PG8_SA(1, 1), a1, 1, false);
            PG8_WAIT_L(8); PG8_BAR; PG8_WAIT_L(0); PG8_MMA(0, 0, At, B0); PG8_BAR; PG8_SCHED;
            PG8_LDB(B1, 0, 1); PG8_STAGE_B(PG8_SB(0, 0), b2);
            PG8_BAR; PG8_WAIT_L(0); PG8_MMA(0, 1, At, B1); PG8_BAR;
            PG8_LDA(At, 0, 1); PG8_STAGE_A(PG8_SA(0, 0), a2, 0, last);
            PG8_BAR; PG8_WAIT_L(0); PG8_MMA(1, 0, At, B0); PG8_BAR; PG8_SCHED;
            PG8_STAGE_B(PG8_SB(0, 1), b2 + hstepB);
            PG8_WAIT_V(6); PG8_BAR; PG8_MMA(1, 1, At, B1); PG8_BAR;
            PG8_LDB(B0, 1, 0); PG8_SCHED; PG8_LDA(At, 1, 0); PG8_STAGE_A(PG8_SA(0, 1), a2, 1, last);
            PG8_WAIT_L(8); PG8_BAR; PG8_WAIT_L(0); PG8_MMA(0, 0, At, B0); PG8_BAR; PG8_SCHED;
            PG8_LDB(B1, 1, 1); PG8_STAGE_B(PG8_SB(1, 0), b3);
            PG8_BAR; PG8_WAIT_L(0); PG8_MMA(0, 1, At, B1); PG8_BAR;
            PG8_LDA(At, 1, 1); PG8_STAGE_A(PG8_SA(1, 0), a3, 0, last);
            PG8_BAR; PG8_WAIT_L(0); PG8_MMA(1, 0, At, B0); PG8_BAR; PG8_SCHED;
            PG8_STAGE_B(PG8_SB(1, 1), b3 + hstepB);
            PG8_WAIT_V(6); PG8_BAR; PG8_MMA(1, 1, At, B1); PG8_BAR;
        }
        { int le = threadIdx.x & 63; asm volatile("" : "+v"(le));
          E(acc, cur, wr, wc, le & 15, le >> 4); }
        if (!has_next) break;
#pragma unroll
        for (int a = 0; a < 2; ++a)
#pragma unroll
            for (int b = 0; b < 2; ++b)
#pragma unroll
                for (int m = 0; m < 4; ++m)
#pragma unroll
                    for (int n = 0; n < 2; ++n) acc[a][b][m][n] = (f32x4){0.f, 0.f, 0.f, 0.f};
        cur = nxt; cA = nA; cB = nB; ++ui;
        if constexpr (GATHER) {
#pragma unroll
            for (int _h = 0; _h < 2; ++_h)
#pragma unroll
                for (int _i = 0; _i < 2; ++_i) ga[_h][_i] = gn[_h][_i]; }
    }
    PG8_WAIT_V(0);
    if (wr == 0) PG8_BAR;
    PG8_BAR;
#undef PG8_SA
#undef PG8_SB
#undef PG8_GLDS
#undef PG8_STAGE_A
#undef PG8_STAGE_B
#undef PG8_GMAP
#undef PG8_LDA
#undef PG8_LDB
#undef PG8_MMA
#undef PG8_WAIT_V
#undef PG8_WAIT_L
#undef PG8_BAR
#undef PG8_SCHED
}

__device__ __forceinline__ void store_tile_bf16(const f32x4 (&acc)[2][2][4][2], bf16_t* dst, size_t ld, int row0, int col0, float scale, int wr, int wc, int fr, int fq) {
#pragma unroll
    for (int ai = 0; ai < 2; ++ai)
#pragma unroll
        for (int m = 0; m < 4; ++m) { bf16_t* rowp = dst + (size_t)(row0 + ai * HALF + wr * 64 + m * 16 + fr) * ld + col0 + wc * 32 + 8 * fq;
#pragma unroll
            for (int bj = 0; bj < 2; ++bj) { const f32x4 v0 = acc[ai][bj][m][0] * scale, v1 = acc[ai][bj][m][1] * scale;
                u32x4 w; w.x = pk2(v0[0], v0[1]); w.y = pk2(v0[2], v0[3]); w.z = pk2(v1[0], v1[1]); w.w = pk2(v1[2], v1[3]);
                *(u32x4*)(rowp + bj * HALF) = w; } }
}
}

struct Args { const float* in[23]; float* out; unsigned char* ws; int g_lo, g_hi, use_bar, pad; };
enum { IN_X = 0, IN_POS, IN_ATTN_NORM, IN_W_IN, IN_POOL_W, IN_POOL_SCALE, IN_Q_NORM, IN_W_UQ, IN_KV_NORM, IN_W_UKV, IN_LAMBDA, IN_SUBLN, IN_REL_BIAS, IN_W_OUT, IN_FFN_NORM,
       IN_RG_W, IN_RG_B, IN_RE_W, IN_RE_B, IN_EW_GATE, IN_EW_UP, IN_EW_DOWN, IN_FINAL_NORM };

struct Frame {
    LAS unsigned char* lds;
    volatile LAS unsigned* MISC;
    unsigned* ctl;
    unsigned char* ws;
    unsigned char* ws0;
    int tid, lane, wave, vcu, G, bx;
};
constexpr int MISC_PTAB = 192;
__device__ __forceinline__ const float* inptr(const Frame& F, int i) {
    const unsigned lo = __builtin_amdgcn_readfirstlane(F.MISC[MISC_PTAB + 2 * i]), hi = __builtin_amdgcn_readfirstlane(F.MISC[MISC_PTAB + 2 * i + 1]);
    return (const float*)(GAS const float*)(((unsigned long long)hi << 32) | lo);
}

__device__ __forceinline__ void frame_refresh(Frame& F) {
    int t = threadIdx.x; asm volatile("" : "+v"(t)); F.tid = t; F.lane = t & 63; F.wave = __builtin_amdgcn_readfirstlane(t >> 6);
    int bx = blockIdx.x, G = gridDim.x; asm volatile("" : "+s"(bx), "+s"(G)); F.bx = bx; F.G = G; F.vcu = (G % 8 == 0) ? (bx % 8) * (G / 8) + bx / 8 : bx;
    GAS unsigned char* w = (GAS unsigned char*)F.ws0; asm volatile("" : "+s"(w)); F.ws = (unsigned char*)w; F.ctl = (unsigned*)(F.ws + WS_CTL);
    LAS unsigned char* lb = F.lds; asm volatile("" : "+s"(lb)); F.MISC = (volatile LAS unsigned*)(lb + LDS_MISC);
}
__device__ __forceinline__ void tr_write(bf16_t* WT, int ldo, int n0, int k0, LAS float* scr, int lane) {
    LDS_WAIT(); asm volatile("" ::: "memory");
#pragma unroll
    for (int it = 0; it < 8; ++it) { const int n = 8 * it + (lane >> 3), kc = lane & 7; const LAS float* s = scr + (8 * kc) * 65 + n;
        u32x4 o; o.x = pk2(s[0], s[65]); o.y = pk2(s[2 * 65], s[3 * 65]); o.z = pk2(s[4 * 65], s[5 * 65]); o.w = pk2(s[6 * 65], s[7 * 65]);
        __builtin_nontemporal_store(o, (u32x4*)(WT + (size_t)(n0 + n) * ldo + k0 + 8 * kc)); }
    LDS_WAIT(); asm volatile("" ::: "memory");
}
__device__ __forceinline__ void tr_item(const float* W, int ldw, int k0, int c0, bf16_t* WT, int ldo, int n0, const float* kscale, LAS float* scr, int lane) {
#pragma unroll
    for (int i = 0; i < 16; ++i) { const int k = 4 * i + (lane >> 4); f32x4 v = __builtin_nontemporal_load((const f32x4*)(W + (size_t)(k0 + k) * ldw + c0 + 4 * (lane & 15)));
        if (kscale) v = v * kscale[k0 + k];
        LAS float* d = scr + k * 65 + 4 * (lane & 15); d[0] = v[0]; d[1] = v[1]; d[2] = v[2]; d[3] = v[3]; }
    tr_write(WT, ldo, n0, k0, scr, lane);
}
__device__ __forceinline__ void tr_item_map(const float* W, int ldw, int k0, int srccol, bf16_t* WT, int ldo, int n0, const float* kscale, LAS float* scr, int lane) {
#pragma unroll 8
    for (int k = 0; k < 64; ++k) { float v = 0.f; if (srccol >= 0) { v = W[(size_t)(k0 + k) * ldw + srccol]; if (kscale) v *= kscale[k0 + k]; } scr[k * 65 + lane] = v; }
    tr_write(WT, ldo, n0, k0, scr, lane);
}

struct XItem { const float* src; bf16_t* dst; int ldw, ldo; };
constexpr int XJ_GU = 32 * 2 * 8 * 32, XJ_D = 32 * 32 * 8, XJ_L = XJ_GU + XJ_D;
__device__ __forceinline__ XItem x_item(Frame& F, int x) {
    unsigned char* ws = F.ws; const int l = x / XJ_L; int r = x % XJ_L; XItem it;
    if (r < XJ_GU) {
        const int e = r / 512, q = r % 512, isup = q >> 8, ntile = q & 7, kt = (q >> 3) & 31, c0 = ntile * 64, n0 = (c0 >> 7) * 256 + isup * 128 + (c0 & 127);
        it.src = inptr(F, isup ? IN_EW_UP : IN_EW_GATE) + ((size_t)l * NE + e) * D * EH + (size_t)(kt * 64) * EH + c0; it.ldw = EH;
        it.dst = (bf16_t*)(ws + WS_WGU + ((size_t)l * NE + e) * SZ_WGU1) + (size_t)n0 * D + kt * 64; it.ldo = D; }
    else { r -= XJ_GU;
        const int e = r / 256, q = r % 256, ntile = q & 31, kt = q >> 5;
        it.src = inptr(F, IN_EW_DOWN) + ((size_t)l * NE + e) * EH * D + (size_t)(kt * 64) * D + ntile * 64; it.ldw = D;
        it.dst = (bf16_t*)(ws + WS_WD + ((size_t)l * NE + e) * SZ_WD1) + (size_t)(ntile * 64) * EH + kt * 64; it.ldo = EH; }
    return it;
}
#define X_LOAD(R, IT) do { _Pragma("unroll") for (int _i = 0; _i < 16; ++_i) R[_i] = __builtin_nontemporal_load((const f32x4*)((IT).src + (size_t)(4 * _i + (lane >> 4)) * (IT).ldw + 4 * (lane & 15))); } while (0)
#define X_OUT(R, IT) do { _Pragma("unroll") for (int _i = 0; _i < 16; ++_i) { LAS float* _d = scr + (4 * _i + (lane >> 4)) * 65 + 4 * (lane & 15); _d[0] = R[_i][0]; _d[1] = R[_i][1]; _d[2] = R[_i][2]; _d[3] = R[_i][3]; } \
        tr_write((IT).dst, (IT).ldo, 0, 0, scr, lane); } while (0)

__device__ __forceinline__ void p0_prologue(Frame& F) {
    frame_refresh(F);
    unsigned char* ws = F.ws;
    {
        LAS float* AsT = (LAS float*)F.lds;
        LAS float* Pw = (LAS float*)(F.lds + 128 * 68 * 4);
        for (int it = F.bx; it < NL * 4 * 32; it += F.G) {
            const int l = it / 128, g = (it / 32) & 3, kb = it & 31;
            const float* win = inptr(F, IN_W_IN) + (size_t)l * D * NIN; const float* pw = inptr(F, IN_POOL_W) + (size_t)(l * 4 + g) * 128 * 128; const float* ps = inptr(F, IN_POOL_SCALE) + l * 512 + g * 128;
            __syncthreads();
#pragma unroll
            for (int i = 0; i < 4; ++i) { const int idx = F.tid + 512 * i, row = idx >> 5, c4 = idx & 31; const f32x4 v = *(const f32x4*)(win + (size_t)(kb * 64 + row) * NIN + g * 128 + 4 * c4);
                LAS float* d = AsT + (4 * c4) * 68 + row; d[0] = v[0]; d[68] = v[1]; d[136] = v[2]; d[204] = v[3]; }
#pragma unroll
            for (int i = 0; i < 8; ++i) { const int idx = F.tid + 512 * i, c = idx >> 5, d4 = idx & 31; f32x4 v = *(const f32x4*)(pw + c * 128 + 4 * d4); const f32x4 sc = *(const f32x4*)(ps + 4 * d4);
                *(LAS f32x4*)(Pw + c * 128 + 4 * d4) = v * sc; }
            __syncthreads();
            const int kg = F.tid & 15, d4 = F.tid >> 4; f32x4 acc[4];
#pragma unroll
            for (int i = 0; i < 4; ++i) acc[i] = (f32x4){0.f, 0.f, 0.f, 0.f};
#pragma unroll 4
            for (int c = 0; c < 128; ++c) { const f32x4 pv = *(const LAS f32x4*)(Pw + c * 128 + 4 * d4), av = *(const LAS f32x4*)(AsT + c * 68 + 4 * kg);
#pragma unroll
                for (int i = 0; i < 4; ++i) acc[i] += pv * av[i]; }
            bf16_t* o = (bf16_t*)(ws + WS_WIN + (size_t)l * SZ_WIN) + (size_t)(g * 128 + 4 * d4) * D + kb * 64 + 4 * kg;
#pragma unroll
            for (int j = 0; j < 4; ++j) { u32x2 w; w.x = pk2(acc[0][j], acc[1][j]); w.y = pk2(acc[2][j], acc[3][j]); *(u32x2*)(o + (size_t)j * D) = w; }
        }
        __syncthreads();
    }
    {
        LAS float* scr = (LAS float*)(F.lds + F.wave * 16640);
        const int gw = F.vcu * NWAVES + F.wave, NGW = F.G * NWAVES, lane = F.lane;
        constexpr int J_WO = 32 * 32, J_A = 12 * 32, J_KR = 32, J_B = 24 * 32, J_DV = 12 * 32, J_UQ = 20 * 8, J_K = 12 * 4, J_V = 12 * 4;
        constexpr int J_L = J_WO + J_A + J_KR + J_B + J_DV + J_UQ + J_K + J_V;
        {
            f32x4 RA[16], RB[16]; int x = gw; XItem ia = x_item(F, x < NL * XJ_L ? x : 0), ib;
            if (x < NL * XJ_L) X_LOAD(RA, ia);
            while (x < NL * XJ_L) {
                const int x1 = x + NGW; if (x1 < NL * XJ_L) { ib = x_item(F, x1); X_LOAD(RB, ib); }
                X_OUT(RA, ia);
                if (x1 >= NL * XJ_L) break;
                const int x2 = x1 + NGW; if (x2 < NL * XJ_L) { ia = x_item(F, x2); X_LOAD(RA, ia); }
                X_OUT(RB, ib);
                x = x2;
            }
        }
        for (int it = gw; it < NL * J_L; it += NGW) {
            const int l = it / J_L; int r = it % J_L;
            const float* win = inptr(F, IN_W_IN) + (size_t)l * D * NIN;
            bf16_t* WinT = (bf16_t*)(ws + WS_WIN + (size_t)l * SZ_WIN);
            if (r < J_WO) { const int ntile = r >> 5, kt = r & 31;
                tr_item(inptr(F, IN_W_OUT) + (size_t)l * D * D, D, kt * 64, ntile * 64, (bf16_t*)(ws + WS_WOUT + (size_t)l * SZ_WOUT), D, ntile * 64, nullptr, scr, lane); continue; }
            r -= J_WO;
            if (r < J_A) { const int ntile = r >> 5, kt = r & 31;
                tr_item(win, NIN, kt * 64, 512 + ntile * 64, WinT, D, 512 + ntile * 64, nullptr, scr, lane); continue; }
            r -= J_A;
            if (r < J_KR) { const int kt = r;
                tr_item_map(win, NIN, kt * 64, 1280 + (lane >> 1) + 32 * (lane & 1), WinT, D, 1280, nullptr, scr, lane); continue; }
            r -= J_KR;
            if (r < J_B) { const int ntile = r >> 5, kt = r & 31;
                tr_item(win, NIN, kt * 64, 1344 + ntile * 64, WinT, D, 1536 + ntile * 64, nullptr, scr, lane); continue; }
            r -= J_B;
            if (r < J_DV) { const int ntile = r >> 5, kt = r & 31;
                tr_item(win, NIN, kt * 64, 2880 + ntile * 64, (bf16_t*)(ws + WS_WDV + (size_t)l * SZ_WDV), D, ntile * 64, nullptr, scr, lane); continue; }
            r -= J_DV;
            if (r < J_UQ) { const int ntile = r >> 3, kt = r & 7;
                const int n = ntile * 64 + lane; int src = -1;
                if (n < 1152) { const int hd = n / 192, w = n % 192; src = hd * 192 + (w < 128 ? w : 128 + ((w - 128) >> 1) + 32 * ((w - 128) & 1)); }
                tr_item_map(inptr(F, IN_W_UQ) + (size_t)l * 512 * 1152, 1152, kt * 64, src, (bf16_t*)(ws + WS_WUQ + (size_t)l * SZ_WUQ), 512, ntile * 64, inptr(F, IN_Q_NORM) + l * 512, scr, lane); continue; }
            r -= J_UQ;
            {
                const bool isv = r >= J_K; if (isv) r -= J_K;
                const int ntile = r >> 2, kt = r & 3, n0 = ntile * 64, hd = n0 >> 7, c0 = hd * 256 + (isv ? 128 : 0) + (n0 & 127);
                tr_item(inptr(F, IN_W_UKV) + (size_t)l * 256 * 1536, 1536, kt * 64, c0, (bf16_t*)(ws + (isv ? WS_WV : WS_WK) + (size_t)l * SZ_WK), 256, n0, inptr(F, IN_KV_NORM) + l * 256, scr, lane);
            }
        }
        for (int l = 0; l < NL; ++l) { u32x4* z = (u32x4*)((bf16_t*)(ws + WS_WIN + (size_t)l * SZ_WIN) + (size_t)1344 * D);
            for (int i = gw * 64 + lane; i < 192 * D / 8; i += NGW * 64) z[i] = (u32x4){0u, 0u, 0u, 0u}; }
        const int* pos = (const int*)inptr(F, IN_POS);
        for (int i = gw * 64 + lane; i < T * 32; i += NGW * 64) { const int t = i >> 5, f = i & 31;
            const double inv = pow(10000.0, -(double)(2 * f) / 64.0); const double ang = (double)pos[t] * inv;
            ((float*)(ws + WS_COS))[i] = (float)cos(ang); ((float*)(ws + WS_SIN))[i] = (float)sin(ang); }
        for (int i = gw * 64 + lane; i < 6 * 132; i += NGW * 64) { const int hd = i / 132, n = i % 132; float v = 0.f;
            if (n <= 128) { int bkt; if (n < 16) bkt = n; else { bkt = 16 + (int)(log((double)n / 16.0) / log(8.0) * 16.0); bkt = bkt < 31 ? bkt : 31; }
                v = inptr(F, IN_REL_BIAS)[bkt * 6 + hd] * LOG2E; }
            ((float*)(ws + WS_LUT))[i] = v; }
        for (int i = gw * 64 + lane; i < NL * 64 * D; i += NGW * 64) { const int l = i / (64 * D), c = (i / D) & 63, k = i & (D - 1); float v = 0.f;
            if (c < 4) v = inptr(F, IN_RG_W)[((size_t)l * D + k) * 4 + c]; else if (c < 36) v = inptr(F, IN_RE_W)[((size_t)l * D + k) * 32 + c - 4];
            v *= inptr(F, IN_FFN_NORM)[l * D + k];
            const unsigned hi = pk2(v, 0.f) & 0xffffu; const float rem = v - __builtin_bit_cast(float, hi << 16);
            const int fo = (((l * 8 + (k >> 8)) * 16 + ((k >> 4) & 15)) * 4 + (c >> 5)) * 512 + ((c & 31) + 32 * ((k >> 3) & 1)) * 8 + (k & 7);
            ((bf16_t*)(ws + WS_WRH))[fo] = (bf16_t)hi; ((bf16_t*)(ws + WS_WRH))[fo + 1024] = (bf16_t)(pk2(rem, 0.f) & 0xffffu); }
        for (int i = gw * 64 + lane; i < NB * 32; i += NGW * 64) { int mx = pos[i * 64]; for (int j = 1; j < 64; ++j) { const int p = pos[i * 64 + j]; mx = p > mx ? p : mx; } ((int*)(ws + WS_TMAX))[i] = mx; }
        const float* x = inptr(F, IN_X); bf16_t* h = (bf16_t*)(ws + WS_H); bf16_t* u = (bf16_t*)(ws + WS_XB); const float* gn = inptr(F, IN_ATTN_NORM);
        f32x4 g0[8];
#pragma unroll
        for (int j = 0; j < 8; ++j) g0[j] = ((const f32x4*)gn)[lane + 64 * j];
        for (int m = gw; m < T; m += NGW) {
            const f32x4* xr = (const f32x4*)(x + (size_t)m * D) + lane; u32x2* hr = (u32x2*)(h + (size_t)m * D) + lane; f32x4 v[8]; float s = 0.f;
#pragma unroll
            for (int j = 0; j < 8; ++j) v[j] = xr[64 * j];
            asm volatile("" ::: "memory");
#pragma unroll
            for (int j = 0; j < 8; ++j) { { u32x2 hw; hw.x = pk2(v[j][0], v[j][1]); hw.y = pk2(v[j][2], v[j][3]); hr[64 * j] = hw; } s += (v[j][0] * v[j][0] + v[j][1] * v[j][1]) + (v[j][2] * v[j][2] + v[j][3] * v[j][3]); }
            const float rs = 1.0f / sqrtf(wave_sum(s) * (1.0f / D) + EPS);
            u32x2* o = (u32x2*)(u + (size_t)m * D) + lane;
#pragma unroll
            for (int j = 0; j < 8; ++j) { const f32x4 gg = g0[j]; u32x2 w; w.x = pk2(v[j][0] * rs * gg[0], v[j][1] * rs * gg[1]); w.y = pk2(v[j][2] * rs * gg[2], v[j][3] * rs * gg[3]); o[64 * j] = w; }
        }
    }
}

enum { K1_ZP = 0, K1_CQ, K1_CKV, K1_KR, K1_DQ, K1_DK, K1_DVT };
struct SchedP1 {
    int G, c, l; unsigned char* ws;
    __device__ __forceinline__ bool next(int i, pg8::Unit& U) const {
        const int L = i * G + c; if (L >= 480) return false;
        const char* u = (const char*)(ws + WS_XB); const char* win = (const char*)(ws + WS_WIN + (size_t)l * SZ_WIN); const char* wdv = (const char*)(ws + WS_WDV + (size_t)l * SZ_WDV);
        U.rowmap = nullptr; U.nrows = 256; U.p3 = 0;
        if (L < 384) { int pm, pn; pg8::tile_of(L, 32, 12, pm, pn);
            U.a = u + (size_t)pm * 256 * D * 2; U.b = win + (size_t)pn * 256 * D * 2; U.p1 = 256 * pm;
            if (pn < 2) { U.p0 = K1_ZP; U.p2 = 256 * pn; } else if (pn < 4) { U.p0 = K1_CQ; U.p2 = 256 * (pn - 2); } else if (pn == 4) { U.p0 = K1_CKV; U.p2 = 0; }
            else if (pn == 5) { U.p0 = K1_KR; U.p2 = 0; } else if (pn < 9) { U.p0 = K1_DQ; U.p2 = 256 * (pn - 6); } else { U.p0 = K1_DK; U.p2 = 256 * (pn - 9); }
        } else { const int Ls = L - 384, pm = Ls % 3, pn = Ls / 3;
            U.a = wdv + (size_t)pm * 256 * D * 2; U.b = u + (size_t)pn * 256 * D * 2; U.p0 = K1_DVT; U.p1 = 256 * pm; U.p2 = 256 * pn; }
        return true;
    }
};
struct EpiP1 {
    static constexpr bool PERM = true;
    unsigned char* ws;
    __device__ __forceinline__ void operator()(const f32x4 (&acc)[2][2][4][2], const pg8::Unit& U, int wr, int wc, int fr, int fq) const {
        const int kind = U.p0, row0 = U.p1, col0 = U.p2;
        bf16_t *zp = (bf16_t*)(ws + WS_ZP), *cq = (bf16_t*)(ws + WS_CQ), *ckv = (bf16_t*)(ws + WS_CKV), *kr = (bf16_t*)(ws + WS_KR), *dq = (bf16_t*)(ws + WS_DQ), *dk = (bf16_t*)(ws + WS_DK), *dvT = (bf16_t*)(ws + WS_DVT);
        float *cqss = (float*)(ws + WS_CQSS), *ckvss = (float*)(ws + WS_CKVSS); const float *cs = (const float*)(ws + WS_COS), *sn = (const float*)(ws + WS_SIN);
        if (kind == K1_ZP) { pg8::store_tile_bf16(acc, zp, 512, row0, col0, 1.0f, wr, wc, fr, fq); }
        else if (kind == K1_CQ || kind == K1_CKV) {
            if (kind == K1_CQ) pg8::store_tile_bf16(acc, cq, 512, row0, col0, 1.0f, wr, wc, fr, fq); else pg8::store_tile_bf16(acc, ckv, 256, row0, 0, 1.0f, wr, wc, fr, fq);
            float* ss = (kind == K1_CQ) ? cqss : ckvss; const int ns = (kind == K1_CQ) ? 8 : 4, slot = (kind == K1_CQ) ? (col0 >> 8) * 4 + wc : wc;
#pragma unroll
            for (int ai = 0; ai < 2; ++ai)
#pragma unroll
                for (int m = 0; m < 4; ++m) { float s = 0.f;
#pragma unroll
                    for (int bj = 0; bj < 2; ++bj)
#pragma unroll
                        for (int n = 0; n < 2; ++n) { const f32x4 x = acc[ai][bj][m][n]; s += (x[0] * x[0] + x[1] * x[1]) + (x[2] * x[2] + x[3] * x[3]); }
                    s += xor_lt32<16>(s); s = sum32(s);
                    if (fq == 0) ss[(size_t)(row0 + ai * 128 + wr * 64 + m * 16 + fr) * ns + slot] = s; }
        }
        else if (kind == K1_KR) {
            if (wc < 2) {
#pragma unroll
                for (int ai = 0; ai < 2; ++ai) { f32x4 cb[4], sb[4];
#pragma unroll
                    for (int i = 0; i < 4; ++i) { const int row = row0 + ai * 128 + wr * 64 + i * 16 + fr; cb[i] = *(const f32x4*)(cs + (size_t)row * 32 + 16 * wc + 4 * fq); sb[i] = *(const f32x4*)(sn + (size_t)row * 32 + 16 * wc + 4 * fq); }
                    asm volatile("" ::: "memory");
#pragma unroll
                    for (int m = 0; m < 4; ++m) { const int row = row0 + ai * 128 + wr * 64 + m * 16 + fr;
                        const f32x4 c4 = cb[m], s4 = sb[m];
                        const f32x4 v0 = acc[ai][0][m][0], v1 = acc[ai][0][m][1]; u32x4 w;
                        w.x = pk2(v0[0] * c4[0] - v0[1] * s4[0], v0[0] * s4[0] + v0[1] * c4[0]); w.y = pk2(v0[2] * c4[1] - v0[3] * s4[1], v0[2] * s4[1] + v0[3] * c4[1]);
                        w.z = pk2(v1[0] * c4[2] - v1[1] * s4[2], v1[0] * s4[2] + v1[1] * c4[2]); w.w = pk2(v1[2] * c4[3] - v1[3] * s4[3], v1[2] * s4[3] + v1[3] * c4[3]);
                        *(u32x4*)(kr + (size_t)row * 64 + 32 * wc + 8 * fq) = w; asm volatile("" ::: "memory"); } }
            }
        }
        else if (kind == K1_DQ) { pg8::store_tile_bf16(acc, dq, 768, row0, col0, 0.125f * LOG2E, wr, wc, fr, fq); }
        else if (kind == K1_DK) { pg8::store_tile_bf16(acc, dk, 768, row0, col0, 1.0f, wr, wc, fr, fq); }
        else { pg8::store_tile_bf16(acc, dvT, T, row0, col0, 1.0f, wr, wc, fr, fq); }
    }
};

struct SchedQ {
    int G, c, l; unsigned char* ws;
    __device__ __forceinline__ bool next(int i, pg8::Unit& U) const {
        const int L = i * G + c; if (L >= 160) return false;
        const char* cq = (const char*)(ws + WS_CQ); const char* wuq = (const char*)(ws + WS_WUQ + (size_t)l * SZ_WUQ);
        int pm, pn; pg8::tile_of(L, 32, 5, pm, pn);
        U.a = cq + (size_t)pm * 256 * 512 * 2; U.b = wuq + (size_t)pn * 256 * 512 * 2; U.rowmap = nullptr; U.nrows = 256; U.p0 = 0; U.p1 = 256 * pm; U.p2 = 256 * pn; U.p3 = 0; return true;
    }
};
constexpr float QM_SCALE = 0.07216878364870322f * LOG2E;
struct EpiQ {
    static constexpr bool PERM = true;
    unsigned char* ws;
    __device__ __forceinline__ void operator()(const f32x4 (&acc)[2][2][4][2], const pg8::Unit& U, int wr, int wc, int fr, int fq) const {
        const int row0 = U.p1, colt = U.p2;
        bf16_t* qm = (bf16_t*)(ws + WS_QM); const float* cqss = (const float*)(ws + WS_CQSS); const float *cs = (const float*)(ws + WS_COS), *sn = (const float*)(ws + WS_SIN);
        bool isr[2], inr[2]; int i0 = 0;
#pragma unroll
        for (int bj = 0; bj < 2; ++bj) { const int cg = colt + bj * 128 + wc * 32 + 8 * fq, w = cg % 192; inr[bj] = cg < 1152; isr[bj] = inr[bj] && w >= 128; if (isr[bj]) i0 = (w - 128) >> 1; }
#pragma unroll
        for (int ai = 0; ai < 2; ++ai)
#pragma unroll
          for (int mh = 0; mh < 4; mh += 2) {
            f32x4 p0[2], p1[2], c4[2], s4[2];
#pragma unroll
            for (int m2 = 0; m2 < 2; ++m2) { const int row = row0 + ai * 128 + wr * 64 + (mh + m2) * 16 + fr;
                p0[m2] = *(const f32x4*)(cqss + (size_t)row * 8); p1[m2] = *(const f32x4*)(cqss + (size_t)row * 8 + 4); c4[m2] = *(const f32x4*)(cs + (size_t)row * 32 + i0); s4[m2] = *(const f32x4*)(sn + (size_t)row * 32 + i0); }
            asm volatile("" ::: "memory");
#pragma unroll
            for (int m2 = 0; m2 < 2; ++m2) { const int m = mh + m2; int row = row0 + ai * 128 + wr * 64 + m * 16 + fr; asm volatile("" : "+v"(row));
                const float ssum = ((p0[m2][0] + p0[m2][1]) + (p0[m2][2] + p0[m2][3])) + ((p1[m2][0] + p1[m2][1]) + (p1[m2][2] + p1[m2][3]));
                const float rs = QM_SCALE / sqrtf(ssum * (1.0f / 512.0f) + EPS); const f32x4 cc = c4[m2], ss = s4[m2];
#pragma unroll
                for (int bj = 0; bj < 2; ++bj) { const int cg = colt + bj * 128 + wc * 32 + 8 * fq;
                    if (inr[bj]) { const f32x4 v0 = acc[ai][bj][m][0] * rs, v1 = acc[ai][bj][m][1] * rs; u32x4 o;
                        if (isr[bj]) {
                            o.x = pk2(v0[0] * cc[0] - v0[1] * ss[0], v0[0] * ss[0] + v0[1] * cc[0]); o.y = pk2(v0[2] * cc[1] - v0[3] * ss[1], v0[2] * ss[1] + v0[3] * cc[1]);
                            o.z = pk2(v1[0] * cc[2] - v1[1] * ss[2], v1[0] * ss[2] + v1[1] * cc[2]); o.w = pk2(v1[2] * cc[3] - v1[3] * ss[3], v1[2] * ss[3] + v1[3] * cc[3]); }
                        else { o.x = pk2(v0[0], v0[1]); o.y = pk2(v0[2], v0[3]); o.z = pk2(v1[0], v1[1]); o.w = pk2(v1[2], v1[3]); }
                        *(u32x4*)(qm + (size_t)row * 1152 + cg) = o; } }
                asm volatile("" ::: "memory"); }
          }
    }
};
struct SchedKV {
    int G, c, l; unsigned char* ws;
    __device__ __forceinline__ bool next(int i, pg8::Unit& U) const {
        const int L = i * G + c; if (c < 0 || L >= 192) return false;
        const char* ckv = (const char*)(ws + WS_CKV); const char* wk = (const char*)(ws + WS_WK + (size_t)l * SZ_WK); const char* wv = (const char*)(ws + WS_WV + (size_t)l * SZ_WK);
        U.rowmap = nullptr; U.nrows = 256; U.p3 = 0;
        if (L < 96) { int pm, pn; pg8::tile_of(L, 32, 3, pm, pn); U.a = ckv + (size_t)pm * 256 * 256 * 2; U.b = wk + (size_t)pn * 256 * 256 * 2; U.p0 = 0; U.p1 = 256 * pm; U.p2 = 256 * pn; }
        else { const int Ls = L - 96, pm = Ls % 3, pn = Ls / 3; U.a = wv + (size_t)pm * 256 * 256 * 2; U.b = ckv + (size_t)pn * 256 * 256 * 2; U.p0 = 1; U.p1 = 256 * pm; U.p2 = 256 * pn; }
        return true;
    }
};
struct EpiKV {
    static constexpr bool PERM = true;
    unsigned char* ws;
    __device__ __forceinline__ float rs_of(int t) const { const float* ckvss = (const float*)(ws + WS_CKVSS); const f32x4 p = *(const f32x4*)(ckvss + (size_t)t * 4); return 1.0f / sqrtf(((p[0] + p[1]) + (p[2] + p[3])) * (1.0f / 256.0f) + EPS); }
    __device__ __forceinline__ void operator()(const f32x4 (&acc)[2][2][4][2], const pg8::Unit& U, int wr, int wc, int fr, int fq) const {
        const int row0 = U.p1, col0 = U.p2; bf16_t *kn = (bf16_t*)(ws + WS_KN), *vmT = (bf16_t*)(ws + WS_VMT);
        if (U.p0 == 0) {
            float rsb[8]; { f32x4 pv[8]; const float* ckvss = (const float*)(ws + WS_CKVSS);
#pragma unroll
              for (int i = 0; i < 8; ++i) pv[i] = *(const f32x4*)(ckvss + (size_t)(row0 + (i >> 2) * 128 + wr * 64 + (i & 3) * 16 + fr) * 4);
              asm volatile("" ::: "memory");
#pragma unroll
              for (int i = 0; i < 8; ++i) rsb[i] = 1.0f / sqrtf(((pv[i][0] + pv[i][1]) + (pv[i][2] + pv[i][3])) * (1.0f / 256.0f) + EPS); }
#pragma unroll
            for (int ai = 0; ai < 2; ++ai)
#pragma unroll
                for (int m = 0; m < 4; ++m) { int row = row0 + ai * 128 + wr * 64 + m * 16 + fr; asm volatile("" : "+v"(row)); const float rs = rsb[ai * 4 + m];
                    bf16_t* rowp = kn + (size_t)row * 768 + col0 + wc * 32 + 8 * fq;
#pragma unroll
                    for (int bj = 0; bj < 2; ++bj) { const f32x4 v0 = acc[ai][bj][m][0] * rs, v1 = acc[ai][bj][m][1] * rs;
                        u32x4 w; w.x = pk2(v0[0], v0[1]); w.y = pk2(v0[2], v0[3]); w.z = pk2(v1[0], v1[1]); w.w = pk2(v1[2], v1[3]); *(u32x4*)(rowp + bj * 128) = w; }
                    asm volatile("" ::: "memory"); }
        } else {
#pragma unroll
            for (int bj = 0; bj < 2; ++bj) { const int t0 = col0 + bj * 128 + wc * 32 + 8 * fq; float rs[8]; { f32x4 pv[8]; const float* ckvss = (const float*)(ws + WS_CKVSS);
#pragma unroll
                for (int j = 0; j < 8; ++j) pv[j] = *(const f32x4*)(ckvss + (size_t)(t0 + j) * 4);
                asm volatile("" ::: "memory");
#pragma unroll
                for (int j = 0; j < 8; ++j) rs[j] = 1.0f / sqrtf(((pv[j][0] + pv[j][1]) + (pv[j][2] + pv[j][3])) * (1.0f / 256.0f) + EPS); }
#pragma unroll
                for (int ai = 0; ai < 2; ++ai)
#pragma unroll
                    for (int m = 0; m < 4; ++m) { int row = row0 + ai * 128 + wr * 64 + m * 16 + fr; asm volatile("" : "+v"(row)); const f32x4 v0 = acc[ai][bj][m][0], v1 = acc[ai][bj][m][1];
                        u32x4 w; w.x = pk2(v0[0] * rs[0], v0[1] * rs[1]); w.y = pk2(v0[2] * rs[2], v0[3] * rs[3]); w.z = pk2(v1[0] * rs[4], v1[1] * rs[5]); w.w = pk2(v1[2] * rs[6], v1[3] * rs[7]);
                        *(u32x4*)(vmT + (size_t)row * T + t0) = w; }
                asm volatile("" ::: "memory"); }
        }
    }
};
template <int WIN> __device__ __forceinline__ void pool_load(u32x4 (&v)[WIN], const bf16_t* zrow, int cnt) {
#pragma unroll
    for (int k = 0; k < WIN; ++k) { const int kk = k < cnt ? k : 0; v[k] = *(const u32x4*)(zrow - (size_t)kk * 512); }
}
template <int WIN> __device__ __forceinline__ void pool_out(const u32x4 (&v)[WIN], bf16_t* orow, int cnt) {
    float sum[8], self[8];
#pragma unroll
    for (int j = 0; j < 4; ++j) { self[2 * j] = __builtin_bit_cast(float, v[0][j] << 16); self[2 * j + 1] = __builtin_bit_cast(float, v[0][j] & 0xffff0000u); sum[2 * j] = self[2 * j]; sum[2 * j + 1] = self[2 * j + 1]; }
#pragma unroll
    for (int k = 1; k < WIN; ++k)
#pragma unroll
        for (int j = 0; j < 4; ++j) { const unsigned w = k < cnt ? v[k][j] : 0u; sum[2 * j] += __builtin_bit_cast(float, w << 16); sum[2 * j + 1] += __builtin_bit_cast(float, w & 0xffff0000u); }
    const float ic = 1.0f / (float)cnt; u32x4 o;
    o.x = pk2(sum[0] * ic - self[0], sum[1] * ic - self[1]); o.y = pk2(sum[2] * ic - self[2], sum[3] * ic - self[3]);
    o.z = pk2(sum[4] * ic - self[4], sum[5] * ic - self[5]); o.w = pk2(sum[6] * ic - self[6], sum[7] * ic - self[7]);
    *(u32x4*)orow = o;
}
__device__ __forceinline__ void pool_stencil(Frame& F) {
    frame_refresh(F);
    const bf16_t* zp = (const bf16_t*)(F.ws + WS_ZP); bf16_t* mix = (bf16_t*)(F.ws + WS_MIX);
    for (int q = F.vcu * NTHR + F.tid; q < T * 16; q += F.G * NTHR) {
        const int t = q >> 4, c16 = q & 15, s = t & (S - 1);
        const int c0 = (s + 1) < 2 ? (s + 1) : 2, c1 = (s + 1) < 4 ? (s + 1) : 4, c2 = (s + 1) < 8 ? (s + 1) : 8, c3 = (s + 1) < 16 ? (s + 1) : 16;
        const bf16_t* zr = zp + (size_t)t * 512 + c16 * 8; bf16_t* orow = mix + (size_t)t * D + c16 * 8;
        u32x4 v0[2], v1[4], v2[8], v3[16];
        pool_load<16>(v3, zr + 384, c3); pool_load<8>(v2, zr + 256, c2); pool_load<4>(v1, zr + 128, c1); pool_load<2>(v0, zr, c0);
        asm volatile("" ::: "memory");
        pool_out<16>(v3, orow + 384, c3); pool_out<8>(v2, orow + 256, c2); pool_out<4>(v1, orow + 128, c1); pool_out<2>(v0, orow, c0);
    }
}

constexpr int ATT_MAXU = 3;
__device__ const unsigned short att_sched[256][ATT_MAXU] = {
  {1407,1266,65535},
  {1391,1250,65535},
  {1375,1234,65535},
  {1359,1218,65535},
  {1343,1202,65535},
  {1327,1186,65535},
  {1311,1170,65535},
  {1295,1154,65535},
  {1279,1138,65535},
  {1263,1122,65535},
  {1247,1106,65535},
  {1231,1090,65535},
  {1215,1074,65535},
  {1199,1058,65535},
  {1183,1042,65535},
  {1167,1026,65535},
  {1151,1393,1265},
  {1135,1377,1249},
  {1119,1361,1233},
  {1103,1345,1217},
  {1087,1329,1201},
  {1071,1313,1185},
  {1055,1297,1169},
  {1039,1281,1153},
  {1406,241,65535},
  {1390,225,65535},
  {1374,209,65535},
  {1358,193,65535},
  {1342,177,65535},
  {1326,161,65535},
  {1310,145,65535},
  {1294,129,65535},
  {1278,113,65535},
  {1262,97,65535},
  {1246,81,65535},
  {1230,65,65535},
  {1214,49,65535},
  {1198,33,65535},
  {1182,17,65535},
  {1166,1,65535},
  {1150,1394,1137},
  {1134,1378,1121},
  {1118,1362,1105},
  {1102,1346,1089},
  {1086,1330,1073},
  {1070,1314,1057},
  {1054,1298,1041},
  {1038,1282,1025},
  {375,1267,65535},
  {359,1251,65535},
  {343,1235,65535},
  {327,1219,65535},
  {311,1203,65535},
  {295,1187,65535},
  {279,1171,65535},
  {263,1155,65535},
  {247,1139,65535},
  {231,1123,65535},
  {215,1107,65535},
  {199,1091,65535},
  {183,1075,65535},
  {167,1059,65535},
  {151,1043,65535},
  {135,1027,65535},
  {119,369,65535},
  {103,353,65535},
  {87,337,65535},
  {71,321,65535},
  {55,305,65535},
  {39,289,65535},
  {23,273,65535},
  {7,257,65535},
  {1405,1268,65535},
  {1389,1252,65535},
  {1373,1236,65535},
  {1357,1220,65535},
  {1341,1204,65535},
  {1325,1188,65535},
  {1309,1172,65535},
  {1293,1156,65535},
  {1277,1140,65535},
  {1261,1124,65535},
  {1245,1108,65535},
  {1229,1092,65535},
  {1213,1076,65535},
  {1197,1060,65535},
  {1181,1044,65535},
  {1165,1028,65535},
  {1149,1395,1392},
  {1133,1379,1376},
  {1117,1363,1360},
  {1101,1347,1344},
  {1085,1331,1328},
  {1069,1315,1312},
  {1053,1299,1296},
  {1037,1283,1280},
  {1404,242,65535},
  {1388,226,65535},
  {1372,210,65535},
  {1356,194,65535},
  {1340,178,65535},
  {1324,162,65535},
  {1308,146,65535},
  {1292,130,65535},
  {1276,114,65535},
  {1260,98,65535},
  {1244,82,65535},
  {1228,66,65535},
  {1212,50,65535},
  {1196,34,65535},
  {1180,18,65535},
  {1164,2,65535},
  {1148,1396,368},
  {1132,1380,352},
  {1116,1364,336},
  {1100,1348,320},
  {1084,1332,304},
  {1068,1316,288},
  {1052,1300,272},
  {1036,1284,256},
  {374,1269,65535},
  {358,1253,65535},
  {342,1237,65535},
  {326,1221,65535},
  {310,1205,65535},
  {294,1189,65535},
  {278,1173,65535},
  {262,1157,65535},
  {246,1141,65535},
  {230,1125,65535},
  {214,1109,65535},
  {198,1093,65535},
  {182,1077,65535},
  {166,1061,65535},
  {150,1045,65535},
  {134,1029,65535},
  {118,370,65535},
  {102,354,65535},
  {86,338,65535},
  {70,322,65535},
  {54,306,65535},
  {38,290,65535},
  {22,274,65535},
  {6,258,65535},
  {1403,1270,65535},
  {1387,1254,65535},
  {1371,1238,65535},
  {1355,1222,65535},
  {1339,1206,65535},
  {1323,1190,65535},
  {1307,1174,65535},
  {1291,1158,65535},
  {1275,1142,65535},
  {1259,1126,65535},
  {1243,1110,65535},
  {1227,1094,65535},
  {1211,1078,65535},
  {1195,1062,65535},
  {1179,1046,65535},
  {1163,1030,65535},
  {1147,1397,240},
  {1131,1381,224},
  {1115,1365,208},
  {1099,1349,192},
  {1083,1333,176},
  {1067,1317,160},
  {1051,1301,144},
  {1035,1285,128},
  {1402,243,65535},
  {1386,227,65535},
  {1370,211,65535},
  {1354,195,65535},
  {1338,179,65535},
  {1322,163,65535},
  {1306,147,65535},
  {1290,131,65535},
  {1274,115,65535},
  {1258,99,65535},
  {1242,83,65535},
  {1226,67,65535},
  {1210,51,65535},
  {1194,35,65535},
  {1178,19,65535},
  {1162,3,65535},
  {1146,1398,1264},
  {1130,1382,1248},
  {1114,1366,1232},
  {1098,1350,1216},
  {1082,1334,1200},
  {1066,1318,1184},
  {1050,1302,1168},
  {1034,1286,1152},
  {373,1271,65535},
  {357,1255,65535},
  {341,1239,65535},
  {325,1223,65535},
  {309,1207,65535},
  {293,1191,65535},
  {277,1175,65535},
  {261,1159,65535},
  {245,1143,65535},
  {229,1127,65535},
  {213,1111,65535},
  {197,1095,65535},
  {181,1079,65535},
  {165,1063,65535},
  {149,1047,65535},
  {133,1031,65535},
  {117,371,65535},
  {101,355,65535},
  {85,339,65535},
  {69,323,65535},
  {53,307,65535},
  {37,291,65535},
  {21,275,65535},
  {5,259,65535},
  {1401,1272,65535},
  {1385,1256,65535},
  {1369,1240,65535},
  {1353,1224,65535},
  {1337,1208,65535},
  {1321,1192,65535},
  {1305,1176,65535},
  {1289,1160,65535},
  {1273,1144,65535},
  {1257,1128,65535},
  {1241,1112,65535},
  {1225,1096,65535},
  {1209,1080,65535},
  {1193,1064,65535},
  {1177,1048,65535},
  {1161,1032,65535},
  {1145,1399,112},
  {1129,1383,96},
  {1113,1367,80},
  {1097,1351,64},
  {1081,1335,48},
  {1065,1319,32},
  {1049,1303,16},
  {1033,1287,0},
  {372,116,65535},
  {356,100,65535},
  {340,84,65535},
  {324,68,65535},
  {308,52,65535},
  {292,36,65535},
  {276,20,65535},
  {260,4,65535},
  {244,1400,1136},
  {228,1384,1120},
  {212,1368,1104},
  {196,1352,1088},
  {180,1336,1072},
  {164,1320,1056},
  {148,1304,1040},
  {132,1288,1024},
};
namespace att {
constexpr int VROW = 136, KBUF = 64 * 400, VBUF = 128 * VROW, BUF = KBUF + VBUF;
constexpr int LUT_OFF = 2 * BUF;
constexpr int TMAX_OFF = LUT_OFF + 3328, POS_OFF = TMAX_OFF + 512;
#define MFMA32(a, b, c) __builtin_amdgcn_mfma_f32_32x32x16_bf16((a), (b), (c), 0, 0, 0)

template <int DQK, int KEL, bool BIAS>
__device__ __forceinline__ void attn_core(LAS unsigned char* lds, int tid, int lane,
        const bf16_t* qrow, const bf16_t* kA, int ldkA, const bf16_t* kB, const bf16_t* vT, int q0, int nj, int koffB,
        const LAS int* posb, const LAS int* tmaxb, const LAS float* lut, f32x16 (&o)[4]) {
    constexpr int KROW = KEL * 2 + 16, KC = KEL / 8, NKL = KC / 8, NKS = DQK / 16;
    const int r31 = lane & 31, hh = lane >> 5;
    const int qi = q0 + r31, jd = q0 >> 6;
    bf16x8 qf[NKS];
#pragma unroll
    for (int ks = 0; ks < NKS; ++ks) qf[ks] = *(const bf16x8*)(qrow + 16 * ks + 8 * hh);
#pragma unroll
    for (int dt = 0; dt < 4; ++dt)
#pragma unroll
        for (int r = 0; r < 16; ++r) o[dt][r] = 0.f;
    float mrun = 0.f, lsum = 0.f;
    int pq = 0; if (BIAS) pq = posb[qi];
    u32x4 kreg[NKL]; u32x4 vreg[2];
#define ATT_LOAD(j) do { _Pragma("unroll") for (int _i = 0; _i < NKL; ++_i) { const int _c = tid + 512 * _i, _row = _c / KC, _ch = _c % KC; \
            const bf16_t* _s = (KEL == 192 && _ch >= 16) ? (kB + (size_t)(64 * (j) + _row) * 64 + (_ch - 16) * 8) : (kA + (size_t)(64 * (j) + _row) * ldkA + _ch * 8); kreg[_i] = *(const u32x4*)_s; } \
        _Pragma("unroll") for (int _i = 0; _i < 2; ++_i) { const int _c = tid + 512 * _i, _d = _c >> 3, _ch = _c & 7; vreg[_i] = *(const u32x4*)(vT + (size_t)_d * T + 64 * (j) + _ch * 8); } } while (0)
#define ATT_WRITE(buf) do { _Pragma("unroll") for (int _i = 0; _i < NKL; ++_i) { const int _c = tid + 512 * _i, _row = _c / KC, _ch = _c % KC; *(LAS u32x4*)((buf) + _row * KROW + _ch * 16) = kreg[_i]; } \
        _Pragma("unroll") for (int _i = 0; _i < 2; ++_i) { const int _c = tid + 512 * _i, _d = _c >> 3, _ch = _c & 7; LAS u32x2* _p = (LAS u32x2*)((buf) + KBUF + _d * VROW + _ch * 16); \
            _p[0] = (u32x2){vreg[_i].x, vreg[_i].y}; _p[1] = (u32x2){vreg[_i].z, vreg[_i].w}; } } while (0)
    ATT_LOAD(0); ATT_WRITE(lds);
    __syncthreads();
    for (int j = 0; j < nj; ++j) {
        LAS unsigned char* cur = lds + (j & 1) * BUF;
        if (j + 1 < nj) ATT_LOAD(j + 1);
        if (j <= jd) {
            bool farb = false; float c0 = -mrun;
            if (BIAS) { farb = __all(pq - tmaxb[j] >= 128); if (farb) c0 += lut[128]; }
            f32x16 s0, s1;
#pragma unroll
            for (int r = 0; r < 16; ++r) { s0[r] = c0; s1[r] = c0; }
            const LAS unsigned char* kp = cur + r31 * KROW + koffB + hh * 16;
            {
                bf16x8 kf[3][2];
#define ATT_LDK(b, g) do { kf[b][0] = *(const LAS bf16x8*)(kp + (g) * 32); kf[b][1] = *(const LAS bf16x8*)(kp + 32 * KROW + (g) * 32); } while (0)
                ATT_LDK(0, 0); ATT_LDK(1, 1);
#pragma unroll
                for (int g = 0; g < NKS; ++g) {
                    if (g + 2 < NKS) ATT_LDK((g + 2) % 3, g + 2);
                    __builtin_amdgcn_sched_barrier(0);
                    s0 = MFMA32(kf[g % 3][0], qf[g], s0); s1 = MFMA32(kf[g % 3][1], qf[g], s1);
                    __builtin_amdgcn_sched_barrier(0);
                }
#undef ATT_LDK
            }
            if (BIAS && !farb) {
#pragma unroll
                for (int r = 0; r < 16; ++r) { const int kj = 64 * j + (r & 3) + 8 * (r >> 2) + 4 * hh;
                    int r0 = pq - posb[kj], r1 = pq - posb[kj + 32]; r0 = r0 < 0 ? 0 : (r0 > 128 ? 128 : r0); r1 = r1 < 0 ? 0 : (r1 > 128 ? 128 : r1);
                    s0[r] += lut[r0]; s1[r] += lut[r1]; }
            }
            if (j == jd) {
#pragma unroll
                for (int r = 0; r < 16; ++r) { const int kj = 64 * j + (r & 3) + 8 * (r >> 2) + 4 * hh;
                    if (kj > qi) s0[r] = -__builtin_inff(); if (kj + 32 > qi) s1[r] = -__builtin_inff(); }
            }
            float mx = fmaxf(fmaxf(s0[0], s0[1]), s0[2]);
#pragma unroll
            for (int r = 3; r < 15; r += 2) mx = fmaxf(fmaxf(mx, s0[r]), s0[r + 1]);
            mx = fmaxf(mx, s0[15]);
#pragma unroll
            for (int r = 0; r < 16; r += 2) mx = fmaxf(fmaxf(mx, s1[r]), s1[r + 1]);
            mx = max32(mx);
            if (j == 0 || !__all(mx <= 8.0f)) {
                if (j != 0) mx = fmaxf(mx, 0.f);
                const float alpha = __builtin_amdgcn_exp2f(-mx);
                mrun += mx; lsum *= alpha;
#pragma unroll
                for (int dt = 0; dt < 4; ++dt)
#pragma unroll
                    for (int r = 0; r < 16; ++r) o[dt][r] *= alpha;
#pragma unroll
                for (int r = 0; r < 16; ++r) { s0[r] -= mx; s1[r] -= mx; }
            }
            float ps0 = 0.f, ps1 = 0.f;
#pragma unroll
            for (int r = 0; r < 16; ++r) { s0[r] = __builtin_amdgcn_exp2f(s0[r]); s1[r] = __builtin_amdgcn_exp2f(s1[r]); ps0 += s0[r]; ps1 += s1[r]; }
            lsum += ps0 + ps1;
            bf16x8 pb[2][2];
            { u32x4 w;
              w.x = pk2(s0[0], s0[1]); w.y = pk2(s0[2], s0[3]); w.z = pk2(s0[4], s0[5]); w.w = pk2(s0[6], s0[7]); pb[0][0] = __builtin_bit_cast(bf16x8, w);
              w.x = pk2(s0[8], s0[9]); w.y = pk2(s0[10], s0[11]); w.z = pk2(s0[12], s0[13]); w.w = pk2(s0[14], s0[15]); pb[0][1] = __builtin_bit_cast(bf16x8, w);
              w.x = pk2(s1[0], s1[1]); w.y = pk2(s1[2], s1[3]); w.z = pk2(s1[4], s1[5]); w.w = pk2(s1[6], s1[7]); pb[1][0] = __builtin_bit_cast(bf16x8, w);
              w.x = pk2(s1[8], s1[9]); w.y = pk2(s1[10], s1[11]); w.z = pk2(s1[12], s1[13]); w.w = pk2(s1[14], s1[15]); pb[1][1] = __builtin_bit_cast(bf16x8, w); }
            const LAS unsigned char* vp = cur + KBUF + r31 * VROW + hh * 8;
            {
                u32x4 vf[3][2];
#define ATT_LDV(b, g) do { _Pragma("unroll") for (int _q = 0; _q < 2; ++_q) { const LAS unsigned char* _a = vp + ((g) >> 1) * 32 * VROW + (2 * ((g) & 1) + _q) * 32; \
                           const u32x2 _lo = *(const LAS u32x2*)_a, _hi = *(const LAS u32x2*)(_a + 16); vf[b][_q] = (u32x4){_lo.x, _lo.y, _hi.x, _hi.y}; } } while (0)
                ATT_LDV(0, 0); ATT_LDV(1, 1);
#pragma unroll
                for (int g = 0; g < 8; ++g) {
                    if (g + 2 < 8) ATT_LDV((g + 2) % 3, g + 2);
                    __builtin_amdgcn_sched_barrier(0);
#pragma unroll
                    for (int q = 0; q < 2; ++q) o[g >> 1] = MFMA32(__builtin_bit_cast(bf16x8, vf[g % 3][q]), pb[g & 1][q], o[g >> 1]);
                    __builtin_amdgcn_sched_barrier(0);
                }
#undef ATT_LDV
            }
        }
        if (j + 1 < nj) ATT_WRITE(lds + ((j + 1) & 1) * BUF);
        __syncthreads();
    }
#undef ATT_LOAD
#undef ATT_WRITE
    const float lt = sum32(lsum), il = 1.0f / lt;
#pragma unroll
    for (int dt = 0; dt < 4; ++dt)
#pragma unroll
        for (int r = 0; r < 16; ++r) o[dt][r] *= il;
}

__device__ __forceinline__ void attn_phase(Frame& F, int l) {
    frame_refresh(F);
    unsigned char* ws = F.ws; LAS unsigned char* lds = F.lds;
    const bf16_t *qm = (const bf16_t*)(ws + WS_QM), *kn = (const bf16_t*)(ws + WS_KN), *kr = (const bf16_t*)(ws + WS_KR), *vmT = (const bf16_t*)(ws + WS_VMT);
    const bf16_t *dq = (const bf16_t*)(ws + WS_DQ), *dk = (const bf16_t*)(ws + WS_DK), *dvT = (const bf16_t*)(ws + WS_DVT);
    bf16_t* mix = (bf16_t*)(ws + WS_MIX);
    const int* pos = (const int*)inptr(F, IN_POS); const int* tmax = (const int*)(ws + WS_TMAX);
    LAS float* lut = (LAS float*)(lds + LUT_OFF);
    for (int i = F.tid; i < 6 * 132; i += NTHR) lut[i] = ((const float*)(ws + WS_LUT))[i];
    LAS int* tmaxl = (LAS int*)(lds + TMAX_OFF); LAS int* posl = (LAS int*)(lds + POS_OFF);
    if (F.tid < NB * 32) tmaxl[F.tid] = tmax[F.tid];
    for (int i = F.tid; i < T; i += NTHR) posl[i] = pos[i];
    float lam, lam_init;
    { const float* lv = inptr(F, IN_LAMBDA) + l * 256;
      const float d1 = wave_sum(lv[F.lane] * lv[64 + F.lane]), d2 = wave_sum(lv[128 + F.lane] * lv[192 + F.lane]);
      lam_init = 0.8f - 0.6f * expf(-0.3f * (float)l);
      lam = __builtin_bit_cast(float, __builtin_amdgcn_readfirstlane(__builtin_bit_cast(int, expf(d1) - expf(d2) + lam_init))); }
    __syncthreads();
    for (int uu = 0; uu < ATT_MAXU * ((256 + F.G - 1) / F.G); ++uu) {
        const int srow = F.bx + (uu / ATT_MAXU) * F.G, ui = uu % ATT_MAXU;
        if (srow >= 256) break;
        const int uid = (int)att_sched[srow][ui];
        if (uid == 0xFFFF) continue;
        frame_refresh(F);
        const int kind = uid >> 10, bh = (uid >> 4) & 63, qb = uid & 15, b = bh / 6, hd = bh % 6;
        const int r31 = F.lane & 31, hh = F.lane >> 5;
        f32x16 o[4];
        if (kind == 0) {
            const int q0 = 256 * qb + 32 * F.wave, t = b * S + q0 + r31;
            attn_core<192, 192, false>(lds, F.tid, F.lane, qm + (size_t)t * 1152 + hd * 192, kn + (size_t)b * S * 768 + hd * 128, 768, kr + (size_t)b * S * 64,
                                       vmT + (size_t)hd * 128 * T + b * S, q0, 4 * qb + 4, 0, nullptr, nullptr, nullptr, o);
            bf16_t* orow = mix + (size_t)t * D + 512 + hd * 128 + 4 * hh;
#pragma unroll
            for (int dt = 0; dt < 4; ++dt)
#pragma unroll
                for (int g = 0; g < 4; ++g) { u32x2 w; w.x = pk2(o[dt][4 * g], o[dt][4 * g + 1]); w.y = pk2(o[dt][4 * g + 2], o[dt][4 * g + 3]); *(u32x2*)(orow + 32 * dt + 8 * g) = w; }
        } else {
            const int map = F.wave >> 2, rg = F.wave & 3, q0 = 128 * qb + 32 * rg, t = b * S + q0 + r31;
            attn_core<64, 128, true>(lds, F.tid, F.lane, dq + (size_t)t * 768 + hd * 128 + 64 * map, dk + (size_t)b * S * 768 + hd * 128, 768, nullptr,
                                     dvT + (size_t)hd * 128 * T + b * S, q0, 2 * qb + 2, 128 * map, posl + b * S, tmaxl + b * 32, lut + hd * 132, o);
            LAS float* xch = (LAS float*)lds + (size_t)rg * 4096 + F.lane;
            if (map == 1) {
#pragma unroll
                for (int dt = 0; dt < 4; ++dt)
#pragma unroll
                    for (int r = 0; r < 16; ++r) xch[(dt * 16 + r) * 64] = o[dt][r] * lam; }
            __syncthreads();
            if (map == 0) {
                float ss = 0.f;
#pragma unroll
                for (int dt = 0; dt < 4; ++dt)
#pragma unroll
                    for (int r = 0; r < 16; ++r) { o[dt][r] -= xch[(dt * 16 + r) * 64]; ss += o[dt][r] * o[dt][r]; }
                ss = sum32(ss);
                const float rr = (1.0f - lam_init) / sqrtf(ss * (1.0f / 128.0f) + EPS);
                const float* sub = inptr(F, IN_SUBLN) + l * 128 + 4 * hh;
                bf16_t* orow = mix + (size_t)t * D + 1280 + hd * 128 + 4 * hh;
                f32x4 sgv[16];
#pragma unroll
                for (int i = 0; i < 16; ++i) sgv[i] = *(const f32x4*)(sub + 32 * (i >> 2) + 8 * (i & 3));
                asm volatile("" ::: "memory");
#pragma unroll
                for (int dt = 0; dt < 4; ++dt)
#pragma unroll
                    for (int g = 0; g < 4; ++g) { const f32x4 sg = sgv[dt * 4 + g]; u32x2 w;
                        w.x = pk2(o[dt][4 * g] * rr * sg[0], o[dt][4 * g + 1] * rr * sg[1]); w.y = pk2(o[dt][4 * g + 2] * rr * sg[2], o[dt][4 * g + 3] * rr * sg[3]); *(u32x2*)(orow + 32 * dt + 8 * g) = w; }
            }
            __syncthreads();
        }
    }
}
}

struct SchedOut {
    int G, c, l; unsigned char* ws;
    __device__ __forceinline__ bool next(int i, pg8::Unit& U) const {
        const int L = i * G + c; if (L >= 256) return false;
        const char* mix = (const char*)(ws + WS_MIX); const char* wout = (const char*)(ws + WS_WOUT + (size_t)l * SZ_WOUT);
        int pm, pn; pg8::tile_of(L, 32, 8, pm, pn);
        U.a = mix + (size_t)pm * 256 * D * 2; U.b = wout + (size_t)pn * 256 * D * 2; U.rowmap = nullptr; U.nrows = 256; U.p0 = 0; U.p1 = 256 * pm; U.p2 = 256 * pn; U.p3 = 0; return true;
    }
};
struct EpiOut {
    static constexpr bool PERM = true;
    unsigned char* ws;
    __device__ __forceinline__ void operator()(const f32x4 (&acc)[2][2][4][2], const pg8::Unit& U, int wr, int wc, int fr, int fq) const {
        const int row0 = U.p1 + wr * 64 + fr, col0 = U.p2 + wc * 32 + 8 * fq; const bf16_t* h = (const bf16_t*)(ws + WS_H); bf16_t* h2 = (bf16_t*)(ws + WS_H2);
        u32x4 hv[2][4][2];
#pragma unroll
        for (int ai = 0; ai < 2; ++ai)
#pragma unroll
            for (int m = 0; m < 4; ++m)
#pragma unroll
                for (int bj = 0; bj < 2; ++bj) hv[ai][m][bj] = *(const u32x4*)(h + (size_t)(row0 + ai * 128 + m * 16) * D + col0 + bj * 128);
        asm volatile("" ::: "memory");
#pragma unroll
        for (int ai = 0; ai < 2; ++ai)
#pragma unroll
            for (int m = 0; m < 4; ++m) { const size_t ro = (size_t)(row0 + ai * 128 + m * 16) * D + col0;
#pragma unroll
                for (int bj = 0; bj < 2; ++bj) { const u32x4 hw = hv[ai][m][bj];
                    const f32x4 v0 = unpk4((u32x2){hw.x, hw.y}) + acc[ai][bj][m][0], v1 = unpk4((u32x2){hw.z, hw.w}) + acc[ai][bj][m][1];
                    u32x4 w; w.x = pk2(v0[0], v0[1]); w.y = pk2(v0[2], v0[3]); w.z = pk2(v1[0], v1[1]); w.w = pk2(v1[2], v1[3]); *(u32x4*)(h2 + ro + bj * 128) = w; }
                asm volatile("" ::: "memory"); }
    }
};

__device__ __forceinline__ void router_phase(Frame& F, int l) {
    frame_refresh(F);
    unsigned char* ws = F.ws; LAS unsigned char* lds = F.lds;
    const bf16_t* h = (const bf16_t*)(ws + WS_H2); bf16_t* xn = (bf16_t*)(ws + WS_XB);
    const float* gain = inptr(F, IN_FFN_NORM) + l * D;

    const float* bg = inptr(F, IN_RG_B) + l * 4; const float* be = inptr(F, IN_RE_B) + l * 32;
    unsigned* cnt = F.ctl + CW_CNT + 2048 * l; int* list = (int*)(ws + WS_LIST); float* gwt = (float*)(ws + WS_GW);
    const int lane = F.lane, w = F.wave, r31 = lane & 31, hh = lane >> 5;
    LAS float* part = (LAS float*)lds;
    LAS float* ssqp = (LAS float*)(lds + 65536);
    LAS float* rsv = (LAS float*)(lds + 65536 + 2048);
    LAS float* lg = (LAS float*)(lds + 65536 + 4096);
    for (int tile = F.bx; tile < T / 32; tile += F.G) {
        const int t0 = tile * 32;
        { const bf16_t* xrow = h + (size_t)(t0 + r31) * D + 256 * w + 8 * hh;
          const unsigned char* wb = ws + WS_WRH + ((size_t)l * 8 + w) * 65536; const unsigned lo16 = (unsigned)lane * 16u;
          f32x16 a0, a1; float ssq = 0.f;
#pragma unroll
          for (int r = 0; r < 16; ++r) { a0[r] = 0.f; a1[r] = 0.f; }
#pragma unroll
          for (int kc = 0; kc < 16; kc += 4) {
              bf16x8 wh0[4], wh1[4], wl0[4], wl1[4]; u32x4 xw[16];
#pragma unroll
              for (int q = 0; q < 4; ++q) xw[kc + q] = *(const u32x4*)(xrow + 16 * (kc + q));
#pragma unroll
              for (int q = 0; q < 4; ++q) { GAS const unsigned char* wq_ = (GAS const unsigned char*)wb + (kc + q) * 4096; asm volatile("" : "+s"(wq_)); const unsigned char* wq = (const unsigned char*)wq_;
                  wh0[q] = *(const bf16x8*)(wq + lo16); wh1[q] = *(const bf16x8*)(wq + 1024 + lo16); wl0[q] = *(const bf16x8*)(wq + 2048 + lo16); wl1[q] = *(const bf16x8*)(wq + 3072 + lo16); }
              asm volatile("" ::: "memory");
#pragma unroll
              for (int q = 0; q < 4; ++q) { const u32x4 xv = xw[kc + q];
                  const f32x4 xa = unpk4((u32x2){xv.x, xv.y}), xb = unpk4((u32x2){xv.z, xv.w});
                  ssq += (xa[0] * xa[0] + xa[1] * xa[1]) + (xa[2] * xa[2] + xa[3] * xa[3]) + (xb[0] * xb[0] + xb[1] * xb[1]) + (xb[2] * xb[2] + xb[3] * xb[3]);
                  const bf16x8 xh = __builtin_bit_cast(bf16x8, xv);
                  a0 = MFMA32(xh, wh0[q], a0); a0 = MFMA32(xh, wl0[q], a0);
                  a1 = MFMA32(xh, wh1[q], a1); a1 = MFMA32(xh, wl1[q], a1); } }
          __syncthreads();
#pragma unroll
          for (int r = 0; r < 16; ++r) { const int tk = (r & 3) + 8 * (r >> 2) + 4 * hh; part[(w * 32 + tk) * 64 + r31] = a0[r]; part[(w * 32 + tk) * 64 + 32 + r31] = a1[r]; }
          ssqp[(w * 2 + hh) * 32 + r31] = ssq; }
        __syncthreads();
        if (F.tid < 32) { float s = 0.f;
#pragma unroll
            for (int q = 0; q < 16; ++q) s += ssqp[q * 32 + F.tid];
            rsv[F.tid] = 1.0f / sqrtf(s * (1.0f / D) + EPS); }
        __syncthreads();
        for (int idx = F.tid; idx < 32 * 36; idx += NTHR) { const int tk = idx / 36, c = idx - tk * 36; float s = 0.f;
#pragma unroll
            for (int q = 0; q < 8; ++q) s += part[(q * 32 + tk) * 64 + c];
            lg[tk * 40 + c] = s * rsv[tk] + (c < 4 ? bg[c] : be[c - 4]); }
        { f32x4 gg[8]; u32x2 xv[4][8];
#pragma unroll
          for (int j = 0; j < 8; ++j) gg[j] = ((const f32x4*)gain)[lane + 64 * j];
#pragma unroll
          for (int q = 0; q < 4; ++q) { const u32x2* xr = (const u32x2*)(h + (size_t)(t0 + 4 * w + q) * D) + lane;
#pragma unroll
              for (int j = 0; j < 8; ++j) xv[q][j] = xr[64 * j]; }
          asm volatile("" ::: "memory");
#pragma unroll
          for (int q = 0; q < 4; ++q) { const int t = t0 + 4 * w + q; const float rs = rsv[4 * w + q]; u32x2* o = (u32x2*)(xn + (size_t)t * D) + lane;
#pragma unroll
              for (int j = 0; j < 8; ++j) { const f32x4 v = unpk4(xv[q][j]) * rs * gg[j]; u32x2 wv; wv.x = pk2(v[0], v[1]); wv.y = pk2(v[2], v[3]); o[64 * j] = wv; } } }
        __syncthreads();
        if (F.tid < 32) { const int t = t0 + F.tid; const LAS float* L = lg + F.tid * 40;
            int gi = 0; float gm = L[0];
            for (int c = 1; c < 4; ++c) { const float v = L[c]; if (v > gm) { gm = v; gi = c; } }
            float gs = 0.f; for (int c = 0; c < 4; ++c) gs += expf(L[c] - gm);
            const float ggate = 1.0f / gs; const LAS float* E8 = L + 4 + 8 * gi;
            int i0 = 0; float m0 = E8[0];
            for (int q = 1; q < 8; ++q) { const float v = E8[q]; if (v > m0) { m0 = v; i0 = q; } }
            int i1 = -1; float m1 = -__builtin_inff();
            for (int q = 0; q < 8; ++q) { const float v = E8[q]; if (q != i0 && v > m1) { m1 = v; i1 = q; } }
            const float p0 = 1.0f / (1.0f + expf(m1 - m0)), p1 = 1.0f - p0;
            const int e0 = gi * 8 + i0, e1 = gi * 8 + i1;
            LAS unsigned* lcnt = (LAS unsigned*)(lds + 65536 + 4096 + 5120); LAS unsigned* lbase = lcnt + 32;
            lcnt[F.tid] = 0u; LDS_WAIT();
            const unsigned r0 = __hip_atomic_fetch_add(lcnt + e0, 1u, __ATOMIC_RELAXED, __HIP_MEMORY_SCOPE_WORKGROUP);
            const unsigned r1 = __hip_atomic_fetch_add(lcnt + e1, 1u, __ATOMIC_RELAXED, __HIP_MEMORY_SCOPE_WORKGROUP);
            LDS_WAIT();
            { const unsigned n = lcnt[F.tid]; unsigned bs = 0u; if (n) bs = atomicAdd(cnt + 64 * F.tid, n); lbase[F.tid] = bs; }
            LDS_WAIT();
            const unsigned slot0 = lbase[e0] + r0, slot1 = lbase[e1] + r1;
            list[e0 * LISTCAP + slot0] = t * 2; list[e1 * LISTCAP + slot1] = t * 2 + 1;
            *(f32x2*)(gwt + t * 2) = (f32x2){ggate * p0, ggate * p1}; }
    }
    __syncthreads();
}

__device__ __forceinline__ void moe_tables(Frame& F, int l) {
    frame_refresh(F);
    __syncthreads();
    if (F.tid < NE) F.MISC[112 + F.tid] = (F.ctl + CW_CNT + 2048 * l)[64 * F.tid];
    __syncthreads();
    if (F.tid < NE) { const LAS unsigned* C = (const LAS unsigned*)F.MISC + 112; const int e = F.tid;
        const int c = (int)C[e], nfull = c >> 8, part = c & 255;
        int fpre = 0, spre = 0, ftot = 0, ptot = 0, rank = 0;
#pragma unroll 8
        for (int q = 0; q < NE; ++q) { const int cq = (int)C[q], fq = cq >> 8, pq = cq & 255;
            ftot += fq; ptot += (pq != 0); if (q < e) { fpre += fq; spre += cq; }
            rank += (pq > part || (pq == part && q < e)) ? 1 : 0; }
        for (int mt = 0; mt < nfull; ++mt) F.MISC[256 + fpre + mt] = (unsigned)(e | (mt << 8));
        if (part != 0) F.MISC[256 + ftot + rank] = (unsigned)(e | (nfull << 8));
        F.MISC[64 + e] = (unsigned)spre;
        if (e == 0) F.MISC[16 + NE] = (unsigned)(ftot + ptot); }
    __syncthreads();
}
__device__ __forceinline__ int moe_rank4(int c, int G) { if (G % 32 != 0 || c < 0) return c; const int x = c & 7, r = c >> 3; return (((G >> 5) * x + (r >> 2)) << 2) | (r & 3); }
__device__ __forceinline__ int moe_rank8(int c, int G) { if (G % 64 != 0 || c < 0) return c; const int x = c & 7, r = c >> 3; return (((G >> 6) * x + (r >> 3)) << 3) | (r & 7); }
struct SchedMoE {
    int G, c, l; bool down; volatile LAS unsigned* M; unsigned char* ws; int Lb, Le;
    __device__ __forceinline__ bool next(int i, pg8::Unit& U) const {
        const int L = Lb + i * G + c;
        if (c < 0 || L >= Le) return false;
        return make(L, U);
    }
    __device__ __forceinline__ bool make(int L, pg8::Unit& U) const {
        const int ntn = down ? 8 : 4; const char* abase = (const char*)(ws + (down ? WS_ACT : WS_XB));
        const char* wbase = (const char*)(ws + (down ? WS_WD + (size_t)l * NE * SZ_WD1 : WS_WGU + (size_t)l * NE * SZ_WGU1));
        const size_t wstride = down ? SZ_WD1 : SZ_WGU1, tstride = down ? (size_t)256 * EH * 2 : (size_t)256 * D * 2; const int* list = (const int*)(ws + WS_LIST);
        const int TR = (int)M[16 + NE]; const int rt = L / ntn, nt = L - rt * ntn;
        if (rt >= TR) return false;
        const int ent = __builtin_amdgcn_readfirstlane((int)M[256 + rt]), e = ent & 255, mt = ent >> 8;
        const int cnt = (int)M[112 + e], slot0 = (int)M[64 + e] + 256 * mt; int nv = cnt - 256 * mt; nv = nv > 256 ? 256 : nv;
        U.nrows = __builtin_amdgcn_readfirstlane(nv); U.p0 = rt; U.p1 = U.nrows; U.p3 = nt;
        U.b = wbase + (size_t)e * wstride + (size_t)nt * tstride;
        if (down) { U.a = abase + (size_t)__builtin_amdgcn_readfirstlane(slot0) * EH * 2; U.rowmap = nullptr; U.p2 = e * LISTCAP + 256 * mt; }
        else { U.a = abase; U.rowmap = list + e * LISTCAP + 256 * mt; U.p2 = __builtin_amdgcn_readfirstlane(slot0); }
        return true;
    }
};
struct EpiGU {
    static constexpr bool PERM = true;
    unsigned char* ws; int l;
    __device__ __forceinline__ void operator()(const f32x4 (&acc)[2][2][4][2], const pg8::Unit& U, int wr, int wc, int fr, int fq) const {
        const int nv = U.p1, slot0 = U.p2, nt = U.p3; bf16_t* act = (bf16_t*)(ws + WS_ACT);
#pragma unroll
        for (int ai = 0; ai < 2; ++ai)
#pragma unroll
            for (int m = 0; m < 4; ++m) { const int r = ai * 128 + wr * 64 + m * 16 + fr;
                if (r < nv) { float o[8];
#pragma unroll
                    for (int n = 0; n < 2; ++n)
#pragma unroll
                        for (int e = 0; e < 4; ++e) { const float gt = acc[ai][0][m][n][e], up = acc[ai][1][m][n][e]; o[4 * n + e] = gt * up * __builtin_amdgcn_rcpf(1.0f + __builtin_amdgcn_exp2f(-gt * LOG2E)); }
                    const unsigned long long w0 = (unsigned long long)pk2(o[0], o[1]) | ((unsigned long long)pk2(o[2], o[3]) << 32), w1 = (unsigned long long)pk2(o[4], o[5]) | ((unsigned long long)pk2(o[6], o[7]) << 32);
                    GAS unsigned long long* dp = (GAS unsigned long long*)(act + (size_t)(slot0 + r) * EH + nt * 128 + wc * 32 + 8 * fq);
                    __hip_atomic_store(dp, w0, __ATOMIC_RELAXED, __HIP_MEMORY_SCOPE_AGENT); __hip_atomic_store(dp + 1, w1, __ATOMIC_RELAXED, __HIP_MEMORY_SCOPE_AGENT); } }
        asm volatile("s_waitcnt vmcnt(0)" ::: "memory");
        if ((fr | fq) == 0) { GAS unsigned* rdy = (GAS unsigned*)(ws + WS_CTL) + CW_RDY + 8192 * l + 64 * U.p0; __hip_atomic_fetch_add(rdy, 1u, __ATOMIC_RELAXED, __HIP_MEMORY_SCOPE_AGENT); }
    }
};
struct SchedDown2 {
    SchedMoE B; int ind, rem, nd;
    __device__ __forceinline__ bool next(int i, pg8::Unit& U) const {
        const int G = B.G, c = B.c, N1 = G - rem; int Lu;
        if (c >= rem) { const int j = c - rem, nind = (j < ind) ? (ind - j + N1 - 1) / N1 : 0;
            if (i < nind) Lu = j + i * N1;
            else { const int d = (rem + (N1 - 1 - j)) + (i - nind) * G; if (d >= nd - ind) return false; Lu = ind + d; } }
        else { const int d = c + i * G; if (d >= nd - ind) return false; Lu = ind + d; }
        return B.make(Lu, U);
    }
    __device__ __forceinline__ void a_ready(const pg8::Unit& U) const {
        if (__builtin_amdgcn_readfirstlane((int)(threadIdx.x >> 6)) == 0) {
            GAS unsigned* ctl = (GAS unsigned*)(B.ws + WS_CTL); GAS unsigned* rdy = ctl + CW_RDY + 8192 * B.l + 64 * U.p0; unsigned sp = 0u;
            while ((unsigned)__builtin_amdgcn_readfirstlane((int)__hip_atomic_load(rdy, __ATOMIC_RELAXED, __HIP_MEMORY_SCOPE_AGENT)) < 32u) {
                __builtin_amdgcn_s_sleep(2);
                if ((++sp & 255u) == 0u) { if (__hip_atomic_load(ctl + CW_TMO, __ATOMIC_RELAXED, __HIP_MEMORY_SCOPE_AGENT) != 0u) break;
                    if (sp > (1u << 18)) { __hip_atomic_store(ctl + CW_TMO, 1u, __ATOMIC_RELAXED, __HIP_MEMORY_SCOPE_AGENT); break; } } }
            __builtin_amdgcn_fence(__ATOMIC_ACQUIRE, "agent");
            asm volatile("s_waitcnt vmcnt(0)" ::: "memory");
        }
        asm volatile("" ::: "memory"); __builtin_amdgcn_s_barrier(); asm volatile("" ::: "memory");
    }
};
struct EpiDown {
    static constexpr bool PERM = true;
    unsigned char* ws;
    __device__ __forceinline__ void operator()(const f32x4 (&acc)[2][2][4][2], const pg8::Unit& U, int wr, int wc, int fr, int fq) const {
        const int nv = U.p1, lbase = U.p2, col0 = U.p3 * 256 + wc * 32 + 8 * fq;
        bf16_t *y1 = (bf16_t*)(ws + WS_Y1), *y2 = (bf16_t*)(ws + WS_Y2); const int* list = (const int*)(ws + WS_LIST); const float* gwt = (const float*)(ws + WS_GW);
        int ent[8]; float g[8];
#pragma unroll
        for (int i = 0; i < 8; ++i) { const int r = (i >> 2) * 128 + wr * 64 + (i & 3) * 16 + fr; ent[i] = list[lbase + (r < nv ? r : 0)]; }
#pragma unroll
        for (int i = 0; i < 8; ++i) g[i] = gwt[ent[i]];
#pragma unroll
        for (int i = 0; i < 8; ++i) asm volatile("" : "+v"(g[i]), "+v"(ent[i]));
        asm volatile("" ::: "memory");
#pragma unroll
        for (int ai = 0; ai < 2; ++ai)
#pragma unroll
            for (int m = 0; m < 4; ++m) { const int e1 = ent[ai * 4 + m]; const float gg = g[ai * 4 + m];
                if (ai * 128 + wr * 64 + m * 16 + fr < nv) { const int tok = e1 >> 1;
                    bf16_t* rowp = ((e1 & 1) ? y2 : y1) + (size_t)tok * D + col0;
#pragma unroll
                    for (int bj = 0; bj < 2; ++bj) { const f32x4 v0 = acc[ai][bj][m][0] * gg, v1 = acc[ai][bj][m][1] * gg;
                        u32x4 w; w.x = pk2(v0[0], v0[1]); w.y = pk2(v0[2], v0[3]); w.z = pk2(v1[0], v1[1]); w.w = pk2(v1[2], v1[3]); *(u32x4*)(rowp + bj * 128) = w; } }
                asm volatile("" ::: "memory"); }
    }
};

__device__ __forceinline__ void combine_phase(Frame& F, float* outp, int l) {
    frame_refresh(F);
    unsigned char* ws = F.ws; bf16_t* h = (bf16_t*)(ws + WS_H); const bf16_t* h2 = (const bf16_t*)(ws + WS_H2); const bf16_t* y1 = (const bf16_t*)(ws + WS_Y1); const bf16_t* y2 = (const bf16_t*)(ws + WS_Y2); bf16_t* u = (bf16_t*)(ws + WS_XB);
    const bool lastl = (l == NL - 1); const float* gain = lastl ? inptr(F, IN_FINAL_NORM) : inptr(F, IN_ATTN_NORM) + (l + 1) * D;
    const int gw = F.vcu * NWAVES + F.wave, NGW = F.G * NWAVES, lane = F.lane;
    f32x4 gg[8];
#pragma unroll
    for (int j = 0; j < 8; ++j) gg[j] = ((const f32x4*)gain)[lane + 64 * j];
#define CMB_LOAD(A, B, C, mm) do { const u32x2* h2r_ = (const u32x2*)(h2 + (size_t)(mm) * D) + lane; const u32x2* y1r_ = (const u32x2*)(y1 + (size_t)(mm) * D) + lane; const u32x2* y2r_ = (const u32x2*)(y2 + (size_t)(mm) * D) + lane; \
        _Pragma("unroll") for (int j = 0; j < 8; ++j) { A[j] = h2r_[64 * j]; B[j] = y1r_[64 * j]; C[j] = y2r_[64 * j]; } } while (0)
#define CMB_ROW(A, B, C, mm) do { f32x4 v[8]; float s = 0.f; \
        _Pragma("unroll") for (int j = 0; j < 8; ++j) { v[j] = unpk4(A[j]) + (unpk4(B[j]) + unpk4(C[j])); s += (v[j][0] * v[j][0] + v[j][1] * v[j][1]) + (v[j][2] * v[j][2] + v[j][3] * v[j][3]); } \
        const float rs = 1.0f / sqrtf(wave_sum(s) * (1.0f / D) + EPS); \
        if (lastl) { f32x4* o = (f32x4*)(outp + (size_t)(mm) * D) + lane; \
            _Pragma("unroll") for (int j = 0; j < 8; ++j) o[64 * j] = v[j] * rs * gg[j]; } \
        else { u32x2* hr = (u32x2*)(h + (size_t)(mm) * D) + lane; u32x2* o = (u32x2*)(u + (size_t)(mm) * D) + lane; \
            _Pragma("unroll") for (int j = 0; j < 8; ++j) { { u32x2 hw; hw.x = pk2(v[j][0], v[j][1]); hw.y = pk2(v[j][2], v[j][3]); hr[64 * j] = hw; } \
                u32x2 w; w.x = pk2(v[j][0] * rs * gg[j][0], v[j][1] * rs * gg[j][1]); w.y = pk2(v[j][2] * rs * gg[j][2], v[j][3] * rs * gg[j][3]); o[64 * j] = w; } } } while (0)
    for (int m = gw; m < T; m += 2 * NGW) {
        const int m1 = m + NGW; const bool has1 = m1 < T;
        u32x2 A0[8], B0[8], C0[8], A1[8], B1[8], C1[8];
        CMB_LOAD(A0, B0, C0, m); CMB_LOAD(A1, B1, C1, has1 ? m1 : m);
        asm volatile("" ::: "memory");
        CMB_ROW(A0, B0, C0, m);
        if (has1) CMB_ROW(A1, B1, C1, m1);
    }
#undef CMB_LOAD
#undef CMB_ROW
}

__global__ void __launch_bounds__(NTHR, 2) hymba_fwd(Args args) {
    extern __shared__ __attribute__((aligned(16))) unsigned char lds_raw[];
    Frame F;
    F.lds = (LAS unsigned char*)lds_raw; F.MISC = (volatile LAS unsigned*)(F.lds + LDS_MISC);
    F.tid = threadIdx.x; F.lane = F.tid & 63; F.wave = __builtin_amdgcn_readfirstlane(F.tid >> 6);
    F.G = gridDim.x; F.bx = blockIdx.x; F.vcu = (F.G % 8 == 0) ? (F.bx % 8) * (F.G / 8) + F.bx / 8 : F.bx;
    F.ws = args.ws; F.ws0 = args.ws; F.ctl = (unsigned*)(args.ws + WS_CTL);
    unsigned char* ws = args.ws;
    for (int i = F.tid; i < 192; i += NTHR) F.MISC[i] = 0u;
    if (F.tid < 46) F.MISC[MISC_PTAB + F.tid] = ((const __attribute__((address_space(4))) unsigned*)__builtin_amdgcn_kernarg_segment_ptr())[F.tid];
    float* const outp = args.out; const int use_bar = args.use_bar;
    __syncthreads();
    XcdBarrier bar; bar.bar = F.ctl + CW_BAR; bar.x = 0; bar.st = F.MISC;
    if (use_bar) bar = xcd_barrier_post(F.ctl + CW_BAR, F.MISC);
    const int lo = args.g_lo, hi = args.g_hi;
#define IN(k) (lo <= (k) && (k) < hi)
#define GRIDBAR() do { if (use_bar) { XcdBarrier bb_ = bar; GAS unsigned* bp_ = (GAS unsigned*)bar.bar; asm volatile("" : "+s"(bp_), "+s"(bb_.x)); bb_.bar = (unsigned*)bp_; xcd_barrier(bb_); } } while (0)
#define SEAM(k) do { if (IN((k) + 1)) GRIDBAR(); } while (0)
#define PHASE_LOCALS() frame_refresh(F); int bxo = F.bx, Go = F.G; GAS unsigned char* wsg_ = (GAS unsigned char*)ws; asm volatile("" : "+s"(bxo), "+s"(Go), "+s"(wsg_)); unsigned char* wso = (unsigned char*)wsg_

    if (IN(0)) { for (int rep_ = 0; rep_ < DUPN(0); ++rep_) { if (rep_) GRIDBAR(); p0_prologue(F); } SEAM(0); }

    for (int l = 0; l < NL; ++l) {
        const int g0 = 1 + 9 * l;
        if (lo >= g0 + 9 || hi <= g0) continue;
        if (IN(g0)) for (int rep_ = 0; rep_ < DUPN(1); ++rep_) {
            if (rep_) GRIDBAR();
            PHASE_LOCALS();
            const pg8::Gemm g{D, D, D};
            const SchedP1 Sc{Go, bxo, l, wso};
            const EpiP1 E{wso};
            pg8::gemm_phase<EpiP1, SchedP1, false>(F.lds, g, Sc, E);
            if (rep_ == DUPN(1) - 1) SEAM(g0);
        }
        if (IN(g0 + 1)) for (int rep_ = 0; rep_ < DUPN(2); ++rep_) {
            if (rep_) GRIDBAR();
            { PHASE_LOCALS(); const pg8::Gemm g{512, 512, 512};
              const SchedQ Sc{Go, bxo, l, wso};
              const EpiQ E{wso};
              pg8::gemm_phase<EpiQ, SchedQ, false>(F.lds, g, Sc, E); }
            { PHASE_LOCALS(); const pg8::Gemm g{256, 256, 256};
              const SchedKV Sc{Go == 256 ? 96 : Go, Go == 256 ? bxo - 160 : bxo, l, wso};
              const EpiKV E{wso};
              pg8::gemm_phase<EpiKV, SchedKV, false>(F.lds, g, Sc, E); }
            pool_stencil(F);
            if (rep_ == DUPN(2) - 1) SEAM(g0 + 1);
        }
        if (IN(g0 + 2)) { for (int rep_ = 0; rep_ < DUPN(3); ++rep_) { if (rep_) GRIDBAR(); att::attn_phase(F, l); } SEAM(g0 + 2); }
        if (IN(g0 + 3)) for (int rep_ = 0; rep_ < DUPN(4); ++rep_) {
            if (rep_) GRIDBAR();
            PHASE_LOCALS();
            const pg8::Gemm g{D, D, D};
            const SchedOut Sc{Go, bxo, l, wso};
            const EpiOut E{wso};
            pg8::gemm_phase<EpiOut, SchedOut, false>(F.lds, g, Sc, E);
            if (rep_ == DUPN(4) - 1) SEAM(g0 + 3);
        }
        if (IN(g0 + 4)) { for (int rep_ = 0; rep_ < DUPN(5); ++rep_) {
                if (rep_) { GRIDBAR(); if (F.bx == 0 && F.tid < NE) F.ctl[CW_CNT + 2048 * l + 64 * F.tid] = 0u; GRIDBAR(); }
                router_phase(F, l); }
            SEAM(g0 + 4); }
        if (IN(g0 + 5)) {
            moe_tables(F, l);
            { PHASE_LOCALS();
              const int U6 = (int)F.MISC[16 + NE] * 4;
              const pg8::Gemm g{D, D, D};
              const SchedMoE Sc{Go, moe_rank4(bxo, Go), l, false, F.MISC, wso, 0, U6};
              const EpiGU E{wso, l};
              pg8::gemm_phase<EpiGU, SchedMoE, true>(F.lds, g, Sc, E); }
            { PHASE_LOCALS();
              const int TR = (int)F.MISC[16 + NE], U6 = TR * 4, ND = TR * 8;
              const bool fast = (U6 >= Go && U6 - Go <= Go / 2 && Go % 4 == 0);
              const pg8::Gemm g{EH, EH, EH};
              const SchedDown2 Sc{SchedMoE{Go, moe_rank4(bxo, Go), l, true, F.MISC, wso, 0, 0x7fffffff}, fast ? 2 * Go : 0, fast ? U6 - Go : Go, ND};
              const EpiDown E{wso};
              pg8::gemm_phase<EpiDown, SchedDown2, false, true>(F.lds, g, Sc, E); }
            SEAM(g0 + 5);
        }
        if (IN(g0 + 8)) { for (int rep_ = 0; rep_ < DUPN(8); ++rep_) { if (rep_) GRIDBAR(); combine_phase(F, outp, l); } SEAM(g0 + 8); }
    }
}


#ifndef DBG_CHECK
#define DBG_CHECK 0
#endif
#if DBG_CHECK
constexpr int CW_CHK = 20000;
__device__ inline double dbf(const bf16_t* p, size_t i) { return (double)bf2f(p[i]); }
__device__ inline unsigned hsh(unsigned x) { x ^= x >> 16; x *= 0x7feb352du; x ^= x >> 15; x *= 0x846ca68bu; x ^= x >> 16; return x; }
__device__ inline bool bad(double got, double ref, double scale) { const double e = fabs(got - ref); return !(e <= 0.03 * fabs(ref) + 0.03 * scale); }
__global__ void dbg_check(Args A, int which) {
    unsigned char* ws = A.ws; unsigned* chk = (unsigned*)(ws + WS_CTL) + CW_CHK;
    const int sid = blockIdx.x * blockDim.x + threadIdx.x; const unsigned r0 = hsh(sid * 2654435761u + which * 97u + 12345u), r1 = hsh(r0 + 1u), r2 = hsh(r1 + 7u);
    const float* x = A.in[IN_X]; const int* pos = (const int*)A.in[IN_POS];
    const bf16_t* u = (const bf16_t*)(ws + WS_XB); const float* win = A.in[IN_W_IN];
    double* dscr = (double*)(ws + WS_END) + (size_t)sid * 512;
    const int t = r0 % T; bool b = false; int code = which;
    if (which == 0) {
        const int k = r1 % D; double ss = 0; for (int i = 0; i < D; ++i) ss += (double)x[(size_t)t * D + i] * x[(size_t)t * D + i];
        const double ref = x[(size_t)t * D + k] / sqrt(ss / D + 1e-6) * A.in[IN_ATTN_NORM][k]; b = bad(dbf(u, (size_t)t * D + k), ref, 1.0);
    } else if (which >= 1 && which <= 7) {
        auto proj = [&](int col) { double s = 0; for (int k = 0; k < D; ++k) s += dbf(u, (size_t)t * D + k) * (double)win[(size_t)k * NIN + col]; return s; };
        if (which == 1) { const int n = r1 % 512, g = n >> 7, d = n & 127; double s = 0;
            for (int c = 0; c < 128; ++c) s += proj(g * 128 + c) * (double)A.in[IN_POOL_W][(size_t)(g * 128 + c) * 128 + d];
            s *= A.in[IN_POOL_SCALE][n]; b = bad(dbf((const bf16_t*)(ws + WS_ZP), (size_t)t * 512 + n), s, 1.0); }
        if (which == 2) { const int n = r1 % 512; b = bad(dbf((const bf16_t*)(ws + WS_CQ), (size_t)t * 512 + n), proj(512 + n), 1.0);
            if ((sid & 7) == 0) { double ss = 0; for (int c = 0; c < 512; ++c) { const double v = dbf((const bf16_t*)(ws + WS_CQ), (size_t)t * 512 + c); ss += v * v; }
                double got = 0; for (int c = 0; c < 8; ++c) got += ((const float*)(ws + WS_CQSS))[(size_t)t * 8 + c]; b = b || bad(got, ss, 1.0); } }
        if (which == 3) { const int n = r1 % 256; b = bad(dbf((const bf16_t*)(ws + WS_CKV), (size_t)t * 256 + n), proj(1024 + n), 1.0);
            if ((sid & 7) == 0) { double ss = 0; for (int c = 0; c < 256; ++c) { const double v = dbf((const bf16_t*)(ws + WS_CKV), (size_t)t * 256 + c); ss += v * v; }
                double got = 0; for (int c = 0; c < 4; ++c) got += ((const float*)(ws + WS_CKVSS))[(size_t)t * 4 + c]; b = b || bad(got, ss, 1.0); } }
        if (which == 4) { const int i = r1 % 32, p = r2 & 1; const double x1 = proj(1280 + i), x2 = proj(1280 + 32 + i), ang = (double)pos[t] * pow(10000.0, -(double)(2 * i) / 64.0);
            const double ref = p ? x1 * sin(ang) + x2 * cos(ang) : x1 * cos(ang) - x2 * sin(ang); b = bad(dbf((const bf16_t*)(ws + WS_KR), (size_t)t * 64 + 2 * i + p), ref, 1.0); }
        if (which == 5) { const int n = r1 % 768; b = bad(dbf((const bf16_t*)(ws + WS_DQ), (size_t)t * 768 + n), proj(1344 + n) * 0.125 * 1.4426950408889634, 0.2); }
        if (which == 6) { const int n = r1 % 768; b = bad(dbf((const bf16_t*)(ws + WS_DK), (size_t)t * 768 + n), proj(2112 + n), 1.0); }
        if (which == 7) { const int n = r1 % 768; b = bad(dbf((const bf16_t*)(ws + WS_DVT), (size_t)n * T + t), proj(2880 + n), 1.0); }
    } else if (which == 8) {
        const bf16_t* cq = (const bf16_t*)(ws + WS_CQ); double ss = 0; for (int c = 0; c < 512; ++c) { const double v = dbf(cq, (size_t)t * 512 + c); ss += v * v; }
        const double rs = 1.0 / sqrt(ss / 512 + 1e-6);
        auto qraw = [&](int col) { double s = 0; for (int k = 0; k < 512; ++k) s += dbf(cq, (size_t)t * 512 + k) * rs * A.in[IN_Q_NORM][k] * (double)A.in[IN_W_UQ][(size_t)k * 1152 + col]; return s; };
        const int hd = r1 % 6, w = r2 % 192; double ref;
        if (w < 128) ref = qraw(hd * 192 + w); else { const int i = (w - 128) >> 1, p = (w - 128) & 1; const double x1 = qraw(hd * 192 + 128 + i), x2 = qraw(hd * 192 + 160 + i), ang = (double)pos[t] * pow(10000.0, -(double)(2 * i) / 64.0);
            ref = p ? x1 * sin(ang) + x2 * cos(ang) : x1 * cos(ang) - x2 * sin(ang); }
        ref *= 0.07216878364870322 * 1.4426950408889634; b = bad(dbf((const bf16_t*)(ws + WS_QM), (size_t)t * 1152 + hd * 192 + w), ref, 0.1);
    } else if (which == 9 || which == 10) {
        const bf16_t* ckv = (const bf16_t*)(ws + WS_CKV); double ss = 0; for (int c = 0; c < 256; ++c) { const double v = dbf(ckv, (size_t)t * 256 + c); ss += v * v; }
        const double rs = 1.0 / sqrt(ss / 256 + 1e-6); const int hd = r1 % 6, d = r2 % 128, col = hd * 256 + (which == 10 ? 128 : 0) + d;
        double s = 0; for (int k = 0; k < 256; ++k) s += dbf(ckv, (size_t)t * 256 + k) * rs * A.in[IN_KV_NORM][k] * (double)A.in[IN_W_UKV][(size_t)k * 1536 + col];
        const double got = which == 9 ? dbf((const bf16_t*)(ws + WS_KN), (size_t)t * 768 + hd * 128 + d) : dbf((const bf16_t*)(ws + WS_VMT), (size_t)(hd * 128 + d) * T + t); b = bad(got, s, 1.0);
    } else if (which == 11) {
        const bf16_t* zp = (const bf16_t*)(ws + WS_ZP); const int n = r1 % 512, g = n >> 7, wn = 2 << g, s = t & (S - 1), cnt = (s + 1) < wn ? (s + 1) : wn;
        double sm = 0; for (int k = 0; k < cnt; ++k) sm += dbf(zp, (size_t)(t - k) * 512 + n); const double ref = sm / cnt - dbf(zp, (size_t)t * 512 + n);
        b = bad(dbf((const bf16_t*)(ws + WS_MIX), (size_t)t * D + n), ref, 0.5);
    } else if (which == 12) {
        const bf16_t *qm = (const bf16_t*)(ws + WS_QM), *kn = (const bf16_t*)(ws + WS_KN), *kr = (const bf16_t*)(ws + WS_KR), *vmT = (const bf16_t*)(ws + WS_VMT);
        const int hd = r1 % 6, d = r2 % 128, bb = t / S, s = t % S; double mx = -1e300, l = 0, o = 0;
        for (int pass = 0; pass < 2; ++pass) for (int j = 0; j <= s; ++j) { const size_t tj = (size_t)bb * S + j; double sc = 0;
            for (int w = 0; w < 128; ++w) sc += dbf(qm, (size_t)t * 1152 + hd * 192 + w) * dbf(kn, tj * 768 + hd * 128 + w);
            for (int w = 0; w < 64; ++w) sc += dbf(qm, (size_t)t * 1152 + hd * 192 + 128 + w) * dbf(kr, tj * 64 + w);
            if (pass == 0) mx = sc > mx ? sc : mx; else { const double p = exp2(sc - mx); l += p; o += p * dbf(vmT, (size_t)(hd * 128 + d) * T + tj); } }
        b = bad(dbf((const bf16_t*)(ws + WS_MIX), (size_t)t * D + 512 + hd * 128 + d), o / l, 0.3);
    } else if (which == 13) {
        const bf16_t *dq = (const bf16_t*)(ws + WS_DQ), *dk = (const bf16_t*)(ws + WS_DK), *dvT = (const bf16_t*)(ws + WS_DVT);
        const int hd = r1 % 6, bb = t / S, s = t % S; const float* lv = A.in[IN_LAMBDA]; double d1 = 0, d2 = 0; for (int i = 0; i < 64; ++i) { d1 += (double)lv[i] * lv[64 + i]; d2 += (double)lv[128 + i] * lv[192 + i]; }
        const double lam_init = 0.8 - 0.6 * exp(0.0), lam = exp(d1) - exp(d2) + lam_init; double (*om)[128] = (double (*)[128])dscr;
        for (int c = 0; c < 2; ++c) { double mx = -1e300, l = 0; for (int d = 0; d < 128; ++d) om[c][d] = 0;
            for (int pass = 0; pass < 2; ++pass) for (int j = 0; j <= s; ++j) { const size_t tj = (size_t)bb * S + j; double sc = 0;
                for (int w = 0; w < 64; ++w) sc += dbf(dq, (size_t)t * 768 + hd * 128 + c * 64 + w) * dbf(dk, tj * 768 + hd * 128 + c * 64 + w);
                int n = pos[t] - pos[tj]; n = n < 0 ? 0 : n; int bkt; if (n < 16) bkt = n; else { bkt = 16 + (int)(log((double)n / 16.0) / log(8.0) * 16.0); bkt = bkt < 31 ? bkt : 31; }
                sc += (double)A.in[IN_REL_BIAS][bkt * 6 + hd] * 1.4426950408889634;
                if (pass == 0) mx = sc > mx ? sc : mx; else { const double p = exp2(sc - mx); l += p; for (int d = 0; d < 128; ++d) om[c][d] += p * dbf(dvT, (size_t)(hd * 128 + d) * T + tj); } }
            for (int d = 0; d < 128; ++d) om[c][d] /= l; }
        double ss = 0; for (int d = 0; d < 128; ++d) { om[0][d] -= lam * om[1][d]; ss += om[0][d] * om[0][d]; }
        const double rr = (1.0 - lam_init) / sqrt(ss / 128 + 1e-6); const int d = r2 % 128;
        b = bad(dbf((const bf16_t*)(ws + WS_MIX), (size_t)t * D + 1280 + hd * 128 + d), om[0][d] * rr * A.in[IN_SUBLN][d], 0.2);
    } else if (which == 14) {
        const int n = r1 % D; double s = x[(size_t)t * D + n]; for (int k = 0; k < D; ++k) s += dbf((const bf16_t*)(ws + WS_MIX), (size_t)t * D + k) * (double)A.in[IN_W_OUT][(size_t)k * D + n];
        b = bad(dbf((const bf16_t*)(ws + WS_H2), (size_t)t * D + n), s, 1.0);
    } else if (which == 15) {
        const bf16_t* hb_ = (const bf16_t*)(ws + WS_H2); auto hf = [&](size_t i) { return (double)bf2f(hb_[i]); }; double ss = 0; for (int i = 0; i < D; ++i) ss += hf((size_t)t * D + i) * hf((size_t)t * D + i);
        const double rs = 1.0 / sqrt(ss / D + 1e-6); const int k = r1 % D; b = bad(dbf(u, (size_t)t * D + k), hf((size_t)t * D + k) * rs * A.in[IN_FFN_NORM][k], 1.0);
        double* lg = dscr; for (int c = 0; c < 36; ++c) lg[c] = c < 4 ? A.in[IN_RG_B][c] : A.in[IN_RE_B][c - 4];
        for (int i = 0; i < D; ++i) { const double xv = hf((size_t)t * D + i) * rs * A.in[IN_FFN_NORM][i]; for (int c = 0; c < 4; ++c) lg[c] += xv * A.in[IN_RG_W][(size_t)i * 4 + c]; for (int c = 0; c < 32; ++c) lg[4 + c] += xv * A.in[IN_RE_W][(size_t)i * 32 + c]; }
        int gi = 0; for (int c = 1; c < 4; ++c) if (lg[c] > lg[gi]) gi = c; double gs = 0; for (int c = 0; c < 4; ++c) gs += exp(lg[c] - lg[gi]);
        int i0 = 0; for (int q = 1; q < 8; ++q) if (lg[4 + gi * 8 + q] > lg[4 + gi * 8 + i0]) i0 = q; int i1 = -1; for (int q = 0; q < 8; ++q) if (q != i0 && (i1 < 0 || lg[4 + gi * 8 + q] > lg[4 + gi * 8 + i1])) i1 = q;
        const double p0 = 1.0 / (1.0 + exp(lg[4 + gi * 8 + i1] - lg[4 + gi * 8 + i0]));
        const unsigned* cnt_ = (const unsigned*)(ws + WS_CTL) + CW_CNT; auto cntf = [&](int e) { return cnt_[64 * e]; }; const int* list = (const int*)(ws + WS_LIST); const float* gwt = (const float*)(ws + WS_GW);
        for (int kk = 0; kk < 2; ++kk) { const int e = gi * 8 + (kk ? i1 : i0); bool found = false; for (unsigned i = 0; i < cntf(e) && i < LISTCAP; ++i) if (list[e * LISTCAP + i] == t * 2 + kk) found = true;
            b = b || !found || bad(gwt[t * 2 + kk], (kk ? 1.0 - p0 : p0) / gs, 0.01); }
    } else if (which == 16) {
        const unsigned* cnt_ = (const unsigned*)(ws + WS_CTL) + CW_CNT; auto cntf = [&](int e) { return cnt_[64 * e]; }; const int* list = (const int*)(ws + WS_LIST);
        const int e = r0 % NE; if (cntf(e) == 0) return; const int i = r1 % cntf(e), j = r2 % EH; int off = 0; for (int q = 0; q < e; ++q) off += cntf(q);
        const int tok = list[e * LISTCAP + i] >> 1; double g = 0, up = 0;
        for (int k = 0; k < D; ++k) { const double xv = dbf(u, (size_t)tok * D + k); g += xv * (double)A.in[IN_EW_GATE][((size_t)e * D + k) * EH + j]; up += xv * (double)A.in[IN_EW_UP][((size_t)e * D + k) * EH + j]; }
        b = bad(dbf((const bf16_t*)(ws + WS_ACT), (size_t)(off + i) * EH + j), g / (1.0 + exp(-g)) * up, 0.3);
    } else if (which == 17) {
        const unsigned* cnt_ = (const unsigned*)(ws + WS_CTL) + CW_CNT; auto cntf = [&](int e) { return cnt_[64 * e]; }; const int* list = (const int*)(ws + WS_LIST); const float* gwt = (const float*)(ws + WS_GW); const bf16_t* act = (const bf16_t*)(ws + WS_ACT);
        const int n = r1 % D; double s = x[(size_t)t * D + n]; for (int k = 0; k < D; ++k) s += dbf((const bf16_t*)(ws + WS_MIX), (size_t)t * D + k) * (double)A.in[IN_W_OUT][(size_t)k * D + n];
        int off = 0; for (int e = 0; e < NE; ++e) { for (unsigned i = 0; i < cntf(e); ++i) { const int ent = list[e * LISTCAP + i]; if ((ent >> 1) == t) { double y = 0;
                    for (int j = 0; j < EH; ++j) y += dbf(act, (size_t)(off + i) * EH + j) * (double)A.in[IN_EW_DOWN][((size_t)e * EH + j) * D + n]; s += y * gwt[ent]; } } off += cntf(e); }
        b = bad(dbf((const bf16_t*)(ws + WS_H), (size_t)t * D + n), s, 1.0);
    }
    if (b) atomicAdd(chk + code, 1u);
}
__global__ void dbg_apply(Args A) {
    const unsigned* chk = (const unsigned*)(A.ws + WS_CTL) + CW_CHK; double f = 0; for (int k = 0; k < 18; ++k) if (chk[k]) f += pow(4.0, 17 - k);
    if (f == 0) return; const float sc = (float)(1.0 + f);
    for (size_t i = (size_t)blockIdx.x * blockDim.x + threadIdx.x; i < (size_t)T * D; i += (size_t)gridDim.x * blockDim.x) A.out[i] *= sc;
}
#endif

extern "C" void kernel_launch(void* const* d_in, const int* in_sizes, int n_in, void* d_out, int out_size, void* d_ws, size_t ws_size, hipStream_t stream) {
    static int grid = 0;
    if (!grid) {
        if (n_in != 23 || out_size != T * D || ws_size < WS_END) { fprintf(stderr, "kernel_launch: unexpected problem (n_in %d, out %d, ws %zu < %zu)\n", n_in, out_size, ws_size, (size_t)WS_END); grid = -1; return; }
        int dev = 0, cus = 0, per_cu = 0;
        hipGetDevice(&dev); hipDeviceGetAttribute(&cus, hipDeviceAttributeMultiprocessorCount, dev);
        if (hipFuncSetAttribute((const void*)hymba_fwd, hipFuncAttributeMaxDynamicSharedMemorySize, LDS_BYTES) != hipSuccess) { fprintf(stderr, "kernel_launch: hipFuncSetAttribute failed\n"); grid = -1; return; }
        hipOccupancyMaxActiveBlocksPerMultiprocessor(&per_cu, (const void*)hymba_fwd, NTHR, LDS_BYTES);
        if (per_cu < 1) { fprintf(stderr, "kernel_launch: occupancy query says %d blocks per CU\n", per_cu); }
        grid = cus > 0 ? cus : 256;
    }
    if (grid < 0) return;
    hipMemsetAsync((char*)d_ws + WS_CTL, 0, CTL_BYTES, stream);
    Args a{};
    for (int i = 0; i < 23; ++i) a.in[i] = (const float*)d_in[i];
    a.out = (float*)d_out; a.ws = (unsigned char*)d_ws; a.pad = 0;
#if MK_LAUNCHES == 1
    a.g_lo = 0; a.g_hi = 1 + 9 * NL; a.use_bar = 1;
    hipLaunchKernelGGL(hymba_fwd, dim3(grid), dim3(NTHR), LDS_BYTES, stream, a);
#else
    for (int k = 0; k < 1 + 9 * NL; ++k) { a.g_lo = k; a.g_hi = k + 1; a.use_bar = 0; hipLaunchKernelGGL(hymba_fwd, dim3(grid), dim3(NTHR), LDS_BYTES, stream, a);
#if DBG_CHECK
        auto chk = [&](int which, int blocks) { hipLaunchKernelGGL(dbg_check, dim3(blocks), dim3(64), 0, stream, a, which); };
        if (k == 0) chk(0, 4);
        if (k == 1) for (int w = 1; w <= 7; ++w) chk(w, w == 1 ? 1 : 4);
        if (k == 2) for (int w = 8; w <= 11; ++w) chk(w, 4);
        if (k == 3) { chk(12, 2); chk(13, 1); }
        if (k == 4) chk(14, 4);
        if (k == 5) chk(15, 4);
        if (k == 7) chk(16, 4);
        if (k == 9) chk(17, 4);
        if (k == 9 * NL) hipLaunchKernelGGL(dbg_apply, dim3(1024), dim3(256), 0, stream, a);
#endif
    }
#endif
}
```

```cpp
#include <hip/hip_runtime.h>
#include <cstdio>
#include <cstdint>

#ifndef MK_LAUNCHES
#define MK_LAUNCHES 1
#endif

#ifndef DUP_MASK
#define DUP_MASK 0
#endif
#define DUPN(p) (((DUP_MASK) >> (p)) & 1 ? 2 : 1)
#define LAS __attribute__((address_space(3)))
#define GAS __attribute__((address_space(1)))
typedef unsigned short bf16_t;
typedef short bf16x8 __attribute__((ext_vector_type(8)));
typedef float f32x4 __attribute__((ext_vector_type(4)));
typedef float f32x2 __attribute__((ext_vector_type(2)));
typedef float f32x16 __attribute__((ext_vector_type(16)));
typedef unsigned u32x4 __attribute__((ext_vector_type(4)));
typedef unsigned u32x2 __attribute__((ext_vector_type(2)));
typedef __bf16 bfv2 __attribute__((ext_vector_type(2)));

constexpr int T = 8192, D = 2048, S = 2048, NB = 4, NL = 4, NIN = 3648;
constexpr int NE = 32, EH = 512, LISTCAP = 8192;
constexpr float EPS = 1e-6f;
constexpr float LOG2E = 1.4426950408889634f;
constexpr int NWAVES = 8, NTHR = 512;

constexpr size_t MiB = 1u << 20;
constexpr size_t al256(size_t x) { return (x + 255) & ~(size_t)255; }
constexpr size_t WS_CTL = 0, CTL_BYTES = 1 * MiB;
constexpr size_t SZ_WIN = (size_t)3072 * 2048 * 2, SZ_WDV = (size_t)768 * 2048 * 2, SZ_WUQ = (size_t)1280 * 512 * 2, SZ_WK = (size_t)768 * 256 * 2,
                 SZ_WOUT = (size_t)2048 * 2048 * 2, SZ_WGU1 = (size_t)1024 * 2048 * 2, SZ_WD1 = (size_t)2048 * 512 * 2;
constexpr size_t WS_WIN = WS_CTL + CTL_BYTES;
constexpr size_t WS_WDV = WS_WIN + NL * SZ_WIN;
constexpr size_t WS_WUQ = WS_WDV + NL * SZ_WDV;
constexpr size_t WS_WK = WS_WUQ + NL * SZ_WUQ;
constexpr size_t WS_WV = WS_WK + NL * SZ_WK;
constexpr size_t WS_WOUT = WS_WV + NL * SZ_WK;
constexpr size_t WS_WGU = WS_WOUT + NL * SZ_WOUT;
constexpr size_t WS_WD = WS_WGU + (size_t)NL * NE * SZ_WGU1;
constexpr size_t WS_COS = WS_WD + (size_t)NL * NE * SZ_WD1;
constexpr size_t WS_SIN = WS_COS + (size_t)T * 32 * 4;
constexpr size_t WS_LUT = WS_SIN + (size_t)T * 32 * 4;
constexpr size_t WS_TMAX = WS_LUT + al256(6 * 132 * 4);
constexpr size_t WS_H = WS_TMAX + al256(NB * 32 * 4);
constexpr size_t WS_XB = WS_H + (size_t)T * D * 4;
constexpr size_t WS_ZP = WS_XB + (size_t)T * D * 2;
constexpr size_t WS_CQ = WS_ZP + (size_t)T * 512 * 2;
constexpr size_t WS_CKV = WS_CQ + (size_t)T * 512 * 2;
constexpr size_t WS_KR = WS_CKV + (size_t)T * 256 * 2;
constexpr size_t WS_DQ = WS_KR + (size_t)T * 64 * 2;
constexpr size_t WS_DK = WS_DQ + (size_t)T * 768 * 2;
constexpr size_t WS_DVT = WS_DK + (size_t)T * 768 * 2;
constexpr size_t WS_QM = WS_DVT + (size_t)T * 768 * 2;
constexpr size_t WS_KN = WS_QM + (size_t)T * 1152 * 2;
constexpr size_t WS_VMT = WS_KN + (size_t)T * 768 * 2;
constexpr size_t WS_MIX = WS_VMT + (size_t)T * 768 * 2;
constexpr size_t WS_CQSS = WS_MIX + (size_t)T * D * 2;
constexpr size_t WS_CKVSS = WS_CQSS + (size_t)T * 8 * 4;
constexpr size_t WS_GW = WS_CKVSS + (size_t)T * 4 * 4;
constexpr size_t WS_LIST = WS_GW + (size_t)T * 2 * 4;
constexpr size_t WS_ACT = WS_LIST + (size_t)NE * LISTCAP * 4;
constexpr size_t WS_Y2 = WS_ACT + (size_t)(2 * T + 256) * EH * 2;
constexpr size_t WS_Y1 = WS_Y2 + (size_t)T * D * 4;
constexpr size_t WS_H2 = WS_Y1 + (size_t)T * D * 4;
constexpr size_t WS_WRH = WS_H2 + (size_t)T * D * 4;
constexpr size_t WS_WRL = WS_WRH + (size_t)NL * 64 * D * 2;
constexpr size_t WS_END = WS_WRL + (size_t)NL * 64 * D * 2;
constexpr int CW_BAR = 4096, CW_TMO = 12288, CW_CNT = 16384, CW_RDY = 32768;

constexpr int LDS_MISC = 135168;
constexpr int LDS_BYTES = 147456;

__device__ __forceinline__ unsigned pk2(float lo, float hi) { f32x2 v = {lo, hi}; return __builtin_bit_cast(unsigned, __builtin_convertvector(v, bfv2)); }
__device__ __forceinline__ f32x4 unpk4(u32x2 a) { return (f32x4){__builtin_bit_cast(float, a.x << 16), __builtin_bit_cast(float, a.x & 0xffff0000u), __builtin_bit_cast(float, a.y << 16), __builtin_bit_cast(float, a.y & 0xffff0000u)}; }
__device__ __forceinline__ float bf2f(unsigned short b) { return __builtin_bit_cast(float, (unsigned)b << 16); }
template <int M> __device__ __forceinline__ float xor_lt32(float v) { return __builtin_bit_cast(float, __builtin_amdgcn_ds_swizzle(__builtin_bit_cast(int, v), (M << 10) | 0x1f)); }
__device__ __forceinline__ float sum32(float v) { const unsigned x = __builtin_bit_cast(unsigned, v); auto r = __builtin_amdgcn_permlane32_swap(x, x, false, false);
    unsigned a = r[0], b = r[1]; asm volatile("" : "+v"(a), "+v"(b));
    return __builtin_bit_cast(float, a) + __builtin_bit_cast(float, b); }
__device__ __forceinline__ float max32(float v) { const unsigned x = __builtin_bit_cast(unsigned, v); auto r = __builtin_amdgcn_permlane32_swap(x, x, false, false);
    unsigned a = r[0], b = r[1]; asm volatile("" : "+v"(a), "+v"(b));
    return fmaxf(__builtin_bit_cast(float, a), __builtin_bit_cast(float, b)); }
__device__ __forceinline__ float wave_sum(float v) {
    v += xor_lt32<1>(v); v += xor_lt32<2>(v); v += xor_lt32<4>(v); v += xor_lt32<8>(v); v += xor_lt32<16>(v);
    return sum32(v);
}
#define LDS_WAIT() asm volatile("s_waitcnt lgkmcnt(0)" ::: "memory")

#define XB_TMO      128
#define XB_XCNT(j)  (256  + 64 * (j))
#define XB_XSUB(j)  (1280 + 64 * (j))
#define XB_XGEN(j)  (2304 + 64 * (j))
#define XB_TOP      3328
#define XB_TOPGEN   3392
#define XCD_BAR_WORDS 3456
#define XB_SPIN_CAP (1u << 18)
__device__ __forceinline__ unsigned xb_ld(unsigned* p)              { return __hip_atomic_load(p, __ATOMIC_RELAXED, __HIP_MEMORY_SCOPE_AGENT); }
__device__ __forceinline__ unsigned xb_add(unsigned* p, unsigned v) { return __hip_atomic_fetch_add(p, v, __ATOMIC_RELAXED, __HIP_MEMORY_SCOPE_AGENT); }
__device__ __forceinline__ unsigned xb_xcc_id() { return (unsigned)__builtin_amdgcn_s_getreg((3 << 11) | 20) & 0xFu; }
#define XB_SPIN(cond, bar) do { unsigned _sp = 0; while (cond) { __builtin_amdgcn_s_sleep(1); \
    if ((++_sp & 255u) == 0u) { if (xb_ld(&(bar)[XB_TMO])) break; if (_sp > XB_SPIN_CAP) { atomicAdd(&(bar)[XB_TMO], 1u); break; } } } } while (0)
struct XcdBarrier { unsigned* bar; unsigned x; volatile LAS unsigned* st; };
__device__ __forceinline__ XcdBarrier xcd_barrier_post(unsigned* bar, volatile LAS unsigned* st) {
    XcdBarrier b; b.bar = bar; b.x = xb_xcc_id(); b.st = st;
    if (threadIdx.x == 0) (void)xb_add(&bar[XB_XCNT(b.x)], 1u);
    return b;
}
__device__ __forceinline__ void xcd_barrier_complete(unsigned* bar, unsigned x, unsigned& nloc, unsigned& nx) {
    const unsigned G = gridDim.x * gridDim.y * gridDim.z;
    unsigned sum, cnt, mine, sp = 0u;
    for (;;) {
        sum = 0u; cnt = 0u; mine = 0u;
#pragma unroll
        for (unsigned j = 0; j < 16; ++j) { const unsigned c = xb_ld(&bar[XB_XCNT(j)]); sum += c; cnt += (c > 0u) ? 1u : 0u; mine = (j == x) ? c : mine; }
        if (sum == G) break;
        __builtin_amdgcn_s_sleep(1);
        if ((++sp & 255u) == 0u) { if (xb_ld(&bar[XB_TMO])) break; if (sp > XB_SPIN_CAP) { atomicAdd(&bar[XB_TMO], 1u); break; } }
    }
    nloc = mine > 0u ? mine : 1u; nx = cnt > 0u ? cnt : 1u;
}
__device__ __forceinline__ void xcd_barrier(const XcdBarrier& b) {
    asm volatile("s_waitcnt vmcnt(0)" ::: "memory");
    __syncthreads();
    if (threadIdx.x == 0) {
        unsigned* bar = b.bar;
        __builtin_amdgcn_s_waitcnt(0);
        unsigned nloc = b.st[0], nx = b.st[1];
        if (nloc == 0u) { xcd_barrier_complete(bar, b.x, nloc, nx); b.st[0] = nloc; b.st[1] = nx; }
        const unsigned old = xb_add(&bar[XB_XSUB(b.x)], 1u);
        const unsigned gen = old / nloc;
        if (old + 1u == (gen + 1u) * nloc) {
            __builtin_amdgcn_fence(__ATOMIC_RELEASE, "agent");
            asm volatile("s_waitcnt vmcnt(0)" ::: "memory");
            const unsigned og = xb_add(&bar[XB_TOP], 1u);
            const unsigned tg = og / nx;
            if (og + 1u == (tg + 1u) * nx) xb_add(&bar[XB_TOPGEN], 1u);
            else XB_SPIN(xb_ld(&bar[XB_TOPGEN]) == tg, bar);
            __builtin_amdgcn_fence(__ATOMIC_ACQUIRE, "agent");
            xb_add(&bar[XB_XGEN(b.x)], 1u);
            asm volatile("s_waitcnt vmcnt(0)" ::: "memory");
        } else {
            XB_SPIN(xb_ld(&bar[XB_XGEN(b.x)]) == gen, bar);
            __builtin_amdgcn_fence(__ATOMIC_ACQUIRE, "agent");
            asm volatile("s_waitcnt vmcnt(0)" ::: "memory");
        }
    }
    __syncthreads();
}

namespace pg8 {
constexpr int BM = 256, BK = 64, HALF = 128, HTB = HALF * BK * 2, STAGE_BYTES = 8 * HTB, NXCD = 8, WGM = 8;
__host__ __device__ __forceinline__ int lds_byte(int r, int c) { const int st = (r >> 4) * 2 + (c >> 5), rr = r & 15, cc = c & 31, ob = rr * 64 + cc * 2; return st * 1024 + (ob ^ (((ob >> 9) & 1) << 5)); }
__host__ __device__ __forceinline__ void stage_rc(int b, int& R, int& C) { const int st = b / 1024, sb = b % 1024, swz = sb ^ (((sb >> 9) & 1) << 5); R = (st >> 1) * 16 + swz / 64; C = (st & 1) * 32 + (swz % 64) / 2; }
__host__ __device__ __forceinline__ int perm32(int rho) { const int n = rho >> 4, i = rho & 15; return 8 * (i >> 2) + 4 * n + (i & 3); }

struct Unit { const char* a; const char* b; const int* rowmap; int nrows; int p0, p1, p2, p3; };
struct Gemm { int K, lda, ldb; };

__device__ __forceinline__ void tile_of(int L, int nM, int nN, int& pm, int& pn) {
    const int nwg = nM * nN; int wgid = L;
    { const int q = nwg / NXCD, r = nwg % NXCD, xcd = wgid % NXCD, off = wgid / NXCD; wgid = (xcd < r ? xcd * (q + 1) : r * (q + 1) + (xcd - r) * q) + off; }
    const int nig = WGM * nN, gid = wgid / nig, fm = gid * WGM, gsz = (nM - fm) < WGM ? (nM - fm) : WGM;
    pm = fm + ((wgid % nig) % gsz); pn = (wgid % nig) / gsz;
}

template <class Epi, class Sched, bool GATHER, bool HOOK = false>
__device__ __forceinline__ void gemm_phase(LAS unsigned char* lds, const Gemm g, const Sched& S, const Epi& E) {
    int tid_ = threadIdx.x; asm volatile("" : "+v"(tid_));
    const int tid = tid_, wid = __builtin_amdgcn_readfirstlane(tid >> 6), lane = tid & 63, wr = wid >> 2, wc = wid & 3, fr = lane & 15, fq = lane >> 4;
    const int K = g.K, nt = K / BK;
    unsigned voffA[2], voffB[2];
#pragma unroll
    for (int i = 0; i < 2; ++i) { int R, C; stage_rc(tid * 16 + i * 8192, R, C); const int Rb = Epi::PERM ? ((R & ~31) + perm32(R & 31)) : R;
        voffA[i] = (unsigned)(R * g.lda + C) * 2u; voffB[i] = (unsigned)(Rb * g.ldb + C) * 2u; }
    const size_t kstep = (size_t)(BK * 2);
    const size_t hstepA = (size_t)HALF * g.lda * 2, hstepB = (size_t)HALF * g.ldb * 2;
    const unsigned ldsw = (unsigned)wid * 1024u;
    const int aoff = lds_byte(wr * 64 + fr, fq * 8), boff = lds_byte(wc * 32 + fr, fq * 8);
    unsigned ga[2][2], gn[2][2];
#define PG8_SA(b, h) (((b) * 2 + (h)) * HTB)
#define PG8_SB(b, h) ((4 + (b) * 2 + (h)) * HTB)
#define PG8_GLDS(src, dst) __builtin_amdgcn_global_load_lds((const unsigned*)(src), (LAS unsigned*)(dst), 16, 0, 0)
#define PG8_STAGE_B(bufoff, gbase) do { _Pragma("unroll") for (int _i = 0; _i < 2; ++_i) PG8_GLDS((const char*)(gbase) + voffB[_i], lds + (bufoff) + ldsw + _i * 8192); } while (0)
#define PG8_STAGE_A(bufoff, gbase, hh, SEL) do { _Pragma("unroll") for (int _i = 0; _i < 2; ++_i) { \
        if constexpr (GATHER) PG8_GLDS((const char*)(gbase) + ((SEL) ? gn[hh][_i] : ga[hh][_i]), lds + (bufoff) + ldsw + _i * 8192); \
        else PG8_GLDS((const char*)(gbase) + (hh) * hstepA + voffA[_i], lds + (bufoff) + ldsw + _i * 8192); } } while (0)
#define PG8_GMAP(u, O) do { if constexpr (GATHER) { _Pragma("unroll") for (int _h = 0; _h < 2; ++_h) _Pragma("unroll") for (int _i = 0; _i < 2; ++_i) { \
        int _R, _C; stage_rc(tid * 16 + _i * 8192, _R, _C); const int _r = _R + 128 * _h; const int _e0 = (u).rowmap[_r < (u).nrows ? _r : 0] >> 1;   const int _e = (_r < (u).nrows) ? _e0 : 0; O[_h][_i] = (unsigned)(_e * g.lda + _C) * 2u; } } } while (0)
#define PG8_LDA(dst, b, h) do { _Pragma("unroll") for (int m = 0; m < 4; ++m) _Pragma("unroll") for (int k = 0; k < 2; ++k) dst[m][k] = *(const LAS bf16x8*)(lds + PG8_SA(b, h) + aoff + m * 2048 + k * 1024); } while (0)
#define PG8_LDB(dst, b, h) do { _Pragma("unroll") for (int n = 0; n < 2; ++n) _Pragma("unroll") for (int k = 0; k < 2; ++k) dst[n][k] = *(const LAS bf16x8*)(lds + PG8_SB(b, h) + boff + n * 2048 + k * 1024); } while (0)
#define PG8_MMA(ai, bj, At, Bt) do { __builtin_amdgcn_s_setprio(1); _Pragma("unroll") for (int m = 0; m < 4; ++m) _Pragma("unroll") for (int n = 0; n < 2; ++n) _Pragma("unroll") for (int k = 0; k < 2; ++k) \
        acc[ai][bj][m][n] = __builtin_amdgcn_mfma_f32_16x16x32_bf16(Bt[n][k], At[m][k], acc[ai][bj][m][n], 0, 0, 0); __builtin_amdgcn_s_setprio(0); } while (0)
#define PG8_WAIT_V(n) asm volatile("s_waitcnt vmcnt(" #n ")" ::: "memory")
#define PG8_WAIT_L(n) asm volatile("s_waitcnt lgkmcnt(" #n ")" ::: "memory")
#define PG8_BAR __builtin_amdgcn_s_barrier()
#define PG8_SCHED __builtin_amdgcn_sched_barrier(0)
    Unit cur, nxt; int ui = 0;
    if (!S.next(0, cur)) return;
    if constexpr (HOOK) S.a_ready(cur);
    f32x4 acc[2][2][4][2];
#pragma unroll
    for (int a = 0; a < 2; ++a)
#pragma unroll
        for (int b = 0; b < 2; ++b)
#pragma unroll
            for (int m = 0; m < 4; ++m)
#pragma unroll
                for (int n = 0; n < 2; ++n) acc[a][b][m][n] = (f32x4){0.f, 0.f, 0.f, 0.f};
    bf16x8 At[4][2], B0[2][2], B1[2][2];
    const char* cA = cur.a; const char* cB = cur.b;
    PG8_GMAP(cur, ga);
    PG8_STAGE_B(PG8_SB(0, 0), cB); PG8_STAGE_A(PG8_SA(0, 0), cA, 0, false); PG8_STAGE_B(PG8_SB(0, 1), cB + hstepB); PG8_STAGE_A(PG8_SA(0, 1), cA, 1, false);
    if (wr == 1) PG8_BAR;
    PG8_WAIT_V(4); PG8_BAR;
    PG8_STAGE_B(PG8_SB(1, 0), cB + kstep); PG8_STAGE_A(PG8_SA(1, 0), cA + kstep, 0, false); PG8_STAGE_B(PG8_SB(1, 1), cB + hstepB + kstep);
    PG8_WAIT_V(6); PG8_BAR;
    for (;;) {
        const bool has_next = S.next(ui + 1, nxt);
        const char* nA = has_next ? nxt.a : cA; const char* nB = has_next ? nxt.b : cB;
        if constexpr (GATHER) { if (has_next) { PG8_GMAP(nxt, gn); } else {
#pragma unroll
            for (int _h = 0; _h < 2; ++_h)
#pragma unroll
                for (int _i = 0; _i < 2; ++_i) gn[_h][_i] = ga[_h][_i]; } }
        for (int t = 0; t < nt; t += 2) {
            const bool last = (t == nt - 2);
            if constexpr (HOOK) { if (last && has_next) S.a_ready(nxt); }
            const char* a1 = cA + (size_t)(t + 1) * kstep;
            const char* a2 = last ? nA : cA + (size_t)(t + 2) * kstep; const char* b2 = last ? nB : cB + (size_t)(t + 2) * kstep;
            const char* a3 = a2 + kstep; const char* b3 = b2 + kstep;
            PG8_LDB(B0, 0, 0); PG8_SCHED; PG8_LDA(At, 0, 0); PG8_STAGE_A(PG8_SA(1, 1), a1, 1, false);
            PG8_WAIT_L(8); PG8_BAR; PG8_WAIT_L(0); PG8_MMA(0, 0, At, B0); PG8_BAR; PG8_SCHED;
            PG8_LDB(B1, 0, 1); PG8_STAGE_B(PG8_SB(0, 0), b2);
            PG8_BAR; PG8_WAIT_L(0); PG8_MMA(0, 1, At, B1); PG8_BAR;
            PG8_LDA(At, 0, 1); PG8_STAGE_A(PG8_SA(0, 0), a2, 0, last);
            PG8_BAR; PG8_WAIT_L(0); PG8_MMA(1, 0, At, B0); PG8_BAR; PG8_SCHED;
            PG8_STAGE_B(PG8_SB(0, 1), b2 + hstepB);
            PG8_WAIT_V(6); PG8_BAR; PG8_MMA(1, 1, At, B1); PG8_BAR;
            PG8_LDB(B0, 1, 0); PG8_SCHED; PG8_LDA(At, 1, 0); PG8_STAGE_A(PG8_SA(0, 1), a2, 1, last);
            PG8_WAIT_L(8); PG8_BAR; PG8_WAIT_L(0); PG8_MMA(0, 0, At, B0); PG8_BAR; PG8_SCHED;
            PG8_LDB(B1, 1, 1); PG8_STAGE_B(PG8_SB(1, 0), b3);
            PG8_BAR; PG8_WAIT_L(0); PG8_MMA(0, 1, At, B1); PG8_BAR;
            PG8_LDA(At, 1, 1); PG8_STAGE_A(PG8_SA(1, 0), a3, 0, last);
            PG8_BAR; PG8_WAIT_L(0); PG8_MMA(1, 0, At, B0); PG8_BAR; PG8_SCHED;
            PG8_STAGE_B(PG8_SB(1, 1), b3 + hstepB);
            PG8_WAIT_V(6); PG8_BAR; PG8_MMA(1, 1, At, B1); PG8_BAR;
        }
        { int le = threadIdx.x & 63; asm volatile("" : "+v"(le));
          E(acc, cur, wr, wc, le & 15, le >> 4); }
        if (!has_next) break;
#pragma unroll
        for (int a = 0; a < 2; ++a)
#pragma unroll
            for (int b = 0; b < 2; ++b)
#pragma unroll
                for (int m = 0; m < 4; ++m)
#pragma unroll
                    for (int n = 0; n < 2; ++n) acc[a][b][m][n] = (f32x4){0.f, 0.f, 0.f, 0.f};
        cur = nxt; cA = nA; cB = nB; ++ui;
        if constexpr (GATHER) {
#pragma unroll
            for (int _h = 0; _h < 2; ++_h)
#pragma unroll
                for (int _i = 0; _i < 2; ++_i) ga[_h][_i] = gn[_h][_i]; }
    }
    PG8_WAIT_V(0);
    if (wr == 0) PG8_BAR;
    PG8_BAR;
#undef PG8_SA
#undef PG8_SB
#undef PG8_GLDS
#undef PG8_STAGE_A
#undef PG8_STAGE_B
#undef PG8_GMAP
#undef PG8_LDA
#undef PG8_LDB
#undef PG8_MMA
#undef PG8_WAIT_V
#undef PG8_WAIT_L
#undef PG8_BAR
#undef PG8_SCHED
}

__device__ __forceinline__ void store_tile_bf16(const f32x4 (&acc)[2][2][4][2], bf16_t* dst, size_t ld, int row0, int col0, float scale, int wr, int wc, int fr, int fq) {
#pragma unroll
    for (int ai = 0; ai < 2; ++ai)
#pragma unroll
        for (int m = 0; m < 4; ++m) { bf16_t* rowp = dst + (size_t)(row0 + ai * HALF + wr * 64 + m * 16 + fr) * ld + col0 + wc * 32 + 8 * fq;
#pragma unroll
            for (int bj = 0; bj < 2; ++bj) { const f32x4 v0 = acc[ai][bj][m][0] * scale, v1 = acc[ai][bj][m][1] * scale;
                u32x4 w; w.x = pk2(v0[0], v0[1]); w.y = pk2(v0[2], v0[3]); w.z = pk2(v1[0], v1[1]); w.w = pk2(v1[2], v1[3]);
                *(u32x4*)(rowp + bj * HALF) = w; } }
}
}

struct Args { const float* in[23]; float* out; unsigned char* ws; int g_lo, g_hi, use_bar, pad; };
enum { IN_X = 0, IN_POS, IN_ATTN_NORM, IN_W_IN, IN_POOL_W, IN_POOL_SCALE, IN_Q_NORM, IN_W_UQ, IN_KV_NORM, IN_W_UKV, IN_LAMBDA, IN_SUBLN, IN_REL_BIAS, IN_W_OUT, IN_FFN_NORM,
       IN_RG_W, IN_RG_B, IN_RE_W, IN_RE_B, IN_EW_GATE, IN_EW_UP, IN_EW_DOWN, IN_FINAL_NORM };

struct Frame {
    LAS unsigned char* lds;
    volatile LAS unsigned* MISC;
    unsigned* ctl;
    unsigned char* ws;
    unsigned char* ws0;
    int tid, lane, wave, vcu, G, bx;
};
constexpr int MISC_PTAB = 192;
__device__ __forceinline__ const float* inptr(const Frame& F, int i) {
    const unsigned lo = __builtin_amdgcn_readfirstlane(F.MISC[MISC_PTAB + 2 * i]), hi = __builtin_amdgcn_readfirstlane(F.MISC[MISC_PTAB + 2 * i + 1]);
    return (const float*)(GAS const float*)(((unsigned long long)hi << 32) | lo);
}

__device__ __forceinline__ void frame_refresh(Frame& F) {
    int t = threadIdx.x; asm volatile("" : "+v"(t)); F.tid = t; F.lane = t & 63; F.wave = __builtin_amdgcn_readfirstlane(t >> 6);
    int bx = blockIdx.x, G = gridDim.x; asm volatile("" : "+s"(bx), "+s"(G)); F.bx = bx; F.G = G; F.vcu = (G % 8 == 0) ? (bx % 8) * (G / 8) + bx / 8 : bx;
    GAS unsigned char* w = (GAS unsigned char*)F.ws0; asm volatile("" : "+s"(w)); F.ws = (unsigned char*)w; F.ctl = (unsigned*)(F.ws + WS_CTL);
    LAS unsigned char* lb = F.lds; asm volatile("" : "+s"(lb)); F.MISC = (volatile LAS unsigned*)(lb + LDS_MISC);
}
__device__ __forceinline__ void tr_write(bf16_t* WT, int ldo, int n0, int k0, LAS float* scr, int lane) {
    LDS_WAIT(); asm volatile("" ::: "memory");
#pragma unroll
    for (int it = 0; it < 8; ++it) { const int n = 8 * it + (lane >> 3), kc = lane & 7; const LAS float* s = scr + (8 * kc) * 65 + n;
        u32x4 o; o.x = pk2(s[0], s[65]); o.y = pk2(s[2 * 65], s[3 * 65]); o.z = pk2(s[4 * 65], s[5 * 65]); o.w = pk2(s[6 * 65], s[7 * 65]);
        __builtin_nontemporal_store(o, (u32x4*)(WT + (size_t)(n0 + n) * ldo + k0 + 8 * kc)); }
    LDS_WAIT(); asm volatile("" ::: "memory");
}
__device__ __forceinline__ void tr_item(const float* W, int ldw, int k0, int c0, bf16_t* WT, int ldo, int n0, const float* kscale, LAS float* scr, int lane) {
#pragma unroll
    for (int i = 0; i < 16; ++i) { const int k = 4 * i + (lane >> 4); f32x4 v = __builtin_nontemporal_load((const f32x4*)(W + (size_t)(k0 + k) * ldw + c0 + 4 * (lane & 15)));
        if (kscale) v = v * kscale[k0 + k];
        LAS float* d = scr + k * 65 + 4 * (lane & 15); d[0] = v[0]; d[1] = v[1]; d[2] = v[2]; d[3] = v[3]; }
    tr_write(WT, ldo, n0, k0, scr, lane);
}
__device__ __forceinline__ void tr_item_map(const float* W, int ldw, int k0, int srccol, bf16_t* WT, int ldo, int n0, const float* kscale, LAS float* scr, int lane) {
#pragma unroll 8
    for (int k = 0; k < 64; ++k) { float v = 0.f; if (srccol >= 0) { v = W[(size_t)(k0 + k) * ldw + srccol]; if (kscale) v *= kscale[k0 + k]; } scr[k * 65 + lane] = v; }
    tr_write(WT, ldo, n0, k0, scr, lane);
}

struct XItem { const float* src; bf16_t* dst; int ldw, ldo; };
constexpr int XJ_GU = 32 * 2 * 8 * 32, XJ_D = 32 * 32 * 8, XJ_L = XJ_GU + XJ_D;
__device__ __forceinline__ XItem x_item(Frame& F, int x) {
    unsigned char* ws = F.ws; const int l = x / XJ_L; int r = x % XJ_L; XItem it;
    if (r < XJ_GU) {
        const int e = r / 512, q = r % 512, isup = q >> 8, ntile = q & 7, kt = (q >> 3) & 31, c0 = ntile * 64, n0 = (c0 >> 7) * 256 + isup * 128 + (c0 & 127);
        it.src = inptr(F, isup ? IN_EW_UP : IN_EW_GATE) + ((size_t)l * NE + e) * D * EH + (size_t)(kt * 64) * EH + c0; it.ldw = EH;
        it.dst = (bf16_t*)(ws + WS_WGU + ((size_t)l * NE + e) * SZ_WGU1) + (size_t)n0 * D + kt * 64; it.ldo = D; }
    else { r -= XJ_GU;
        const int e = r / 256, q = r % 256, ntile = q & 31, kt = q >> 5;
        it.src = inptr(F, IN_EW_DOWN) + ((size_t)l * NE + e) * EH * D + (size_t)(kt * 64) * D + ntile * 64; it.ldw = D;
        it.dst = (bf16_t*)(ws + WS_WD + ((size_t)l * NE + e) * SZ_WD1) + (size_t)(ntile * 64) * EH + kt * 64; it.ldo = EH; }
    return it;
}
#define X_LOAD(R, IT) do { _Pragma("unroll") for (int _i = 0; _i < 16; ++_i) R[_i] = __builtin_nontemporal_load((const f32x4*)((IT).src + (size_t)(4 * _i + (lane >> 4)) * (IT).ldw + 4 * (lane & 15))); } while (0)
#define X_OUT(R, IT) do { _Pragma("unroll") for (int _i = 0; _i < 16; ++_i) { LAS float* _d = scr + (4 * _i + (lane >> 4)) * 65 + 4 * (lane & 15); _d[0] = R[_i][0]; _d[1] = R[_i][1]; _d[2] = R[_i][2]; _d[3] = R[_i][3]; } \
        tr_write((IT).dst, (IT).ldo, 0, 0, scr, lane); } while (0)

__device__ __forceinline__ void p0_prologue(Frame& F) {
    frame_refresh(F);
    unsigned char* ws = F.ws;
    {
        LAS float* AsT = (LAS float*)F.lds;
        LAS float* Pw = (LAS float*)(F.lds + 128 * 68 * 4);
        for (int it = F.bx; it < NL * 4 * 32; it += F.G) {
            const int l = it / 128, g = (it / 32) & 3, kb = it & 31;
            const float* win = inptr(F, IN_W_IN) + (size_t)l * D * NIN; const float* pw = inptr(F, IN_POOL_W) + (size_t)(l * 4 + g) * 128 * 128; const float* ps = inptr(F, IN_POOL_SCALE) + l * 512 + g * 128;
            __syncthreads();
#pragma unroll
            for (int i = 0; i < 4; ++i) { const int idx = F.tid + 512 * i, row = idx >> 5, c4 = idx & 31; const f32x4 v = *(const f32x4*)(win + (size_t)(kb * 64 + row) * NIN + g * 128 + 4 * c4);
                LAS float* d = AsT + (4 * c4) * 68 + row; d[0] = v[0]; d[68] = v[1]; d[136] = v[2]; d[204] = v[3]; }
#pragma unroll
            for (int i = 0; i < 8; ++i) { const int idx = F.tid + 512 * i, c = idx >> 5, d4 = idx & 31; f32x4 v = *(const f32x4*)(pw + c * 128 + 4 * d4); const f32x4 sc = *(const f32x4*)(ps + 4 * d4);
                *(LAS f32x4*)(Pw + c * 128 + 4 * d4) = v * sc; }
            __syncthreads();
            const int kg = F.tid & 15, d4 = F.tid >> 4; f32x4 acc[4];
#pragma unroll
            for (int i = 0; i < 4; ++i) acc[i] = (f32x4){0.f, 0.f, 0.f, 0.f};
#pragma unroll 4
            for (int c = 0; c < 128; ++c) { const f32x4 pv = *(const LAS f32x4*)(Pw + c * 128 + 4 * d4), av = *(const LAS f32x4*)(AsT + c * 68 + 4 * kg);
#pragma unroll
                for (int i = 0; i < 4; ++i) acc[i] += pv * av[i]; }
            bf16_t* o = (bf16_t*)(ws + WS_WIN + (size_t)l * SZ_WIN) + (size_t)(g * 128 + 4 * d4) * D + kb * 64 + 4 * kg;
#pragma unroll
            for (int j = 0; j < 4; ++j) { u32x2 w; w.x = pk2(acc[0][j], acc[1][j]); w.y = pk2(acc[2][j], acc[3][j]); *(u32x2*)(o + (size_t)j * D) = w; }
        }
        __syncthreads();
    }
    {
        LAS float* scr = (LAS float*)(F.lds + F.wave * 16640);
        const int gw = F.vcu * NWAVES + F.wave, NGW = F.G * NWAVES, lane = F.lane;
        constexpr int J_WO = 32 * 32, J_A = 12 * 32, J_KR = 32, J_B = 24 * 32, J_DV = 12 * 32, J_UQ = 20 * 8, J_K = 12 * 4, J_V = 12 * 4;
        constexpr int J_L = J_WO + J_A + J_KR + J_B + J_DV + J_UQ + J_K + J_V;
        {
            f32x4 RA[16], RB[16]; int x = gw; XItem ia = x_item(F, x < NL * XJ_L ? x : 0), ib;
            if (x < NL * XJ_L) X_LOAD(RA, ia);
            while (x < NL * XJ_L) {
                const int x1 = x + NGW; if (x1 < NL * XJ_L) { ib = x_item(F, x1); X_LOAD(RB, ib); }
                X_OUT(RA, ia);
                if (x1 >= NL * XJ_L) break;
                const int x2 = x1 + NGW; if (x2 < NL * XJ_L) { ia = x_item(F, x2); X_LOAD(RA, ia); }
                X_OUT(RB, ib);
                x = x2;
            }
        }
        for (int it = gw; it < NL * J_L; it += NGW) {
            const int l = it / J_L; int r = it % J_L;
            const float* win = inptr(F, IN_W_IN) + (size_t)l * D * NIN;
            bf16_t* WinT = (bf16_t*)(ws + WS_WIN + (size_t)l * SZ_WIN);
            if (r < J_WO) { const int ntile = r >> 5, kt = r & 31;
                tr_item(inptr(F, IN_W_OUT) + (size_t)l * D * D, D, kt * 64, ntile * 64, (bf16_t*)(ws + WS_WOUT + (size_t)l * SZ_WOUT), D, ntile * 64, nullptr, scr, lane); continue; }
            r -= J_WO;
            if (r < J_A) { const int ntile = r >> 5, kt = r & 31;
                tr_item(win, NIN, kt * 64, 512 + ntile * 64, WinT, D, 512 + ntile * 64, nullptr, scr, lane); continue; }
            r -= J_A;
            if (r < J_KR) { const int kt = r;
                tr_item_map(win, NIN, kt * 64, 1280 + (lane >> 1) + 32 * (lane & 1), WinT, D, 1280, nullptr, scr, lane); continue; }
            r -= J_KR;
            if (r < J_B) { const int ntile = r >> 5, kt = r & 31;
                tr_item(win, NIN, kt * 64, 1344 + ntile * 64, WinT, D, 1536 + ntile * 64, nullptr, scr, lane); continue; }
            r -= J_B;
            if (r < J_DV) { const int ntile = r >> 5, kt = r & 31;
                tr_item(win, NIN, kt * 64, 2880 + ntile * 64, (bf16_t*)(ws + WS_WDV + (size_t)l * SZ_WDV), D, ntile * 64, nullptr, scr, lane); continue; }
            r -= J_DV;
            if (r < J_UQ) { const int ntile = r >> 3, kt = r & 7;
                const int n = ntile * 64 + lane; int src = -1;
                if (n < 1152) { const int hd = n / 192, w = n % 192; src = hd * 192 + (w < 128 ? w : 128 + ((w - 128) >> 1) + 32 * ((w - 128) & 1)); }
                tr_item_map(inptr(F, IN_W_UQ) + (size_t)l * 512 * 1152, 1152, kt * 64, src, (bf16_t*)(ws + WS_WUQ + (size_t)l * SZ_WUQ), 512, ntile * 64, inptr(F, IN_Q_NORM) + l * 512, scr, lane); continue; }
            r -= J_UQ;
            {
                const bool isv = r >= J_K; if (isv) r -= J_K;
                const int ntile = r >> 2, kt = r & 3, n0 = ntile * 64, hd = n0 >> 7, c0 = hd * 256 + (isv ? 128 : 0) + (n0 & 127);
                tr_item(inptr(F, IN_W_UKV) + (size_t)l * 256 * 1536, 1536, kt * 64, c0, (bf16_t*)(ws + (isv ? WS_WV : WS_WK) + (size_t)l * SZ_WK), 256, n0, inptr(F, IN_KV_NORM) + l * 256, scr, lane);
            }
        }
        for (int l = 0; l < NL; ++l) { u32x4* z = (u32x4*)((bf16_t*)(ws + WS_WIN + (size_t)l * SZ_WIN) + (size_t)1344 * D);
            for (int i = gw * 64 + lane; i < 192 * D / 8; i += NGW * 64) z[i] = (u32x4){0u, 0u, 0u, 0u}; }
        const int* pos = (const int*)inptr(F, IN_POS);
        for (int i = gw * 64 + lane; i < T * 32; i += NGW * 64) { const int t = i >> 5, f = i & 31;
            const double inv = pow(10000.0, -(double)(2 * f) / 64.0); const double ang = (double)pos[t] * inv;
            ((float*)(ws + WS_COS))[i] = (float)cos(ang); ((float*)(ws + WS_SIN))[i] = (float)sin(ang); }
        for (int i = gw * 64 + lane; i < 6 * 132; i += NGW * 64) { const int hd = i / 132, n = i % 132; float v = 0.f;
            if (n <= 128) { int bkt; if (n < 16) bkt = n; else { bkt = 16 + (int)(log((double)n / 16.0) / log(8.0) * 16.0); bkt = bkt < 31 ? bkt : 31; }
                v = inptr(F, IN_REL_BIAS)[bkt * 6 + hd] * LOG2E; }
            ((float*)(ws + WS_LUT))[i] = v; }
        for (int i = gw * 64 + lane; i < NL * 64 * D; i += NGW * 64) { const int l = i / (64 * D), c = (i / D) & 63, k = i & (D - 1); float v = 0.f;
            if (c < 4) v = inptr(F, IN_RG_W)[((size_t)l * D + k) * 4 + c]; else if (c < 36) v = inptr(F, IN_RE_W)[((size_t)l * D + k) * 32 + c - 4];
            v *= inptr(F, IN_FFN_NORM)[l * D + k];
            const unsigned hi = pk2(v, 0.f) & 0xffffu; const float rem = v - __builtin_bit_cast(float, hi << 16);
            const int fo = (((l * 8 + (k >> 8)) * 16 + ((k >> 4) & 15)) * 4 + (c >> 5)) * 512 + ((c & 31) + 32 * ((k >> 3) & 1)) * 8 + (k & 7);
            ((bf16_t*)(ws + WS_WRH))[fo] = (bf16_t)hi; ((bf16_t*)(ws + WS_WRH))[fo + 1024] = (bf16_t)(pk2(rem, 0.f) & 0xffffu); }
        for (int i = gw * 64 + lane; i < NB * 32; i += NGW * 64) { int mx = pos[i * 64]; for (int j = 1; j < 64; ++j) { const int p = pos[i * 64 + j]; mx = p > mx ? p : mx; } ((int*)(ws + WS_TMAX))[i] = mx; }
        const float* x = inptr(F, IN_X); bf16_t* h = (bf16_t*)(ws + WS_H); bf16_t* u = (bf16_t*)(ws + WS_XB); const float* gn = inptr(F, IN_ATTN_NORM);
        f32x4 g0[8];
#pragma unroll
        for (int j = 0; j < 8; ++j) g0[j] = ((const f32x4*)gn)[lane + 64 * j];
        for (int m = gw; m < T; m += NGW) {
            const f32x4* xr = (const f32x4*)(x + (size_t)m * D) + lane; u32x2* hr = (u32x2*)(h + (size_t)m * D) + lane; f32x4 v[8]; float s = 0.f;
#pragma unroll
            for (int j = 0; j < 8; ++j) v[j] = xr[64 * j];
            asm volatile("" ::: "memory");
#pragma unroll
            for (int j = 0; j < 8; ++j) { { u32x2 hw; hw.x = pk2(v[j][0], v[j][1]); hw.y = pk2(v[j][2], v[j][3]); hr[64 * j] = hw; } s += (v[j][0] * v[j][0] + v[j][1] * v[j][1]) + (v[j][2] * v[j][2] + v[j][3] * v[j][3]); }
            const float rs = 1.0f / sqrtf(wave_sum(s) * (1.0f / D) + EPS);
            u32x2* o = (u32x2*)(u + (size_t)m * D) + lane;
#pragma unroll
            for (int j = 0; j < 8; ++j) { const f32x4 gg = g0[j]; u32x2 w; w.x = pk2(v[j][0] * rs * gg[0], v[j][1] * rs * gg[1]); w.y = pk2(v[j][2] * rs * gg[2], v[j][3] * rs * gg[3]); o[64 * j] = w; }
        }
    }
}

enum { K1_ZP = 0, K1_CQ, K1_CKV, K1_KR, K1_DQ, K1_DK, K1_DVT };
struct SchedP1 {
    int G, c, l; unsigned char* ws;
    __device__ __forceinline__ bool next(int i, pg8::Unit& U) const {
        const int L = i * G + c; if (L >= 480) return false;
        const char* u = (const char*)(ws + WS_XB); const char* win = (const char*)(ws + WS_WIN + (size_t)l * SZ_WIN); const char* wdv = (const char*)(ws + WS_WDV + (size_t)l * SZ_WDV);
        U.rowmap = nullptr; U.nrows = 256; U.p3 = 0;
        if (L < 384) { int pm, pn; pg8::tile_of(L, 32, 12, pm, pn);
            U.a = u + (size_t)pm * 256 * D * 2; U.b = win + (size_t)pn * 256 * D * 2; U.p1 = 256 * pm;
            if (pn < 2) { U.p0 = K1_ZP; U.p2 = 256 * pn; } else if (pn < 4) { U.p0 = K1_CQ; U.p2 = 256 * (pn - 2); } else if (pn == 4) { U.p0 = K1_CKV; U.p2 = 0; }
            else if (pn == 5) { U.p0 = K1_KR; U.p2 = 0; } else if (pn < 9) { U.p0 = K1_DQ; U.p2 = 256 * (pn - 6); } else { U.p0 = K1_DK; U.p2 = 256 * (pn - 9); }
        } else { const int Ls = L - 384, pm = Ls % 3, pn = Ls / 3;
            U.a = wdv + (size_t)pm * 256 * D * 2; U.b = u + (size_t)pn * 256 * D * 2; U.p0 = K1_DVT; U.p1 = 256 * pm; U.p2 = 256 * pn; }
        return true;
    }
};
struct EpiP1 {
    static constexpr bool PERM = true;
    unsigned char* ws;
    __device__ __forceinline__ void operator()(const f32x4 (&acc)[2][2][4][2], const pg8::Unit& U, int wr, int wc, int fr, int fq) const {
        const int kind = U.p0, row0 = U.p1, col0 = U.p2;
        bf16_t *zp = (bf16_t*)(ws + WS_ZP), *cq = (bf16_t*)(ws + WS_CQ), *ckv = (bf16_t*)(ws + WS_CKV), *kr = (bf16_t*)(ws + WS_KR), *dq = (bf16_t*)(ws + WS_DQ), *dk = (bf16_t*)(ws + WS_DK), *dvT = (bf16_t*)(ws + WS_DVT);
        float *cqss = (float*)(ws + WS_CQSS), *ckvss = (float*)(ws + WS_CKVSS); const float *cs = (const float*)(ws + WS_COS), *sn = (const float*)(ws + WS_SIN);
        if (kind == K1_ZP) { pg8::store_tile_bf16(acc, zp, 512, row0, col0, 1.0f, wr, wc, fr, fq); }
        else if (kind == K1_CQ || kind == K1_CKV) {
            if (kind == K1_CQ) pg8::store_tile_bf16(acc, cq, 512, row0, col0, 1.0f, wr, wc, fr, fq); else pg8::store_tile_bf16(acc, ckv, 256, row0, 0, 1.0f, wr, wc, fr, fq);
            float* ss = (kind == K1_CQ) ? cqss : ckvss; const int ns = (kind == K1_CQ) ? 8 : 4, slot = (kind == K1_CQ) ? (col0 >> 8) * 4 + wc : wc;
#pragma unroll
            for (int ai = 0; ai < 2; ++ai)
#pragma unroll
                for (int m = 0; m < 4; ++m) { float s = 0.f;
#pragma unroll
                    for (int bj = 0; bj < 2; ++bj)
#pragma unroll
                        for (int n = 0; n < 2; ++n) { const f32x4 x = acc[ai][bj][m][n]; s += (x[0] * x[0] + x[1] * x[1]) + (x[2] * x[2] + x[3] * x[3]); }
                    s += xor_lt32<16>(s); s = sum32(s);
                    if (fq == 0) ss[(size_t)(row0 + ai * 128 + wr * 64 + m * 16 + fr) * ns + slot] = s; }
        }
        else if (kind == K1_KR) {
            if (wc < 2) {
#pragma unroll
                for (int ai = 0; ai < 2; ++ai) { f32x4 cb[4], sb[4];
#pragma unroll
                    for (int i = 0; i < 4; ++i) { const int row = row0 + ai * 128 + wr * 64 + i * 16 + fr; cb[i] = *(const f32x4*)(cs + (size_t)row * 32 + 16 * wc + 4 * fq); sb[i] = *(const f32x4*)(sn + (size_t)row * 32 + 16 * wc + 4 * fq); }
                    asm volatile("" ::: "memory");
#pragma unroll
                    for (int m = 0; m < 4; ++m) { const int row = row0 + ai * 128 + wr * 64 + m * 16 + fr;
                        const f32x4 c4 = cb[m], s4 = sb[m];
                        const f32x4 v0 = acc[ai][0][m][0], v1 = acc[ai][0][m][1]; u32x4 w;
                        w.x = pk2(v0[0] * c4[0] - v0[1] * s4[0], v0[0] * s4[0] + v0[1] * c4[0]); w.y = pk2(v0[2] * c4[1] - v0[3] * s4[1], v0[2] * s4[1] + v0[3] * c4[1]);
                        w.z = pk2(v1[0] * c4[2] - v1[1] * s4[2], v1[0] * s4[2] + v1[1] * c4[2]); w.w = pk2(v1[2] * c4[3] - v1[3] * s4[3], v1[2] * s4[3] + v1[3] * c4[3]);
                        *(u32x4*)(kr + (size_t)row * 64 + 32 * wc + 8 * fq) = w; asm volatile("" ::: "memory"); } }
            }
        }
        else if (kind == K1_DQ) { pg8::store_tile_bf16(acc, dq, 768, row0, col0, 0.125f * LOG2E, wr, wc, fr, fq); }
        else if (kind == K1_DK) { pg8::store_tile_bf16(acc, dk, 768, row0, col0, 1.0f, wr, wc, fr, fq); }
        else { pg8::store_tile_bf16(acc, dvT, T, row0, col0, 1.0f, wr, wc, fr, fq); }
    }
};

struct SchedQ {
    int G, c, l; unsigned char* ws;
    __device__ __forceinline__ bool next(int i, pg8::Unit& U) const {
        const int L = i * G + c; if (L >= 160) return false;
        const char* cq = (const char*)(ws + WS_CQ); const char* wuq = (const char*)(ws + WS_WUQ + (size_t)l * SZ_WUQ);
        int pm, pn; pg8::tile_of(L, 32, 5, pm, pn);
        U.a = cq + (size_t)pm * 256 * 512 * 2; U.b = wuq + (size_t)pn * 256 * 512 * 2; U.rowmap = nullptr; U.nrows = 256; U.p0 = 0; U.p1 = 256 * pm; U.p2 = 256 * pn; U.p3 = 0; return true;
    }
};
constexpr float QM_SCALE = 0.07216878364870322f * LOG2E;
struct EpiQ {
    static constexpr bool PERM = true;
    unsigned char* ws;
    __device__ __forceinline__ void operator()(const f32x4 (&acc)[2][2][4][2], const pg8::Unit& U, int wr, int wc, int fr, int fq) const {
        const int row0 = U.p1, colt = U.p2;
        bf16_t* qm = (bf16_t*)(ws + WS_QM); const float* cqss = (const float*)(ws + WS_CQSS); const float *cs = (const float*)(ws + WS_COS), *sn = (const float*)(ws + WS_SIN);
        bool isr[2], inr[2]; int i0 = 0;
#pragma unroll
        for (int bj = 0; bj < 2; ++bj) { const int cg = colt + bj * 128 + wc * 32 + 8 * fq, w = cg % 192; inr[bj] = cg < 1152; isr[bj] = inr[bj] && w >= 128; if (isr[bj]) i0 = (w - 128) >> 1; }
#pragma unroll
        for (int ai = 0; ai < 2; ++ai)
#pragma unroll
          for (int mh = 0; mh < 4; mh += 2) {
            f32x4 p0[2], p1[2], c4[2], s4[2];
#pragma unroll
            for (int m2 = 0; m2 < 2; ++m2) { const int row = row0 + ai * 128 + wr * 64 + (mh + m2) * 16 + fr;
                p0[m2] = *(const f32x4*)(cqss + (size_t)row * 8); p1[m2] = *(const f32x4*)(cqss + (size_t)row * 8 + 4); c4[m2] = *(const f32x4*)(cs + (size_t)row * 32 + i0); s4[m2] = *(const f32x4*)(sn + (size_t)row * 32 + i0); }
            asm volatile("" ::: "memory");
#pragma unroll
            for (int m2 = 0; m2 < 2; ++m2) { const int m = mh + m2; int row = row0 + ai * 128 + wr * 64 + m * 16 + fr; asm volatile("" : "+v"(row));
                const float ssum = ((p0[m2][0] + p0[m2][1]) + (p0[m2][2] + p0[m2][3])) + ((p1[m2][0] + p1[m2][1]) + (p1[m2][2] + p1[m2][3]));
                const float rs = QM_SCALE * __builtin_amdgcn_rsqf(ssum * (1.0f / 512.0f) + EPS); const f32x4 cc = c4[m2], ss = s4[m2];
#pragma unroll
                for (int bj = 0; bj < 2; ++bj) { const int cg = colt + bj * 128 + wc * 32 + 8 * fq;
                    if (inr[bj]) { const f32x4 v0 = acc[ai][bj][m][0] * rs, v1 = acc[ai][bj][m][1] * rs; u32x4 o;
                        if (isr[bj]) {
                            o.x = pk2(v0[0] * cc[0] - v0[1] * ss[0], v0[0] * ss[0] + v0[1] * cc[0]); o.y = pk2(v0[2] * cc[1] - v0[3] * ss[1], v0[2] * ss[1] + v0[3] * cc[1]);
                            o.z = pk2(v1[0] * cc[2] - v1[1] * ss[2], v1[0] * ss[2] + v1[1] * cc[2]); o.w = pk2(v1[2] * cc[3] - v1[3] * ss[3], v1[2] * ss[3] + v1[3] * cc[3]); }
                        else { o.x = pk2(v0[0], v0[1]); o.y = pk2(v0[2], v0[3]); o.z = pk2(v1[0], v1[1]); o.w = pk2(v1[2], v1[3]); }
                        *(u32x4*)(qm + (size_t)row * 1152 + cg) = o; } }
                asm volatile("" ::: "memory"); }
          }
    }
};
struct SchedKV {
    int G, c, l; unsigned char* ws;
    __device__ __forceinline__ bool next(int i, pg8::Unit& U) const {
        const int L = i * G + c; if (c < 0 || L >= 192) return false;
        const char* ckv = (const char*)(ws + WS_CKV); const char* wk = (const char*)(ws + WS_WK + (size_t)l * SZ_WK); const char* wv = (const char*)(ws + WS_WV + (size_t)l * SZ_WK);
        U.rowmap = nullptr; U.nrows = 256; U.p3 = 0;
        if (L < 96) { int pm, pn; pg8::tile_of(L, 32, 3, pm, pn); U.a = ckv + (size_t)pm * 256 * 256 * 2; U.b = wk + (size_t)pn * 256 * 256 * 2; U.p0 = 0; U.p1 = 256 * pm; U.p2 = 256 * pn; }
        else { const int Ls = L - 96, pm = Ls % 3, pn = Ls / 3; U.a = wv + (size_t)pm * 256 * 256 * 2; U.b = ckv + (size_t)pn * 256 * 256 * 2; U.p0 = 1; U.p1 = 256 * pm; U.p2 = 256 * pn; }
        return true;
    }
};
struct EpiKV {
    static constexpr bool PERM = true;
    unsigned char* ws;
    __device__ __forceinline__ float rs_of(int t) const { const float* ckvss = (const float*)(ws + WS_CKVSS); const f32x4 p = *(const f32x4*)(ckvss + (size_t)t * 4); return 1.0f / sqrtf(((p[0] + p[1]) + (p[2] + p[3])) * (1.0f / 256.0f) + EPS); }
    __device__ __forceinline__ void operator()(const f32x4 (&acc)[2][2][4][2], const pg8::Unit& U, int wr, int wc, int fr, int fq) const {
        const int row0 = U.p1, col0 = U.p2; bf16_t *kn = (bf16_t*)(ws + WS_KN), *vmT = (bf16_t*)(ws + WS_VMT);
        if (U.p0 == 0) {
            float rsb[8]; { f32x4 pv[8]; const float* ckvss = (const float*)(ws + WS_CKVSS);
#pragma unroll
              for (int i = 0; i < 8; ++i) pv[i] = *(const f32x4*)(ckvss + (size_t)(row0 + (i >> 2) * 128 + wr * 64 + (i & 3) * 16 + fr) * 4);
              asm volatile("" ::: "memory");
#pragma unroll
              for (int i = 0; i < 8; ++i) rsb[i] = __builtin_amdgcn_rsqf(((pv[i][0] + pv[i][1]) + (pv[i][2] + pv[i][3])) * (1.0f / 256.0f) + EPS); }
#pragma unroll
            for (int ai = 0; ai < 2; ++ai)
#pragma unroll
                for (int m = 0; m < 4; ++m) { int row = row0 + ai * 128 + wr * 64 + m * 16 + fr; asm volatile("" : "+v"(row)); const float rs = rsb[ai * 4 + m];
                    bf16_t* rowp = kn + (size_t)row * 768 + col0 + wc * 32 + 8 * fq;
#pragma unroll
                    for (int bj = 0; bj < 2; ++bj) { const f32x4 v0 = acc[ai][bj][m][0] * rs, v1 = acc[ai][bj][m][1] * rs;
                        u32x4 w; w.x = pk2(v0[0], v0[1]); w.y = pk2(v0[2], v0[3]); w.z = pk2(v1[0], v1[1]); w.w = pk2(v1[2], v1[3]); *(u32x4*)(rowp + bj * 128) = w; }
                    asm volatile("" ::: "memory"); }
        } else {
#pragma unroll
            for (int bj = 0; bj < 2; ++bj) { const int t0 = col0 + bj * 128 + wc * 32 + 8 * fq; float rs[8]; { f32x4 pv[8]; const float* ckvss = (const float*)(ws + WS_CKVSS);
#pragma unroll
                for (int j = 0; j < 8; ++j) pv[j] = *(const f32x4*)(ckvss + (size_t)(t0 + j) * 4);
                asm volatile("" ::: "memory");
#pragma unroll
                for (int j = 0; j < 8; ++j) rs[j] = __builtin_amdgcn_rsqf(((pv[j][0] + pv[j][1]) + (pv[j][2] + pv[j][3])) * (1.0f / 256.0f) + EPS); }
#pragma unroll
                for (int ai = 0; ai < 2; ++ai)
#pragma unroll
                    for (int m = 0; m < 4; ++m) { int row = row0 + ai * 128 + wr * 64 + m * 16 + fr; asm volatile("" : "+v"(row)); const f32x4 v0 = acc[ai][bj][m][0], v1 = acc[ai][bj][m][1];
                        u32x4 w; w.x = pk2(v0[0] * rs[0], v0[1] * rs[1]); w.y = pk2(v0[2] * rs[2], v0[3] * rs[3]); w.z = pk2(v1[0] * rs[4], v1[1] * rs[5]); w.w = pk2(v1[2] * rs[6], v1[3] * rs[7]);
                        *(u32x4*)(vmT + (size_t)row * T + t0) = w; }
                asm volatile("" ::: "memory"); }
        }
    }
};
template <int WIN> __device__ __forceinline__ void pool_load(u32x4 (&v)[WIN], const bf16_t* zrow, int cnt) {
#pragma unroll
    for (int k = 0; k < WIN; ++k) { const int kk = k < cnt ? k : 0; v[k] = *(const u32x4*)(zrow - (size_t)kk * 512); }
}
template <int WIN> __device__ __forceinline__ void pool_out(const u32x4 (&v)[WIN], bf16_t* orow, int cnt) {
    float sum[8], self[8];
#pragma unroll
    for (int j = 0; j < 4; ++j) { self[2 * j] = __builtin_bit_cast(float, v[0][j] << 16); self[2 * j + 1] = __builtin_bit_cast(float, v[0][j] & 0xffff0000u); sum[2 * j] = self[2 * j]; sum[2 * j + 1] = self[2 * j + 1]; }
#pragma unroll
    for (int k = 1; k < WIN; ++k)
#pragma unroll
        for (int j = 0; j < 4; ++j) { const unsigned w = k < cnt ? v[k][j] : 0u; sum[2 * j] += __builtin_bit_cast(float, w << 16); sum[2 * j + 1] += __builtin_bit_cast(float, w & 0xffff0000u); }
    const float ic = __builtin_amdgcn_rcpf((float)cnt); u32x4 o;
    o.x = pk2(sum[0] * ic - self[0], sum[1] * ic - self[1]); o.y = pk2(sum[2] * ic - self[2], sum[3] * ic - self[3]);
    o.z = pk2(sum[4] * ic - self[4], sum[5] * ic - self[5]); o.w = pk2(sum[6] * ic - self[6], sum[7] * ic - self[7]);
    *(u32x4*)orow = o;
}
__device__ __forceinline__ void pool_stencil(Frame& F) {
    frame_refresh(F);
    const bf16_t* zp = (const bf16_t*)(F.ws + WS_ZP); bf16_t* mix = (bf16_t*)(F.ws + WS_MIX);
    for (int q = F.vcu * NTHR + F.tid; q < T * 16; q += F.G * NTHR) {
        const int t = q >> 4, c16 = q & 15, s = t & (S - 1);
        const int c0 = (s + 1) < 2 ? (s + 1) : 2, c1 = (s + 1) < 4 ? (s + 1) : 4, c2 = (s + 1) < 8 ? (s + 1) : 8, c3 = (s + 1) < 16 ? (s + 1) : 16;
        const bf16_t* zr = zp + (size_t)t * 512 + c16 * 8; bf16_t* orow = mix + (size_t)t * D + c16 * 8;
        u32x4 v0[2], v1[4], v2[8], v3[16];
        pool_load<16>(v3, zr + 384, c3); pool_load<8>(v2, zr + 256, c2); pool_load<4>(v1, zr + 128, c1); pool_load<2>(v0, zr, c0);
        asm volatile("" ::: "memory");
        pool_out<16>(v3, orow + 384, c3); pool_out<8>(v2, orow + 256, c2); pool_out<4>(v1, orow + 128, c1); pool_out<2>(v0, orow, c0);
    }
}

constexpr int ATT_MAXU = 3;
__device__ const unsigned short att_sched[256][ATT_MAXU] = {
  {1407,1266,65535},
  {1391,1250,65535},
  {1375,1234,65535},
  {1359,1218,65535},
  {1343,1202,65535},
  {1327,1186,65535},
  {1311,1170,65535},
  {1295,1154,65535},
  {1279,1138,65535},
  {1263,1122,65535},
  {1247,1106,65535},
  {1231,1090,65535},
  {1215,1074,65535},
  {1199,1058,65535},
  {1183,1042,65535},
  {1167,1026,65535},
  {1151,1393,1265},
  {1135,1377,1249},
  {1119,1361,1233},
  {1103,1345,1217},
  {1087,1329,1201},
  {1071,1313,1185},
  {1055,1297,1169},
  {1039,1281,1153},
  {1406,241,65535},
  {1390,225,65535},
  {1374,209,65535},
  {1358,193,65535},
  {1342,177,65535},
  {1326,161,65535},
  {1310,145,65535},
  {1294,129,65535},
  {1278,113,65535},
  {1262,97,65535},
  {1246,81,65535},
  {1230,65,65535},
  {1214,49,65535},
  {1198,33,65535},
  {1182,17,65535},
  {1166,1,65535},
  {1150,1394,1137},
  {1134,1378,1121},
  {1118,1362,1105},
  {1102,1346,1089},
  {1086,1330,1073},
  {1070,1314,1057},
  {1054,1298,1041},
  {1038,1282,1025},
  {375,1267,65535},
  {359,1251,65535},
  {343,1235,65535},
  {327,1219,65535},
  {311,1203,65535},
  {295,1187,65535},
  {279,1171,65535},
  {263,1155,65535},
  {247,1139,65535},
  {231,1123,65535},
  {215,1107,65535},
  {199,1091,65535},
  {183,1075,65535},
  {167,1059,65535},
  {151,1043,65535},
  {135,1027,65535},
  {119,369,65535},
  {103,353,65535},
  {87,337,65535},
  {71,321,65535},
  {55,305,65535},
  {39,289,65535},
  {23,273,65535},
  {7,257,65535},
  {1405,1268,65535},
  {1389,1252,65535},
  {1373,1236,65535},
  {1357,1220,65535},
  {1341,1204,65535},
  {1325,1188,65535},
  {1309,1172,65535},
  {1293,1156,65535},
  {1277,1140,65535},
  {1261,1124,65535},
  {1245,1108,65535},
  {1229,1092,65535},
  {1213,1076,65535},
  {1197,1060,65535},
  {1181,1044,65535},
  {1165,1028,65535},
  {1149,1395,1392},
  {1133,1379,1376},
  {1117,1363,1360},
  {1101,1347,1344},
  {1085,1331,1328},
  {1069,1315,1312},
  {1053,1299,1296},
  {1037,1283,1280},
  {1404,242,65535},
  {1388,226,65535},
  {1372,210,65535},
  {1356,194,65535},
  {1340,178,65535},
  {1324,162,65535},
  {1308,146,65535},
  {1292,130,65535},
  {1276,114,65535},
  {1260,98,65535},
  {1244,82,65535},
  {1228,66,65535},
  {1212,50,65535},
  {1196,34,65535},
  {1180,18,65535},
  {1164,2,65535},
  {1148,1396,368},
  {1132,1380,352},
  {1116,1364,336},
  {1100,1348,320},
  {1084,1332,304},
  {1068,1316,288},
  {1052,1300,272},
  {1036,1284,256},
  {374,1269,65535},
  {358,1253,65535},
  {342,1237,65535},
  {326,1221,65535},
  {310,1205,65535},
  {294,1189,65535},
  {278,1173,65535},
  {262,1157,65535},
  {246,1141,65535},
  {230,1125,65535},
  {214,1109,65535},
  {198,1093,65535},
  {182,1077,65535},
  {166,1061,65535},
  {150,1045,65535},
  {134,1029,65535},
  {118,370,65535},
  {102,354,65535},
  {86,338,65535},
  {70,322,65535},
  {54,306,65535},
  {38,290,65535},
  {22,274,65535},
  {6,258,65535},
  {1403,1270,65535},
  {1387,1254,65535},
  {1371,1238,65535},
  {1355,1222,65535},
  {1339,1206,65535},
  {1323,1190,65535},
  {1307,1174,65535},
  {1291,1158,65535},
  {1275,1142,65535},
  {1259,1126,65535},
  {1243,1110,65535},
  {1227,1094,65535},
  {1211,1078,65535},
  {1195,1062,65535},
  {1179,1046,65535},
  {1163,1030,65535},
  {1147,1397,240},
  {1131,1381,224},
  {1115,1365,208},
  {1099,1349,192},
  {1083,1333,176},
  {1067,1317,160},
  {1051,1301,144},
  {1035,1285,128},
  {1402,243,65535},
  {1386,227,65535},
  {1370,211,65535},
  {1354,195,65535},
  {1338,179,65535},
  {1322,163,65535},
  {1306,147,65535},
  {1290,131,65535},
  {1274,115,65535},
  {1258,99,65535},
  {1242,83,65535},
  {1226,67,65535},
  {1210,51,65535},
  {1194,35,65535},
  {1178,19,65535},
  {1162,3,65535},
  {1146,1398,1264},
  {1130,1382,1248},
  {1114,1366,1232},
  {1098,1350,1216},
  {1082,1334,1200},
  {1066,1318,1184},
  {1050,1302,1168},
  {1034,1286,1152},
  {373,1271,65535},
  {357,1255,65535},
  {341,1239,65535},
  {325,1223,65535},
  {309,1207,65535},
  {293,1191,65535},
  {277,1175,65535},
  {261,1159,65535},
  {245,1143,65535},
  {229,1127,65535},
  {213,1111,65535},
  {197,1095,65535},
  {181,1079,65535},
  {165,1063,65535},
  {149,1047,65535},
  {133,1031,65535},
  {117,371,65535},
  {101,355,65535},
  {85,339,65535},
  {69,323,65535},
  {53,307,65535},
  {37,291,65535},
  {21,275,65535},
  {5,259,65535},
  {1401,1272,65535},
  {1385,1256,65535},
  {1369,1240,65535},
  {1353,1224,65535},
  {1337,1208,65535},
  {1321,1192,65535},
  {1305,1176,65535},
  {1289,1160,65535},
  {1273,1144,65535},
  {1257,1128,65535},
  {1241,1112,65535},
  {1225,1096,65535},
  {1209,1080,65535},
  {1193,1064,65535},
  {1177,1048,65535},
  {1161,1032,65535},
  {1145,1399,112},
  {1129,1383,96},
  {1113,1367,80},
  {1097,1351,64},
  {1081,1335,48},
  {1065,1319,32},
  {1049,1303,16},
  {1033,1287,0},
  {372,116,65535},
  {356,100,65535},
  {340,84,65535},
  {324,68,65535},
  {308,52,65535},
  {292,36,65535},
  {276,20,65535},
  {260,4,65535},
  {244,1400,1136},
  {228,1384,1120},
  {212,1368,1104},
  {196,1352,1088},
  {180,1336,1072},
  {164,1320,1056},
  {148,1304,1040},
  {132,1288,1024},
};
namespace att {
constexpr int VROW = 136, KBUF = 64 * 400, VBUF = 128 * VROW, BUF = KBUF + VBUF;
constexpr int LUT_OFF = 2 * BUF;
constexpr int TMAX_OFF = LUT_OFF + 3328, POS_OFF = TMAX_OFF + 512;
#define MFMA32(a, b, c) __builtin_amdgcn_mfma_f32_32x32x16_bf16((a), (b), (c), 0, 0, 0)

template <int DQK, int KEL, bool BIAS>
__device__ __forceinline__ void attn_core(LAS unsigned char* lds, int tid, int lane,
        const bf16_t* qrow, const bf16_t* kA, int ldkA, const bf16_t* kB, const bf16_t* vT, int q0, int nj, int koffB,
        const LAS int* posb, const LAS int* tmaxb, const LAS float* lut, f32x16 (&o)[4]) {
    constexpr int KROW = KEL * 2 + 16, KC = KEL / 8, NKL = KC / 8, NKS = DQK / 16;
    const int r31 = lane & 31, hh = lane >> 5;
    const int qi = q0 + r31, jd = q0 >> 6;
    bf16x8 qf[NKS];
#pragma unroll
    for (int ks = 0; ks < NKS; ++ks) qf[ks] = *(const bf16x8*)(qrow + 16 * ks + 8 * hh);
#pragma unroll
    for (int dt = 0; dt < 4; ++dt)
#pragma unroll
        for (int r = 0; r < 16; ++r) o[dt][r] = 0.f;
    float mrun = 0.f, lsum = 0.f;
    int pq = 0; if (BIAS) pq = posb[qi];
    u32x4 kreg[NKL]; u32x4 vreg[2];
#define ATT_LOAD(j) do { _Pragma("unroll") for (int _i = 0; _i < NKL; ++_i) { const int _c = tid + 512 * _i, _row = _c / KC, _ch = _c % KC; \
            const bf16_t* _s = (KEL == 192 && _ch >= 16) ? (kB + (size_t)(64 * (j) + _row) * 64 + (_ch - 16) * 8) : (kA + (size_t)(64 * (j) + _row) * ldkA + _ch * 8); kreg[_i] = *(const u32x4*)_s; } \
        _Pragma("unroll") for (int _i = 0; _i < 2; ++_i) { const int _c = tid + 512 * _i, _d = _c >> 3, _ch = _c & 7; vreg[_i] = *(const u32x4*)(vT + (size_t)_d * T + 64 * (j) + _ch * 8); } } while (0)
#define ATT_WRITE(buf) do { _Pragma("unroll") for (int _i = 0; _i < NKL; ++_i) { const int _c = tid + 512 * _i, _row = _c / KC, _ch = _c % KC; *(LAS u32x4*)((buf) + _row * KROW + _ch * 16) = kreg[_i]; } \
        _Pragma("unroll") for (int _i = 0; _i < 2; ++_i) { const int _c = tid + 512 * _i, _d = _c >> 3, _ch = _c & 7; LAS u32x2* _p = (LAS u32x2*)((buf) + KBUF + _d * VROW + _ch * 16); \
            _p[0] = (u32x2){vreg[_i].x, vreg[_i].y}; _p[1] = (u32x2){vreg[_i].z, vreg[_i].w}; } } while (0)
    ATT_LOAD(0); ATT_WRITE(lds);
    __syncthreads();
    for (int j = 0; j < nj; ++j) {
        LAS unsigned char* cur = lds + (j & 1) * BUF;
        if (j + 1 < nj) ATT_LOAD(j + 1);
        if (j <= jd) {
            bool farb = false; float c0 = -mrun;
            if (BIAS) { farb = __all(pq - tmaxb[j] >= 128); if (farb) c0 += lut[128]; }
            f32x16 s0, s1;
#pragma unroll
            for (int r = 0; r < 16; ++r) { s0[r] = c0; s1[r] = c0; }
            const LAS unsigned char* kp = cur + r31 * KROW + koffB + hh * 16;
            {
                bf16x8 kf[3][2];
#define ATT_LDK(b, g) do { kf[b][0] = *(const LAS bf16x8*)(kp + (g) * 32); kf[b][1] = *(const LAS bf16x8*)(kp + 32 * KROW + (g) * 32); } while (0)
                ATT_LDK(0, 0); ATT_LDK(1, 1);
#pragma unroll
                for (int g = 0; g < NKS; ++g) {
                    if (g + 2 < NKS) ATT_LDK((g + 2) % 3, g + 2);
                    __builtin_amdgcn_sched_barrier(0);
                    s0 = MFMA32(kf[g % 3][0], qf[g], s0); s1 = MFMA32(kf[g % 3][1], qf[g], s1);
                    __builtin_amdgcn_sched_barrier(0);
                }
#undef ATT_LDK
            }
            if (BIAS && !farb) {
#pragma unroll
                for (int r = 0; r < 16; ++r) { const int kj = 64 * j + (r & 3) + 8 * (r >> 2) + 4 * hh;
                    int r0 = pq - posb[kj], r1 = pq - posb[kj + 32]; r0 = r0 < 0 ? 0 : (r0 > 128 ? 128 : r0); r1 = r1 < 0 ? 0 : (r1 > 128 ? 128 : r1);
                    s0[r] += lut[r0]; s1[r] += lut[r1]; }
            }
            if (j == jd) {
#pragma unroll
                for (int r = 0; r < 16; ++r) { const int kj = 64 * j + (r & 3) + 8 * (r >> 2) + 4 * hh;
                    if (kj > qi) s0[r] = -__builtin_inff(); if (kj + 32 > qi) s1[r] = -__builtin_inff(); }
            }
            float mx = fmaxf(fmaxf(s0[0], s0[1]), s0[2]);
#pragma unroll
            for (int r = 3; r < 15; r += 2) mx = fmaxf(fmaxf(mx, s0[r]), s0[r + 1]);
            mx = fmaxf(mx, s0[15]);
#pragma unroll
            for (int r = 0; r < 16; r += 2) mx = fmaxf(fmaxf(mx, s1[r]), s1[r + 1]);
            mx = max32(mx);
            if (j == 0 || !__all(mx <= 8.0f)) {
                if (j != 0) mx = fmaxf(mx, 0.f);
                const float alpha = __builtin_amdgcn_exp2f(-mx);
                mrun += mx; lsum *= alpha;
#pragma unroll
                for (int dt = 0; dt < 4; ++dt)
#pragma unroll
                    for (int r = 0; r < 16; ++r) o[dt][r] *= alpha;
#pragma unroll
                for (int r = 0; r < 16; ++r) { s0[r] -= mx; s1[r] -= mx; }
            }
            float ps0 = 0.f, ps1 = 0.f;
#pragma unroll
            for (int r = 0; r < 16; ++r) { s0[r] = __builtin_amdgcn_exp2f(s0[r]); s1[r] = __builtin_amdgcn_exp2f(s1[r]); ps0 += s0[r]; ps1 += s1[r]; }
            lsum += ps0 + ps1;
            bf16x8 pb[2][2];
            { u32x4 w;
              w.x = pk2(s0[0], s0[1]); w.y = pk2(s0[2], s0[3]); w.z = pk2(s0[4], s0[5]); w.w = pk2(s0[6], s0[7]); pb[0][0] = __builtin_bit_cast(bf16x8, w);
              w.x = pk2(s0[8], s0[9]); w.y = pk2(s0[10], s0[11]); w.z = pk2(s0[12], s0[13]); w.w = pk2(s0[14], s0[15]); pb[0][1] = __builtin_bit_cast(bf16x8, w);
              w.x = pk2(s1[0], s1[1]); w.y = pk2(s1[2], s1[3]); w.z = pk2(s1[4], s1[5]); w.w = pk2(s1[6], s1[7]); pb[1][0] = __builtin_bit_cast(bf16x8, w);
              w.x = pk2(s1[8], s1[9]); w.y = pk2(s1[10], s1[11]); w.z = pk2(s1[12], s1[13]); w.w = pk2(s1[14], s1[15]); pb[1][1] = __builtin_bit_cast(bf16x8, w); }
            const LAS unsigned char* vp = cur + KBUF + r31 * VROW + hh * 8;
            {
                u32x4 vf[3][2];
#define ATT_LDV(b, g) do { _Pragma("unroll") for (int _q = 0; _q < 2; ++_q) { const LAS unsigned char* _a = vp + ((g) >> 1) * 32 * VROW + (2 * ((g) & 1) + _q) * 32; \
                           const u32x2 _lo = *(const LAS u32x2*)_a, _hi = *(const LAS u32x2*)(_a + 16); vf[b][_q] = (u32x4){_lo.x, _lo.y, _hi.x, _hi.y}; } } while (0)
                ATT_LDV(0, 0); ATT_LDV(1, 1);
#pragma unroll
                for (int g = 0; g < 8; ++g) {
                    if (g + 2 < 8) ATT_LDV((g + 2) % 3, g + 2);
                    __builtin_amdgcn_sched_barrier(0);
#pragma unroll
                    for (int q = 0; q < 2; ++q) o[g >> 1] = MFMA32(__builtin_bit_cast(bf16x8, vf[g % 3][q]), pb[g & 1][q], o[g >> 1]);
                    __builtin_amdgcn_sched_barrier(0);
                }
#undef ATT_LDV
            }
        }
        if (j + 1 < nj) ATT_WRITE(lds + ((j + 1) & 1) * BUF);
        __syncthreads();
    }
#undef ATT_LOAD
#undef ATT_WRITE
    const float lt = sum32(lsum), il = 1.0f / lt;
#pragma unroll
    for (int dt = 0; dt < 4; ++dt)
#pragma unroll
        for (int r = 0; r < 16; ++r) o[dt][r] *= il;
}

__device__ __forceinline__ void attn_phase(Frame& F, int l) {
    frame_refresh(F);
    unsigned char* ws = F.ws; LAS unsigned char* lds = F.lds;
    const bf16_t *qm = (const bf16_t*)(ws + WS_QM), *kn = (const bf16_t*)(ws + WS_KN), *kr = (const bf16_t*)(ws + WS_KR), *vmT = (const bf16_t*)(ws + WS_VMT);
    const bf16_t *dq = (const bf16_t*)(ws + WS_DQ), *dk = (const bf16_t*)(ws + WS_DK), *dvT = (const bf16_t*)(ws + WS_DVT);
    bf16_t* mix = (bf16_t*)(ws + WS_MIX);
    const int* pos = (const int*)inptr(F, IN_POS); const int* tmax = (const int*)(ws + WS_TMAX);
    LAS float* lut = (LAS float*)(lds + LUT_OFF);
    for (int i = F.tid; i < 6 * 132; i += NTHR) lut[i] = ((const float*)(ws + WS_LUT))[i];
    LAS int* tmaxl = (LAS int*)(lds + TMAX_OFF); LAS int* posl = (LAS int*)(lds + POS_OFF);
    if (F.tid < NB * 32) tmaxl[F.tid] = tmax[F.tid];
    for (int i = F.tid; i < T; i += NTHR) posl[i] = pos[i];
    float lam, lam_init;
    { const float* lv = inptr(F, IN_LAMBDA) + l * 256;
      const float d1 = wave_sum(lv[F.lane] * lv[64 + F.lane]), d2 = wave_sum(lv[128 + F.lane] * lv[192 + F.lane]);
      lam_init = 0.8f - 0.6f * expf(-0.3f * (float)l);
      lam = __builtin_bit_cast(float, __builtin_amdgcn_readfirstlane(__builtin_bit_cast(int, expf(d1) - expf(d2) + lam_init))); }
    __syncthreads();
    for (int uu = 0; uu < ATT_MAXU * ((256 + F.G - 1) / F.G); ++uu) {
        const int srow = F.bx + (uu / ATT_MAXU) * F.G, ui = uu % ATT_MAXU;
        if (srow >= 256) break;
        const int uid = (int)att_sched[srow][ui];
        if (uid == 0xFFFF) continue;
        frame_refresh(F);
        const int kind = uid >> 10, bh = (uid >> 4) & 63, qb = uid & 15, b = bh / 6, hd = bh % 6;
        const int r31 = F.lane & 31, hh = F.lane >> 5;
        f32x16 o[4];
        if (kind == 0) {
            const int q0 = 256 * qb + 32 * F.wave, t = b * S + q0 + r31;
            attn_core<192, 192, false>(lds, F.tid, F.lane, qm + (size_t)t * 1152 + hd * 192, kn + (size_t)b * S * 768 + hd * 128, 768, kr + (size_t)b * S * 64,
                                       vmT + (size_t)hd * 128 * T + b * S, q0, 4 * qb + 4, 0, nullptr, nullptr, nullptr, o);
            bf16_t* orow = mix + (size_t)t * D + 512 + hd * 128 + 4 * hh;
#pragma unroll
            for (int dt = 0; dt < 4; ++dt)
#pragma unroll
                for (int g = 0; g < 4; ++g) { u32x2 w; w.x = pk2(o[dt][4 * g], o[dt][4 * g + 1]); w.y = pk2(o[dt][4 * g + 2], o[dt][4 * g + 3]); *(u32x2*)(orow + 32 * dt + 8 * g) = w; }
        } else {
            const int map = F.wave >> 2, rg = F.wave & 3, q0 = 128 * qb + 32 * rg, t = b * S + q0 + r31;
            attn_core<64, 128, true>(lds, F.tid, F.lane, dq + (size_t)t * 768 + hd * 128 + 64 * map, dk + (size_t)b * S * 768 + hd * 128, 768, nullptr,
                                     dvT + (size_t)hd * 128 * T + b * S, q0, 2 * qb + 2, 128 * map, posl + b * S, tmaxl + b * 32, lut + hd * 132, o);
            LAS float* xch = (LAS float*)lds + (size_t)rg * 4096 + F.lane;
            if (map == 1) {
#pragma unroll
                for (int dt = 0; dt < 4; ++dt)
#pragma unroll
                    for (int r = 0; r < 16; ++r) xch[(dt * 16 + r) * 64] = o[dt][r] * lam; }
            __syncthreads();
            if (map == 0) {
                float ss = 0.f;
#pragma unroll
                for (int dt = 0; dt < 4; ++dt)
#pragma unroll
                    for (int r = 0; r < 16; ++r) { o[dt][r] -= xch[(dt * 16 + r) * 64]; ss += o[dt][r] * o[dt][r]; }
                ss = sum32(ss);
                const float rr = (1.0f - lam_init) * __builtin_amdgcn_rsqf(ss * (1.0f / 128.0f) + EPS);
                const float* sub = inptr(F, IN_SUBLN) + l * 128 + 4 * hh;
                bf16_t* orow = mix + (size_t)t * D + 1280 + hd * 128 + 4 * hh;
                f32x4 sgv[16];
#pragma unroll
                for (int i = 0; i < 16; ++i) sgv[i] = *(const f32x4*)(sub + 32 * (i >> 2) + 8 * (i & 3));
                asm volatile("" ::: "memory");
#pragma unroll
                for (int dt = 0; dt < 4; ++dt)
#pragma unroll
                    for (int g = 0; g < 4; ++g) { const f32x4 sg = sgv[dt * 4 + g]; u32x2 w;
                        w.x = pk2(o[dt][4 * g] * rr * sg[0], o[dt][4 * g + 1] * rr * sg[1]); w.y = pk2(o[dt][4 * g + 2] * rr * sg[2], o[dt][4 * g + 3] * rr * sg[3]); *(u32x2*)(orow + 32 * dt + 8 * g) = w; }
            }
            __syncthreads();
        }
    }
}
}

struct SchedOut {
    int G, c, l; unsigned char* ws;
    __device__ __forceinline__ bool next(int i, pg8::Unit& U) const {
        const int L = i * G + c; if (L >= 256) return false;
        const char* mix = (const char*)(ws + WS_MIX); const char* wout = (const char*)(ws + WS_WOUT + (size_t)l * SZ_WOUT);
        int pm, pn; pg8::tile_of(L, 32, 8, pm, pn);
        U.a = mix + (size_t)pm * 256 * D * 2; U.b = wout + (size_t)pn * 256 * D * 2; U.rowmap = nullptr; U.nrows = 256; U.p0 = 0; U.p1 = 256 * pm; U.p2 = 256 * pn; U.p3 = 0; return true;
    }
};
struct EpiOut {
    static constexpr bool PERM = true;
    unsigned char* ws;
    __device__ __forceinline__ void operator()(const f32x4 (&acc)[2][2][4][2], const pg8::Unit& U, int wr, int wc, int fr, int fq) const {
        const int row0 = U.p1 + wr * 64 + fr, col0 = U.p2 + wc * 32 + 8 * fq; const bf16_t* h = (const bf16_t*)(ws + WS_H); bf16_t* h2 = (bf16_t*)(ws + WS_H2);
        u32x4 hv[2][4][2];
#pragma unroll
        for (int ai = 0; ai < 2; ++ai)
#pragma unroll
            for (int m = 0; m < 4; ++m)
#pragma unroll
                for (int bj = 0; bj < 2; ++bj) hv[ai][m][bj] = *(const u32x4*)(h + (size_t)(row0 + ai * 128 + m * 16) * D + col0 + bj * 128);
        asm volatile("" ::: "memory");
#pragma unroll
        for (int ai = 0; ai < 2; ++ai)
#pragma unroll
            for (int m = 0; m < 4; ++m) { const size_t ro = (size_t)(row0 + ai * 128 + m * 16) * D + col0;
#pragma unroll
                for (int bj = 0; bj < 2; ++bj) { const u32x4 hw = hv[ai][m][bj];
                    const f32x4 v0 = unpk4((u32x2){hw.x, hw.y}) + acc[ai][bj][m][0], v1 = unpk4((u32x2){hw.z, hw.w}) + acc[ai][bj][m][1];
                    u32x4 w; w.x = pk2(v0[0], v0[1]); w.y = pk2(v0[2], v0[3]); w.z = pk2(v1[0], v1[1]); w.w = pk2(v1[2], v1[3]); *(u32x4*)(h2 + ro + bj * 128) = w; }
                asm volatile("" ::: "memory"); }
    }
};

__device__ __forceinline__ void router_phase(Frame& F, int l) {
    frame_refresh(F);
    unsigned char* ws = F.ws; LAS unsigned char* lds = F.lds;
    const bf16_t* h = (const bf16_t*)(ws + WS_H2); bf16_t* xn = (bf16_t*)(ws + WS_XB);
    const float* gain = inptr(F, IN_FFN_NORM) + l * D;

    const float* bg = inptr(F, IN_RG_B) + l * 4; const float* be = inptr(F, IN_RE_B) + l * 32;
    unsigned* cnt = F.ctl + CW_CNT + 2048 * l; int* list = (int*)(ws + WS_LIST); float* gwt = (float*)(ws + WS_GW);
    const int lane = F.lane, w = F.wave, r31 = lane & 31, hh = lane >> 5;
    LAS float* part = (LAS float*)lds;
    LAS float* ssqp = (LAS float*)(lds + 65536);
    LAS float* rsv = (LAS float*)(lds + 65536 + 2048);
    LAS float* lg = (LAS float*)(lds + 65536 + 4096);
    for (int tile = F.bx; tile < T / 32; tile += F.G) {
        const int t0 = tile * 32;
        { const bf16_t* xrow = h + (size_t)(t0 + r31) * D + 256 * w + 8 * hh;
          const unsigned char* wb = ws + WS_WRH + ((size_t)l * 8 + w) * 65536; const unsigned lo16 = (unsigned)lane * 16u;
          f32x16 a0, a1; float ssq = 0.f;
#pragma unroll
          for (int r = 0; r < 16; ++r) { a0[r] = 0.f; a1[r] = 0.f; }
#pragma unroll
          for (int kc = 0; kc < 16; kc += 4) {
              bf16x8 wh0[4], wh1[4], wl0[4], wl1[4]; u32x4 xw[16];
#pragma unroll
              for (int q = 0; q < 4; ++q) xw[kc + q] = *(const u32x4*)(xrow + 16 * (kc + q));
#pragma unroll
              for (int q = 0; q < 4; ++q) { GAS const unsigned char* wq_ = (GAS const unsigned char*)wb + (kc + q) * 4096; asm volatile("" : "+s"(wq_)); const unsigned char* wq = (const unsigned char*)wq_;
                  wh0[q] = *(const bf16x8*)(wq + lo16); wh1[q] = *(const bf16x8*)(wq + 1024 + lo16); wl0[q] = *(const bf16x8*)(wq + 2048 + lo16); wl1[q] = *(const bf16x8*)(wq + 3072 + lo16); }
              asm volatile("" ::: "memory");
#pragma unroll
              for (int q = 0; q < 4; ++q) { const u32x4 xv = xw[kc + q];
                  const f32x4 xa = unpk4((u32x2){xv.x, xv.y}), xb = unpk4((u32x2){xv.z, xv.w});
                  ssq += (xa[0] * xa[0] + xa[1] * xa[1]) + (xa[2] * xa[2] + xa[3] * xa[3]) + (xb[0] * xb[0] + xb[1] * xb[1]) + (xb[2] * xb[2] + xb[3] * xb[3]);
                  const bf16x8 xh = __builtin_bit_cast(bf16x8, xv);
                  a0 = MFMA32(xh, wh0[q], a0); a0 = MFMA32(xh, wl0[q], a0);
                  a1 = MFMA32(xh, wh1[q], a1); a1 = MFMA32(xh, wl1[q], a1); } }
          __syncthreads();
#pragma unroll
          for (int r = 0; r < 16; ++r) { const int tk = (r & 3) + 8 * (r >> 2) + 4 * hh; part[(w * 32 + tk) * 64 + r31] = a0[r]; part[(w * 32 + tk) * 64 + 32 + r31] = a1[r]; }
          ssqp[(w * 2 + hh) * 32 + r31] = ssq; }
        __syncthreads();
        if (F.tid < 32) { float s = 0.f;
#pragma unroll
            for (int q = 0; q < 16; ++q) s += ssqp[q * 32 + F.tid];
            rsv[F.tid] = 1.0f / sqrtf(s * (1.0f / D) + EPS); }
        __syncthreads();
        for (int idx = F.tid; idx < 32 * 36; idx += NTHR) { const int tk = idx / 36, c = idx - tk * 36; float s = 0.f;
#pragma unroll
            for (int q = 0; q < 8; ++q) s += part[(q * 32 + tk) * 64 + c];
            lg[tk * 40 + c] = s * rsv[tk] + (c < 4 ? bg[c] : be[c - 4]); }
        { f32x4 gg[8]; u32x2 xv[4][8];
#pragma unroll
          for (int j = 0; j < 8; ++j) gg[j] = ((const f32x4*)gain)[lane + 64 * j];
#pragma unroll
          for (int q = 0; q < 4; ++q) { const u32x2* xr = (const u32x2*)(h + (size_t)(t0 + 4 * w + q) * D) + lane;
#pragma unroll
              for (int j = 0; j < 8; ++j) xv[q][j] = xr[64 * j]; }
          asm volatile("" ::: "memory");
#pragma unroll
          for (int q = 0; q < 4; ++q) { const int t = t0 + 4 * w + q; const float rs = rsv[4 * w + q]; u32x2* o = (u32x2*)(xn + (size_t)t * D) + lane;
#pragma unroll
              for (int j = 0; j < 8; ++j) { const f32x4 v = unpk4(xv[q][j]) * rs * gg[j]; u32x2 wv; wv.x = pk2(v[0], v[1]); wv.y = pk2(v[2], v[3]); o[64 * j] = wv; } } }
        __syncthreads();
        if (F.tid < 32) { const int t = t0 + F.tid; const LAS float* L = lg + F.tid * 40;
            int gi = 0; float gm = L[0];
            for (int c = 1; c < 4; ++c) { const float v = L[c]; if (v > gm) { gm = v; gi = c; } }
            float gs = 0.f; for (int c = 0; c < 4; ++c) gs += expf(L[c] - gm);
            const float ggate = 1.0f / gs; const LAS float* E8 = L + 4 + 8 * gi;
            int i0 = 0; float m0 = E8[0];
            for (int q = 1; q < 8; ++q) { const float v = E8[q]; if (v > m0) { m0 = v; i0 = q; } }
            int i1 = -1; float m1 = -__builtin_inff();
            for (int q = 0; q < 8; ++q) { const float v = E8[q]; if (q != i0 && v > m1) { m1 = v; i1 = q; } }
            const float p0 = 1.0f / (1.0f + expf(m1 - m0)), p1 = 1.0f - p0;
            const int e0 = gi * 8 + i0, e1 = gi * 8 + i1;
            LAS unsigned* lcnt = (LAS unsigned*)(lds + 65536 + 4096 + 5120); LAS unsigned* lbase = lcnt + 32;
            lcnt[F.tid] = 0u; LDS_WAIT();
            const unsigned r0 = __hip_atomic_fetch_add(lcnt + e0, 1u, __ATOMIC_RELAXED, __HIP_MEMORY_SCOPE_WORKGROUP);
            const unsigned r1 = __hip_atomic_fetch_add(lcnt + e1, 1u, __ATOMIC_RELAXED, __HIP_MEMORY_SCOPE_WORKGROUP);
            LDS_WAIT();
            { const unsigned n = lcnt[F.tid]; unsigned bs = 0u; if (n) bs = atomicAdd(cnt + 64 * F.tid, n); lbase[F.tid] = bs; }
            LDS_WAIT();
            const unsigned slot0 = lbase[e0] + r0, slot1 = lbase[e1] + r1;
            list[e0 * LISTCAP + slot0] = t * 2; list[e1 * LISTCAP + slot1] = t * 2 + 1;
            *(f32x2*)(gwt + t * 2) = (f32x2){ggate * p0, ggate * p1}; }
    }
    __syncthreads();
}

__device__ __forceinline__ void moe_tables(Frame& F, int l) {
    frame_refresh(F);
    __syncthreads();
    if (F.tid < NE) F.MISC[112 + F.tid] = (F.ctl + CW_CNT + 2048 * l)[64 * F.tid];
    __syncthreads();
    if (F.tid < NE) { const LAS unsigned* C = (const LAS unsigned*)F.MISC + 112; const int e = F.tid;
        const int c = (int)C[e], nfull = c >> 8, part = c & 255;
        int fpre = 0, spre = 0, ftot = 0, ptot = 0, rank = 0;
#pragma unroll 8
        for (int q = 0; q < NE; ++q) { const int cq = (int)C[q], fq = cq >> 8, pq = cq & 255;
            ftot += fq; ptot += (pq != 0); if (q < e) { fpre += fq; spre += cq; }
            rank += (pq > part || (pq == part && q < e)) ? 1 : 0; }
        for (int mt = 0; mt < nfull; ++mt) F.MISC[256 + fpre + mt] = (unsigned)(e | (mt << 8));
        if (part != 0) F.MISC[256 + ftot + rank] = (unsigned)(e | (nfull << 8));
        F.MISC[64 + e] = (unsigned)spre;
        if (e == 0) F.MISC[16 + NE] = (unsigned)(ftot + ptot); }
    __syncthreads();
}
__device__ __forceinline__ int moe_rank4(int c, int G) { if (G % 32 != 0 || c < 0) return c; const int x = c & 7, r = c >> 3; return (((G >> 5) * x + (r >> 2)) << 2) | (r & 3); }
__device__ __forceinline__ int moe_rank8(int c, int G) { if (G % 64 != 0 || c < 0) return c; const int x = c & 7, r = c >> 3; return (((G >> 6) * x + (r >> 3)) << 3) | (r & 7); }
struct SchedMoE {
    int G, c, l; bool down; volatile LAS unsigned* M; unsigned char* ws; int Lb, Le;
    __device__ __forceinline__ bool next(int i, pg8::Unit& U) const {
        const int L = Lb + i * G + c;
        if (c < 0 || L >= Le) return false;
        return make(L, U);
    }
    __device__ __forceinline__ bool make(int L, pg8::Unit& U) const {
        const int ntn = down ? 8 : 4; const char* abase = (const char*)(ws + (down ? WS_ACT : WS_XB));
        const char* wbase = (const char*)(ws + (down ? WS_WD + (size_t)l * NE * SZ_WD1 : WS_WGU + (size_t)l * NE * SZ_WGU1));
        const size_t wstride = down ? SZ_WD1 : SZ_WGU1, tstride = down ? (size_t)256 * EH * 2 : (size_t)256 * D * 2; const int* list = (const int*)(ws + WS_LIST);
        const int TR = (int)M[16 + NE]; const int rt = L / ntn, nt = L - rt * ntn;
        if (rt >= TR) return false;
        const int ent = __builtin_amdgcn_readfirstlane((int)M[256 + rt]), e = ent & 255, mt = ent >> 8;
        const int cnt = (int)M[112 + e], slot0 = (int)M[64 + e] + 256 * mt; int nv = cnt - 256 * mt; nv = nv > 256 ? 256 : nv;
        U.nrows = __builtin_amdgcn_readfirstlane(nv); U.p0 = rt; U.p1 = U.nrows; U.p3 = nt;
        U.b = wbase + (size_t)e * wstride + (size_t)nt * tstride;
        if (down) { U.a = abase + (size_t)__builtin_amdgcn_readfirstlane(slot0) * EH * 2; U.rowmap = nullptr; U.p2 = e * LISTCAP + 256 * mt; }
        else { U.a = abase; U.rowmap = list + e * LISTCAP + 256 * mt; U.p2 = __builtin_amdgcn_readfirstlane(slot0); }
        return true;
    }
};
struct EpiGU {
    static constexpr bool PERM = true;
    unsigned char* ws; int l;
    __device__ __forceinline__ void operator()(const f32x4 (&acc)[2][2][4][2], const pg8::Unit& U, int wr, int wc, int fr, int fq) const {
        const int nv = U.p1, slot0 = U.p2, nt = U.p3; bf16_t* act = (bf16_t*)(ws + WS_ACT);
#pragma unroll
        for (int ai = 0; ai < 2; ++ai)
#pragma unroll
            for (int m = 0; m < 4; ++m) { const int r = ai * 128 + wr * 64 + m * 16 + fr;
                if (r < nv) { float o[8];
#pragma unroll
                    for (int n = 0; n < 2; ++n)
#pragma unroll
                        for (int e = 0; e < 4; ++e) { const float gt = acc[ai][0][m][n][e], up = acc[ai][1][m][n][e]; o[4 * n + e] = gt * up * __builtin_amdgcn_rcpf(1.0f + __builtin_amdgcn_exp2f(-gt * LOG2E)); }
                    const unsigned long long w0 = (unsigned long long)pk2(o[0], o[1]) | ((unsigned long long)pk2(o[2], o[3]) << 32), w1 = (unsigned long long)pk2(o[4], o[5]) | ((unsigned long long)pk2(o[6], o[7]) << 32);
                    GAS unsigned long long* dp = (GAS unsigned long long*)(act + (size_t)(slot0 + r) * EH + nt * 128 + wc * 32 + 8 * fq);
                    __hip_atomic_store(dp, w0, __ATOMIC_RELAXED, __HIP_MEMORY_SCOPE_AGENT); __hip_atomic_store(dp + 1, w1, __ATOMIC_RELAXED, __HIP_MEMORY_SCOPE_AGENT); } }
        asm volatile("s_waitcnt vmcnt(0)" ::: "memory");
        if ((fr | fq) == 0) { GAS unsigned* rdy = (GAS unsigned*)(ws + WS_CTL) + CW_RDY + 8192 * l + 64 * U.p0; __hip_atomic_fetch_add(rdy, 1u, __ATOMIC_RELAXED, __HIP_MEMORY_SCOPE_AGENT); }
    }
};
struct SchedDown2 {
    SchedMoE B; int ind, rem, nd;
    __device__ __forceinline__ bool next(int i, pg8::Unit& U) const {
        const int G = B.G, c = B.c, N1 = G - rem; int Lu;
        if (c >= rem) { const int j = c - rem, nind = (j < ind) ? (ind - j + N1 - 1) / N1 : 0;
            if (i < nind) Lu = j + i * N1;
            else { const int d = (rem + (N1 - 1 - j)) + (i - nind) * G; if (d >= nd - ind) return false; Lu = ind + d; } }
        else { const int d = c + i * G; if (d >= nd - ind) return false; Lu = ind + d; }
        return B.make(Lu, U);
    }
    __device__ __forceinline__ void a_ready(const pg8::Unit& U) const {
        if (__builtin_amdgcn_readfirstlane((int)(threadIdx.x >> 6)) == 0) {
            GAS unsigned* ctl = (GAS unsigned*)(B.ws + WS_CTL); GAS unsigned* rdy = ctl + CW_RDY + 8192 * B.l + 64 * U.p0; unsigned sp = 0u;
            while ((unsigned)__builtin_amdgcn_readfirstlane((int)__hip_atomic_load(rdy, __ATOMIC_RELAXED, __HIP_MEMORY_SCOPE_AGENT)) < 32u) {
                __builtin_amdgcn_s_sleep(2);
                if ((++sp & 255u) == 0u) { if (__hip_atomic_load(ctl + CW_TMO, __ATOMIC_RELAXED, __HIP_MEMORY_SCOPE_AGENT) != 0u) break;
                    if (sp > (1u << 18)) { __hip_atomic_store(ctl + CW_TMO, 1u, __ATOMIC_RELAXED, __HIP_MEMORY_SCOPE_AGENT); break; } } }
            __builtin_amdgcn_fence(__ATOMIC_ACQUIRE, "agent");
            asm volatile("s_waitcnt vmcnt(0)" ::: "memory");
        }
        asm volatile("" ::: "memory"); __builtin_amdgcn_s_barrier(); asm volatile("" ::: "memory");
    }
};
struct EpiDown {
    static constexpr bool PERM = true;
    unsigned char* ws;
    __device__ __forceinline__ void operator()(const f32x4 (&acc)[2][2][4][2], const pg8::Unit& U, int wr, int wc, int fr, int fq) const {
        const int nv = U.p1, lbase = U.p2, col0 = U.p3 * 256 + wc * 32 + 8 * fq;
        bf16_t *y1 = (bf16_t*)(ws + WS_Y1), *y2 = (bf16_t*)(ws + WS_Y2); const int* list = (const int*)(ws + WS_LIST); const float* gwt = (const float*)(ws + WS_GW);
        int ent[8]; float g[8];
#pragma unroll
        for (int i = 0; i < 8; ++i) { const int r = (i >> 2) * 128 + wr * 64 + (i & 3) * 16 + fr; ent[i] = list[lbase + (r < nv ? r : 0)]; }
#pragma unroll
        for (int i = 0; i < 8; ++i) g[i] = gwt[ent[i]];
#pragma unroll
        for (int i = 0; i < 8; ++i) asm volatile("" : "+v"(g[i]), "+v"(ent[i]));
        asm volatile("" ::: "memory");
#pragma unroll
        for (int ai = 0; ai < 2; ++ai)
#pragma unroll
            for (int m = 0; m < 4; ++m) { const int e1 = ent[ai * 4 + m]; const float gg = g[ai * 4 + m];
                if (ai * 128 + wr * 64 + m * 16 + fr < nv) { const int tok = e1 >> 1;
                    bf16_t* rowp = ((e1 & 1) ? y2 : y1) + (size_t)tok * D + col0;
#pragma unroll
                    for (int bj = 0; bj < 2; ++bj) { const f32x4 v0 = acc[ai][bj][m][0] * gg, v1 = acc[ai][bj][m][1] * gg;
                        u32x4 w; w.x = pk2(v0[0], v0[1]); w.y = pk2(v0[2], v0[3]); w.z = pk2(v1[0], v1[1]); w.w = pk2(v1[2], v1[3]); *(u32x4*)(rowp + bj * 128) = w; } }
                asm volatile("" ::: "memory"); }
    }
};

__device__ __forceinline__ void combine_phase(Frame& F, float* outp, int l) {
    frame_refresh(F);
    unsigned char* ws = F.ws; bf16_t* h = (bf16_t*)(ws + WS_H); const bf16_t* h2 = (const bf16_t*)(ws + WS_H2); const bf16_t* y1 = (const bf16_t*)(ws + WS_Y1); const bf16_t* y2 = (const bf16_t*)(ws + WS_Y2); bf16_t* u = (bf16_t*)(ws + WS_XB);
    const bool lastl = (l == NL - 1); const float* gain = lastl ? inptr(F, IN_FINAL_NORM) : inptr(F, IN_ATTN_NORM) + (l + 1) * D;
    const int gw = F.vcu * NWAVES + F.wave, NGW = F.G * NWAVES, lane = F.lane;
    f32x4 gg[8];
#pragma unroll
    for (int j = 0; j < 8; ++j) gg[j] = ((const f32x4*)gain)[lane + 64 * j];
#define CMB_LOAD(A, B, C, mm) do { const u32x2* h2r_ = (const u32x2*)(h2 + (size_t)(mm) * D) + lane; const u32x2* y1r_ = (const u32x2*)(y1 + (size_t)(mm) * D) + lane; const u32x2* y2r_ = (const u32x2*)(y2 + (size_t)(mm) * D) + lane; \
        _Pragma("unroll") for (int j = 0; j < 8; ++j) { A[j] = h2r_[64 * j]; B[j] = y1r_[64 * j]; C[j] = y2r_[64 * j]; } } while (0)
#define CMB_ROW(A, B, C, mm) do { f32x4 v[8]; float s = 0.f; \
        _Pragma("unroll") for (int j = 0; j < 8; ++j) { v[j] = unpk4(A[j]) + (unpk4(B[j]) + unpk4(C[j])); s += (v[j][0] * v[j][0] + v[j][1] * v[j][1]) + (v[j][2] * v[j][2] + v[j][3] * v[j][3]); } \
        const float rs = 1.0f / sqrtf(wave_sum(s) * (1.0f / D) + EPS); \
        if (lastl) { f32x4* o = (f32x4*)(outp + (size_t)(mm) * D) + lane; \
            _Pragma("unroll") for (int j = 0; j < 8; ++j) o[64 * j] = v[j] * rs * gg[j]; } \
        else { u32x2* hr = (u32x2*)(h + (size_t)(mm) * D) + lane; u32x2* o = (u32x2*)(u + (size_t)(mm) * D) + lane; \
            _Pragma("unroll") for (int j = 0; j < 8; ++j) { { u32x2 hw; hw.x = pk2(v[j][0], v[j][1]); hw.y = pk2(v[j][2], v[j][3]); hr[64 * j] = hw; } \
                u32x2 w; w.x = pk2(v[j][0] * rs * gg[j][0], v[j][1] * rs * gg[j][1]); w.y = pk2(v[j][2] * rs * gg[j][2], v[j][3] * rs * gg[j][3]); o[64 * j] = w; } } } while (0)
    for (int m = gw; m < T; m += 2 * NGW) {
        const int m1 = m + NGW; const bool has1 = m1 < T;
        u32x2 A0[8], B0[8], C0[8], A1[8], B1[8], C1[8];
        CMB_LOAD(A0, B0, C0, m); CMB_LOAD(A1, B1, C1, has1 ? m1 : m);
        asm volatile("" ::: "memory");
        CMB_ROW(A0, B0, C0, m);
        if (has1) CMB_ROW(A1, B1, C1, m1);
    }
#undef CMB_LOAD
#undef CMB_ROW
}

__global__ void __launch_bounds__(NTHR, 2) hymba_fwd(Args args) {
    extern __shared__ __attribute__((aligned(16))) unsigned char lds_raw[];
    Frame F;
    F.lds = (LAS unsigned char*)lds_raw; F.MISC = (volatile LAS unsigned*)(F.lds + LDS_MISC);
    F.tid = threadIdx.x; F.lane = F.tid & 63; F.wave = __builtin_amdgcn_readfirstlane(F.tid >> 6);
    F.G = gridDim.x; F.bx = blockIdx.x; F.vcu = (F.G % 8 == 0) ? (F.bx % 8) * (F.G / 8) + F.bx / 8 : F.bx;
    F.ws = args.ws; F.ws0 = args.ws; F.ctl = (unsigned*)(args.ws + WS_CTL);
    unsigned char* ws = args.ws;
    for (int i = F.tid; i < 192; i += NTHR) F.MISC[i] = 0u;
    if (F.tid < 46) F.MISC[MISC_PTAB + F.tid] = ((const __attribute__((address_space(4))) unsigned*)__builtin_amdgcn_kernarg_segment_ptr())[F.tid];
    float* const outp = args.out; const int use_bar = args.use_bar;
    __syncthreads();
    XcdBarrier bar; bar.bar = F.ctl + CW_BAR; bar.x = 0; bar.st = F.MISC;
    if (use_bar) bar = xcd_barrier_post(F.ctl + CW_BAR, F.MISC);
    const int lo = args.g_lo, hi = args.g_hi;
#define IN(k) (lo <= (k) && (k) < hi)
#define GRIDBAR() do { if (use_bar) { XcdBarrier bb_ = bar; GAS unsigned* bp_ = (GAS unsigned*)bar.bar; asm volatile("" : "+s"(bp_), "+s"(bb_.x)); bb_.bar = (unsigned*)bp_; xcd_barrier(bb_); } } while (0)
#define SEAM(k) do { if (IN((k) + 1)) GRIDBAR(); } while (0)
#define PHASE_LOCALS() frame_refresh(F); int bxo = F.bx, Go = F.G; GAS unsigned char* wsg_ = (GAS unsigned char*)ws; asm volatile("" : "+s"(bxo), "+s"(Go), "+s"(wsg_)); unsigned char* wso = (unsigned char*)wsg_

    if (IN(0)) { for (int rep_ = 0; rep_ < DUPN(0); ++rep_) { if (rep_) GRIDBAR(); p0_prologue(F); } SEAM(0); }

    for (int l = 0; l < NL; ++l) {
        const int g0 = 1 + 9 * l;
        if (lo >= g0 + 9 || hi <= g0) continue;
        if (IN(g0)) for (int rep_ = 0; rep_ < DUPN(1); ++rep_) {
            if (rep_) GRIDBAR();
            PHASE_LOCALS();
            const pg8::Gemm g{D, D, D};
            const SchedP1 Sc{Go, bxo, l, wso};
            const EpiP1 E{wso};
            pg8::gemm_phase<EpiP1, SchedP1, false>(F.lds, g, Sc, E);
            if (rep_ == DUPN(1) - 1) SEAM(g0);
        }
        if (IN(g0 + 1)) for (int rep_ = 0; rep_ < DUPN(2); ++rep_) {
            if (rep_) GRIDBAR();
            { PHASE_LOCALS(); const pg8::Gemm g{512, 512, 512};
              const SchedQ Sc{Go, bxo, l, wso};
              const EpiQ E{wso};
              pg8::gemm_phase<EpiQ, SchedQ, false>(F.lds, g, Sc, E); }
            { PHASE_LOCALS(); const pg8::Gemm g{256, 256, 256};
              const SchedKV Sc{Go == 256 ? 96 : Go, Go == 256 ? bxo - 160 : bxo, l, wso};
              const EpiKV E{wso};
              pg8::gemm_phase<EpiKV, SchedKV, false>(F.lds, g, Sc, E); }
            pool_stencil(F);
            if (rep_ == DUPN(2) - 1) SEAM(g0 + 1);
        }
        if (IN(g0 + 2)) { for (int rep_ = 0; rep_ < DUPN(3); ++rep_) { if (rep_) GRIDBAR(); att::attn_phase(F, l); } SEAM(g0 + 2); }
        if (IN(g0 + 3)) for (int rep_ = 0; rep_ < DUPN(4); ++rep_) {
            if (rep_) GRIDBAR();
            PHASE_LOCALS();
            const pg8::Gemm g{D, D, D};
            const SchedOut Sc{Go, bxo, l, wso};
            const EpiOut E{wso};
            pg8::gemm_phase<EpiOut, SchedOut, false>(F.lds, g, Sc, E);
            if (rep_ == DUPN(4) - 1) SEAM(g0 + 3);
        }
        if (IN(g0 + 4)) { for (int rep_ = 0; rep_ < DUPN(5); ++rep_) {
                if (rep_) { GRIDBAR(); if (F.bx == 0 && F.tid < NE) F.ctl[CW_CNT + 2048 * l + 64 * F.tid] = 0u; GRIDBAR(); }
                router_phase(F, l); }
            SEAM(g0 + 4); }
        if (IN(g0 + 5)) {
            moe_tables(F, l);
            { PHASE_LOCALS();
              const int U6 = (int)F.MISC[16 + NE] * 4;
              const pg8::Gemm g{D, D, D};
              const SchedMoE Sc{Go, moe_rank4(bxo, Go), l, false, F.MISC, wso, 0, U6};
              const EpiGU E{wso, l};
              pg8::gemm_phase<EpiGU, SchedMoE, true>(F.lds, g, Sc, E); }
            { PHASE_LOCALS();
              const int TR = (int)F.MISC[16 + NE], U6 = TR * 4, ND = TR * 8;
              const bool fast = (U6 >= Go && U6 - Go <= Go / 2 && Go % 4 == 0);
              const pg8::Gemm g{EH, EH, EH};
              const SchedDown2 Sc{SchedMoE{Go, moe_rank4(bxo, Go), l, true, F.MISC, wso, 0, 0x7fffffff}, fast ? 2 * Go : 0, fast ? U6 - Go : Go, ND};
              const EpiDown E{wso};
              pg8::gemm_phase<EpiDown, SchedDown2, false, true>(F.lds, g, Sc, E); }
            SEAM(g0 + 5);
        }
        if (IN(g0 + 8)) { for (int rep_ = 0; rep_ < DUPN(8); ++rep_) { if (rep_) GRIDBAR(); combine_phase(F, outp, l); } SEAM(g0 + 8); }
    }
}


#ifndef DBG_CHECK
#define DBG_CHECK 0
#endif
#if DBG_CHECK
constexpr int CW_CHK = 20000;
__device__ inline double dbf(const bf16_t* p, size_t i) { return (double)bf2f(p[i]); }
__device__ inline unsigned hsh(unsigned x) { x ^= x >> 16; x *= 0x7feb352du; x ^= x >> 15; x *= 0x846ca68bu; x ^= x >> 16; return x; }
__device__ inline bool bad(double got, double ref, double scale) { const double e = fabs(got - ref); return !(e <= 0.03 * fabs(ref) + 0.03 * scale); }
__global__ void dbg_check(Args A, int which) {
    unsigned char* ws = A.ws; unsigned* chk = (unsigned*)(ws + WS_CTL) + CW_CHK;
    const int sid = blockIdx.x * blockDim.x + threadIdx.x; const unsigned r0 = hsh(sid * 2654435761u + which * 97u + 12345u), r1 = hsh(r0 + 1u), r2 = hsh(r1 + 7u);
    const float* x = A.in[IN_X]; const int* pos = (const int*)A.in[IN_POS];
    const bf16_t* u = (const bf16_t*)(ws + WS_XB); const float* win = A.in[IN_W_IN];
    double* dscr = (double*)(ws + WS_END) + (size_t)sid * 512;
    const int t = r0 % T; bool b = false; int code = which;
    if (which == 0) {
        const int k = r1 % D; double ss = 0; for (int i = 0; i < D; ++i) ss += (double)x[(size_t)t * D + i] * x[(size_t)t * D + i];
        const double ref = x[(size_t)t * D + k] / sqrt(ss / D + 1e-6) * A.in[IN_ATTN_NORM][k]; b = bad(dbf(u, (size_t)t * D + k), ref, 1.0);
    } else if (which >= 1 && which <= 7) {
        auto proj = [&](int col) { double s = 0; for (int k = 0; k < D; ++k) s += dbf(u, (size_t)t * D + k) * (double)win[(size_t)k * NIN + col]; return s; };
        if (which == 1) { const int n = r1 % 512, g = n >> 7, d = n & 127; double s = 0;
            for (int c = 0; c < 128; ++c) s += proj(g * 128 + c) * (double)A.in[IN_POOL_W][(size_t)(g * 128 + c) * 128 + d];
            s *= A.in[IN_POOL_SCALE][n]; b = bad(dbf((const bf16_t*)(ws + WS_ZP), (size_t)t * 512 + n), s, 1.0); }
        if (which == 2) { const int n = r1 % 512; b = bad(dbf((const bf16_t*)(ws + WS_CQ), (size_t)t * 512 + n), proj(512 + n), 1.0);
            if ((sid & 7) == 0) { double ss = 0; for (int c = 0; c < 512; ++c) { const double v = dbf((const bf16_t*)(ws + WS_CQ), (size_t)t * 512 + c); ss += v * v; }
                double got = 0; for (int c = 0; c < 8; ++c) got += ((const float*)(ws + WS_CQSS))[(size_t)t * 8 + c]; b = b || bad(got, ss, 1.0); } }
        if (which == 3) { const int n = r1 % 256; b = bad(dbf((const bf16_t*)(ws + WS_CKV), (size_t)t * 256 + n), proj(1024 + n), 1.0);
            if ((sid & 7) == 0) { double ss = 0; for (int c = 0; c < 256; ++c) { const double v = dbf((const bf16_t*)(ws + WS_CKV), (size_t)t * 256 + c); ss += v * v; }
                double got = 0; for (int c = 0; c < 4; ++c) got += ((const float*)(ws + WS_CKVSS))[(size_t)t * 4 + c]; b = b || bad(got, ss, 1.0); } }
        if (which == 4) { const int i = r1 % 32, p = r2 & 1; const double x1 = proj(1280 + i), x2 = proj(1280 + 32 + i), ang = (double)pos[t] * pow(10000.0, -(double)(2 * i) / 64.0);
            const double ref = p ? x1 * sin(ang) + x2 * cos(ang) : x1 * cos(ang) - x2 * sin(ang); b = bad(dbf((const bf16_t*)(ws + WS_KR), (size_t)t * 64 + 2 * i + p), ref, 1.0); }
        if (which == 5) { const int n = r1 % 768; b = bad(dbf((const bf16_t*)(ws + WS_DQ), (size_t)t * 768 + n), proj(1344 + n) * 0.125 * 1.4426950408889634, 0.2); }
        if (which == 6) { const int n = r1 % 768; b = bad(dbf((const bf16_t*)(ws + WS_DK), (size_t)t * 768 + n), proj(2112 + n), 1.0); }
        if (which == 7) { const int n = r1 % 768; b = bad(dbf((const bf16_t*)(ws + WS_DVT), (size_t)n * T + t), proj(2880 + n), 1.0); }
    } else if (which == 8) {
        const bf16_t* cq = (const bf16_t*)(ws + WS_CQ); double ss = 0; for (int c = 0; c < 512; ++c) { const double v = dbf(cq, (size_t)t * 512 + c); ss += v * v; }
        const double rs = 1.0 / sqrt(ss / 512 + 1e-6);
        auto qraw = [&](int col) { double s = 0; for (int k = 0; k < 512; ++k) s += dbf(cq, (size_t)t * 512 + k) * rs * A.in[IN_Q_NORM][k] * (double)A.in[IN_W_UQ][(size_t)k * 1152 + col]; return s; };
        const int hd = r1 % 6, w = r2 % 192; double ref;
        if (w < 128) ref = qraw(hd * 192 + w); else { const int i = (w - 128) >> 1, p = (w - 128) & 1; const double x1 = qraw(hd * 192 + 128 + i), x2 = qraw(hd * 192 + 160 + i), ang = (double)pos[t] * pow(10000.0, -(double)(2 * i) / 64.0);
            ref = p ? x1 * sin(ang) + x2 * cos(ang) : x1 * cos(ang) - x2 * sin(ang); }
        ref *= 0.07216878364870322 * 1.4426950408889634; b = bad(dbf((const bf16_t*)(ws + WS_QM), (size_t)t * 1152 + hd * 192 + w), ref, 0.1);
    } else if (which == 9 || which == 10) {
        const bf16_t* ckv = (const bf16_t*)(ws + WS_CKV); double ss = 0; for (int c = 0; c < 256; ++c) { const double v = dbf(ckv, (size_t)t * 256 + c); ss += v * v; }
        const double rs = 1.0 / sqrt(ss / 256 + 1e-6); const int hd = r1 % 6, d = r2 % 128, col = hd * 256 + (which == 10 ? 128 : 0) + d;
        double s = 0; for (int k = 0; k < 256; ++k) s += dbf(ckv, (size_t)t * 256 + k) * rs * A.in[IN_KV_NORM][k] * (double)A.in[IN_W_UKV][(size_t)k * 1536 + col];
        const double got = which == 9 ? dbf((const bf16_t*)(ws + WS_KN), (size_t)t * 768 + hd * 128 + d) : dbf((const bf16_t*)(ws + WS_VMT), (size_t)(hd * 128 + d) * T + t); b = bad(got, s, 1.0);
    } else if (which == 11) {
        const bf16_t* zp = (const bf16_t*)(ws + WS_ZP); const int n = r1 % 512, g = n >> 7, wn = 2 << g, s = t & (S - 1), cnt = (s + 1) < wn ? (s + 1) : wn;
        double sm = 0; for (int k = 0; k < cnt; ++k) sm += dbf(zp, (size_t)(t - k) * 512 + n); const double ref = sm / cnt - dbf(zp, (size_t)t * 512 + n);
        b = bad(dbf((const bf16_t*)(ws + WS_MIX), (size_t)t * D + n), ref, 0.5);
    } else if (which == 12) {
        const bf16_t *qm = (const bf16_t*)(ws + WS_QM), *kn = (const bf16_t*)(ws + WS_KN), *kr = (const bf16_t*)(ws + WS_KR), *vmT = (const bf16_t*)(ws + WS_VMT);
        const int hd = r1 % 6, d = r2 % 128, bb = t / S, s = t % S; double mx = -1e300, l = 0, o = 0;
        for (int pass = 0; pass < 2; ++pass) for (int j = 0; j <= s; ++j) { const size_t tj = (size_t)bb * S + j; double sc = 0;
            for (int w = 0; w < 128; ++w) sc += dbf(qm, (size_t)t * 1152 + hd * 192 + w) * dbf(kn, tj * 768 + hd * 128 + w);
            for (int w = 0; w < 64; ++w) sc += dbf(qm, (size_t)t * 1152 + hd * 192 + 128 + w) * dbf(kr, tj * 64 + w);
            if (pass == 0) mx = sc > mx ? sc : mx; else { const double p = exp2(sc - mx); l += p; o += p * dbf(vmT, (size_t)(hd * 128 + d) * T + tj); } }
        b = bad(dbf((const bf16_t*)(ws + WS_MIX), (size_t)t * D + 512 + hd * 128 + d), o / l, 0.3);
    } else if (which == 13) {
        const bf16_t *dq = (const bf16_t*)(ws + WS_DQ), *dk = (const bf16_t*)(ws + WS_DK), *dvT = (const bf16_t*)(ws + WS_DVT);
        const int hd = r1 % 6, bb = t / S, s = t % S; const float* lv = A.in[IN_LAMBDA]; double d1 = 0, d2 = 0; for (int i = 0; i < 64; ++i) { d1 += (double)lv[i] * lv[64 + i]; d2 += (double)lv[128 + i] * lv[192 + i]; }
        const double lam_init = 0.8 - 0.6 * exp(0.0), lam = exp(d1) - exp(d2) + lam_init; double (*om)[128] = (double (*)[128])dscr;
        for (int c = 0; c < 2; ++c) { double mx = -1e300, l = 0; for (int d = 0; d < 128; ++d) om[c][d] = 0;
            for (int pass = 0; pass < 2; ++pass) for (int j = 0; j <= s; ++j) { const size_t tj = (size_t)bb * S + j; double sc = 0;
                for (int w = 0; w < 64; ++w) sc += dbf(dq, (size_t)t * 768 + hd * 128 + c * 64 + w) * dbf(dk, tj * 768 + hd * 128 + c * 64 + w);
                int n = pos[t] - pos[tj]; n = n < 0 ? 0 : n; int bkt; if (n < 16) bkt = n; else { bkt = 16 + (int)(log((double)n / 16.0) / log(8.0) * 16.0); bkt = bkt < 31 ? bkt : 31; }
                sc += (double)A.in[IN_REL_BIAS][bkt * 6 + hd] * 1.4426950408889634;
                if (pass == 0) mx = sc > mx ? sc : mx; else { const double p = exp2(sc - mx); l += p; for (int d = 0; d < 128; ++d) om[c][d] += p * dbf(dvT, (size_t)(hd * 128 + d) * T + tj); } }
            for (int d = 0; d < 128; ++d) om[c][d] /= l; }
        double ss = 0; for (int d = 0; d < 128; ++d) { om[0][d] -= lam * om[1][d]; ss += om[0][d] * om[0][d]; }
        const double rr = (1.0 - lam_init) / sqrt(ss / 128 + 1e-6); const int d = r2 % 128;
        b = bad(dbf((const bf16_t*)(ws + WS_MIX), (size_t)t * D + 1280 + hd * 128 + d), om[0][d] * rr * A.in[IN_SUBLN][d], 0.2);
    } else if (which == 14) {
        const int n = r1 % D; double s = x[(size_t)t * D + n]; for (int k = 0; k < D; ++k) s += dbf((const bf16_t*)(ws + WS_MIX), (size_t)t * D + k) * (double)A.in[IN_W_OUT][(size_t)k * D + n];
        b = bad(dbf((const bf16_t*)(ws + WS_H2), (size_t)t * D + n), s, 1.0);
    } else if (which == 15) {
        const bf16_t* hb_ = (const bf16_t*)(ws + WS_H2); auto hf = [&](size_t i) { return (double)bf2f(hb_[i]); }; double ss = 0; for (int i = 0; i < D; ++i) ss += hf((size_t)t * D + i) * hf((size_t)t * D + i);
        const double rs = 1.0 / sqrt(ss / D + 1e-6); const int k = r1 % D; b = bad(dbf(u, (size_t)t * D + k), hf((size_t)t * D + k) * rs * A.in[IN_FFN_NORM][k], 1.0);
        double* lg = dscr; for (int c = 0; c < 36; ++c) lg[c] = c < 4 ? A.in[IN_RG_B][c] : A.in[IN_RE_B][c - 4];
        for (int i = 0; i < D; ++i) { const double xv = hf((size_t)t * D + i) * rs * A.in[IN_FFN_NORM][i]; for (int c = 0; c < 4; ++c) lg[c] += xv * A.in[IN_RG_W][(size_t)i * 4 + c]; for (int c = 0; c < 32; ++c) lg[4 + c] += xv * A.in[IN_RE_W][(size_t)i * 32 + c]; }
        int gi = 0; for (int c = 1; c < 4; ++c) if (lg[c] > lg[gi]) gi = c; double gs = 0; for (int c = 0; c < 4; ++c) gs += exp(lg[c] - lg[gi]);
        int i0 = 0; for (int q = 1; q < 8; ++q) if (lg[4 + gi * 8 + q] > lg[4 + gi * 8 + i0]) i0 = q; int i1 = -1; for (int q = 0; q < 8; ++q) if (q != i0 && (i1 < 0 || lg[4 + gi * 8 + q] > lg[4 + gi * 8 + i1])) i1 = q;
        const double p0 = 1.0 / (1.0 + exp(lg[4 + gi * 8 + i1] - lg[4 + gi * 8 + i0]));
        const unsigned* cnt_ = (const unsigned*)(ws + WS_CTL) + CW_CNT; auto cntf = [&](int e) { return cnt_[64 * e]; }; const int* list = (const int*)(ws + WS_LIST); const float* gwt = (const float*)(ws + WS_GW);
        for (int kk = 0; kk < 2; ++kk) { const int e = gi * 8 + (kk ? i1 : i0); bool found = false; for (unsigned i = 0; i < cntf(e) && i < LISTCAP; ++i) if (list[e * LISTCAP + i] == t * 2 + kk) found = true;
            b = b || !found || bad(gwt[t * 2 + kk], (kk ? 1.0 - p0 : p0) / gs, 0.01); }
    } else if (which == 16) {
        const unsigned* cnt_ = (const unsigned*)(ws + WS_CTL) + CW_CNT; auto cntf = [&](int e) { return cnt_[64 * e]; }; const int* list = (const int*)(ws + WS_LIST);
        const int e = r0 % NE; if (cntf(e) == 0) return; const int i = r1 % cntf(e), j = r2 % EH; int off = 0; for (int q = 0; q < e; ++q) off += cntf(q);
        const int tok = list[e * LISTCAP + i] >> 1; double g = 0, up = 0;
        for (int k = 0; k < D; ++k) { const double xv = dbf(u, (size_t)tok * D + k); g += xv * (double)A.in[IN_EW_GATE][((size_t)e * D + k) * EH + j]; up += xv * (double)A.in[IN_EW_UP][((size_t)e * D + k) * EH + j]; }
        b = bad(dbf((const bf16_t*)(ws + WS_ACT), (size_t)(off + i) * EH + j), g / (1.0 + exp(-g)) * up, 0.3);
    } else if (which == 17) {
        const unsigned* cnt_ = (const unsigned*)(ws + WS_CTL) + CW_CNT; auto cntf = [&](int e) { return cnt_[64 * e]; }; const int* list = (const int*)(ws + WS_LIST); const float* gwt = (const float*)(ws + WS_GW); const bf16_t* act = (const bf16_t*)(ws + WS_ACT);
        const int n = r1 % D; double s = x[(size_t)t * D + n]; for (int k = 0; k < D; ++k) s += dbf((const bf16_t*)(ws + WS_MIX), (size_t)t * D + k) * (double)A.in[IN_W_OUT][(size_t)k * D + n];
        int off = 0; for (int e = 0; e < NE; ++e) { for (unsigned i = 0; i < cntf(e); ++i) { const int ent = list[e * LISTCAP + i]; if ((ent >> 1) == t) { double y = 0;
                    for (int j = 0; j < EH; ++j) y += dbf(act, (size_t)(off + i) * EH + j) * (double)A.in[IN_EW_DOWN][((size_t)e * EH + j) * D + n]; s += y * gwt[ent]; } } off += cntf(e); }
        b = bad(dbf((const bf16_t*)(ws + WS_H), (size_t)t * D + n), s, 1.0);
    }
    if (b) atomicAdd(chk + code, 1u);
}
__global__ void dbg_apply(Args A) {
    const unsigned* chk = (const unsigned*)(A.ws + WS_CTL) + CW_CHK; double f = 0; for (int k = 0; k < 18; ++k) if (chk[k]) f += pow(4.0, 17 - k);
    if (f == 0) return; const float sc = (float)(1.0 + f);
    for (size_t i = (size_t)blockIdx.x * blockDim.x + threadIdx.x; i < (size_t)T * D; i += (size_t)gridDim.x * blockDim.x) A.out[i] *= sc;
}
#endif

extern "C" void kernel_launch(void* const* d_in, const int* in_sizes, int n_in, void* d_out, int out_size, void* d_ws, size_t ws_size, hipStream_t stream) {
    static int grid = 0;
    if (!grid) {
        if (n_in != 23 || out_size != T * D || ws_size < WS_END) { fprintf(stderr, "kernel_launch: unexpected problem (n_in %d, out %d, ws %zu < %zu)\n", n_in, out_size, ws_size, (size_t)WS_END); grid = -1; return; }
        int dev = 0, cus = 0, per_cu = 0;
        hipGetDevice(&dev); hipDeviceGetAttribute(&cus, hipDeviceAttributeMultiprocessorCount, dev);
        if (hipFuncSetAttribute((const void*)hymba_fwd, hipFuncAttributeMaxDynamicSharedMemorySize, LDS_BYTES) != hipSuccess) { fprintf(stderr, "kernel_launch: hipFuncSetAttribute failed\n"); grid = -1; return; }
        hipOccupancyMaxActiveBlocksPerMultiprocessor(&per_cu, (const void*)hymba_fwd, NTHR, LDS_BYTES);
        if (per_cu < 1) { fprintf(stderr, "kernel_launch: occupancy query says %d blocks per CU\n", per_cu); }
        grid = cus > 0 ? cus : 256;
    }
    if (grid < 0) return;
    hipMemsetAsync((char*)d_ws + WS_CTL, 0, CTL_BYTES, stream);
    Args a{};
    for (int i = 0; i < 23; ++i) a.in[i] = (const float*)d_in[i];
    a.out = (float*)d_out; a.ws = (unsigned char*)d_ws; a.pad = 0;
#if MK_LAUNCHES == 1
    a.g_lo = 0; a.g_hi = 1 + 9 * NL; a.use_bar = 1;
    hipLaunchKernelGGL(hymba_fwd, dim3(grid), dim3(NTHR), LDS_BYTES, stream, a);
#else
    for (int k = 0; k < 1 + 9 * NL; ++k) { a.g_lo = k; a.g_hi = k + 1; a.use_bar = 0; hipLaunchKernelGGL(hymba_fwd, dim3(grid), dim3(NTHR), LDS_BYTES, stream, a);
#if DBG_CHECK
        auto chk = [&](int which, int blocks) { hipLaunchKernelGGL(dbg_check, dim3(blocks), dim3(64), 0, stream, a, which); };
        if (k == 0) chk(0, 4);
        if (k == 1) for (int w = 1; w <= 7; ++w) chk(w, w == 1 ? 1 : 4);
        if (k == 2) for (int w = 8; w <= 11; ++w) chk(w, 4);
        if (k == 3) { chk(12, 2); chk(13, 1); }
        if (k == 4) chk(14, 4);
        if (k == 5) chk(15, 4);
        if (k == 7) chk(16, 4);
        if (k == 9) chk(17, 4);
        if (k == 9 * NL) hipLaunchKernelGGL(dbg_apply, dim3(1024), dim3(256), 0, stream, a);
#endif
    }
#endif
}
```
